# Optimizing an MI355X kernel written in HIP

```python
import jax, jax.numpy as jnp
from jax import lax
import numpy as np

D_MODEL = 2048
BATCH = 8
SEQ = 2048
DEPTH = 2

HEAD_DIM = 128
DIL_CONFIGS = ((128, 1), (512, 4), (2048, 16))
N_DIL_GROUPS = 3
HEADS_PER_DIL_GROUP = 4
N_SB_HEADS = 8
SB_BLOCK = 128
ROPE_THETA = 500000.0
ROPE_DIM = HEAD_DIM // 4
N_EXPERT_GROUPS = 4
EXPERTS_PER_GROUP = 4
N_EXPERTS = N_EXPERT_GROUPS * EXPERTS_PER_GROUP
TOP_K_FINE = 2
EXPERT_FF = D_MODEL // 4
LN_EPS = 1e-5
DEEPNORM_ALPHA = (2 * DEPTH) ** 0.25
DEEPNORM_BETA = (8 * DEPTH) ** -0.25

WIDTH_A = N_DIL_GROUPS * HEADS_PER_DIL_GROUP * HEAD_DIM
OUT_A = HEADS_PER_DIL_GROUP * HEAD_DIM
WIDTH_B = N_SB_HEADS * HEAD_DIM
IN_SPLITS = (WIDTH_A, WIDTH_A, WIDTH_A, WIDTH_B, WIDTH_B, WIDTH_B, D_MODEL, D_MODEL)
IN_WIDTH = 3 * WIDTH_A + 3 * WIDTH_B + 2 * D_MODEL

kernel_name = "dilated_stickbreak_hier_moe_deepnorm"


def layer_norm(x, g, b):
    xf = x.astype(jnp.float32)
    mu = jnp.mean(xf, axis=-1, keepdims=True)
    var = jnp.mean(jnp.square(xf - mu), axis=-1, keepdims=True)
    return ((xf - mu) * lax.rsqrt(var + LN_EPS) * g + b).astype(x.dtype)


def partial_rotary(t, positions):
    half = ROPE_DIM // 2
    inv_freq = ROPE_THETA ** (-2.0 * jnp.arange(half, dtype=jnp.float32) / ROPE_DIM)
    ang = positions.astype(jnp.float32)[:, :, None] * inv_freq
    cos = jnp.cos(ang)[:, :, None, None, :]
    sin = jnp.sin(ang)[:, :, None, None, :]
    tf = t.astype(jnp.float32)
    x1, x2 = tf[..., :half], tf[..., half:ROPE_DIM]
    rot = jnp.concatenate([x1 * cos - x2 * sin, x2 * cos + x1 * sin, tf[..., ROPE_DIM:]], axis=-1)
    return rot.astype(t.dtype)


def dilated_window_attention(q, k, v, window, dilation):
    B, S, H, Dh = q.shape
    n = window // dilation
    sub_len = -(-S // dilation)
    sub_len = -(-sub_len // n) * n
    s_pad = sub_len * dilation
    nb = sub_len // n

    def to_blocks(t):
        t = jnp.pad(t, ((0, 0), (0, s_pad - S), (0, 0), (0, 0)))
        t = t.reshape(B, sub_len, dilation, H, Dh).transpose(0, 2, 3, 1, 4)
        return t.reshape(B, dilation, H, nb, n, Dh)

    def with_prev(t):
        prev = jnp.concatenate([jnp.zeros_like(t[:, :, :, :1]), t[:, :, :, :-1]], axis=3)
        return jnp.concatenate([prev, t], axis=4)

    qb = to_blocks(q)
    kk = with_prev(to_blocks(k))
    vv = with_prev(to_blocks(v))
    s = jnp.einsum('brhnqd,brhnkd->brhnqk', qb, kk).astype(jnp.float32) * (Dh ** -0.5)
    qi = jnp.arange(n)[:, None]
    kj = jnp.arange(2 * n)[None, :]
    band = (kj >= qi) & (kj <= qi + n)
    in_range = (jnp.arange(nb)[:, None, None] > 0) | (kj >= n)[None]
    valid = band[None] & in_range
    s = jnp.where(valid, s, -jnp.inf)
    m = jnp.max(s, axis=-1, keepdims=True)
    p = jnp.exp(s - m)
    den = jnp.sum(p, axis=-1, keepdims=True)
    out = jnp.einsum('brhnqk,brhnkd->brhnqd', (p / den).astype(v.dtype), vv)
    lse = (m + jnp.log(den))[..., 0]
    out = out.reshape(B, dilation, H, sub_len, Dh).transpose(0, 3, 1, 2, 4).reshape(B, s_pad, H, Dh)[:, :S]
    lse = lse.reshape(B, dilation, H, sub_len).transpose(0, 3, 1, 2).reshape(B, s_pad, H)[:, :S]
    return out, lse


def stick_breaking_attention(q, k, v):
    B, S, H, Dh = q.shape
    outs = []
    for i in range(S // SB_BLOCK):
        q0 = i * SB_BLOCK
        kv_len = q0 + SB_BLOCK
        z = jnp.einsum('bqhd,bkhd->bhqk', q[:, q0:kv_len], k[:, :kv_len]).astype(jnp.float32) * (Dh ** -0.5)
        t_idx = q0 + jnp.arange(SB_BLOCK)
        causal = jnp.arange(kv_len)[None, :] < t_idx[:, None]
        log_keep = jnp.where(causal, jax.nn.log_sigmoid(-z), 0.0)
        later = lax.cumsum(log_keep, axis=3, reverse=True) - log_keep
        log_a = jnp.where(causal, jax.nn.log_sigmoid(z) + later, -jnp.inf)
        outs.append(jnp.einsum('bhqk,bkhd->bqhd', jnp.exp(log_a).astype(v.dtype), v[:, :kv_len]))
    return jnp.concatenate(outs, axis=1)


def hybrid_mixer(x, positions, w_in, p_a, p_b, w_o):
    B, S, _ = x.shape
    proj = jnp.einsum('bsd,de->bse', x, w_in)
    qa, ka, va, qb, kb, vb, ga, gb = jnp.split(proj, np.cumsum(IN_SPLITS)[:-1], axis=-1)
    shp_a = (B, S, N_DIL_GROUPS, HEADS_PER_DIL_GROUP, HEAD_DIM)
    qa = partial_rotary(qa.reshape(shp_a), positions)
    ka = partial_rotary(ka.reshape(shp_a), positions)
    va = va.reshape(shp_a)
    outs, lses = [], []
    for g, (window, dilation) in enumerate(DIL_CONFIGS):
        o, l = dilated_window_attention(qa[:, :, g], ka[:, :, g], va[:, :, g], window, dilation)
        outs.append(o)
        lses.append(l)
    w_grp = jax.nn.softmax(jnp.stack(lses, axis=0), axis=0)
    o_a = jnp.sum(w_grp[..., None].astype(x.dtype) * jnp.stack(outs, axis=0), axis=0).reshape(B, S, OUT_A)
    shp_b = (B, S, N_SB_HEADS, HEAD_DIM)
    o_b = stick_breaking_attention(qb.reshape(shp_b), kb.reshape(shp_b), vb.reshape(shp_b)).reshape(B, S, WIDTH_B)
    merged = (jax.nn.sigmoid(ga) * jnp.einsum('bse,ed->bsd', o_a, p_a)
              + jax.nn.sigmoid(gb) * jnp.einsum('bse,ed->bsd', o_b, p_b))
    return jnp.einsum('bsd,de->bse', merged, w_o).astype(x.dtype)


def hierarchical_moe(x, w_coarse, b_coarse, w_fine, b_fine, w_up, w_down):
    B, S, D = x.shape
    xt = x.reshape(B * S, D)
    coarse_p = jax.nn.softmax((xt @ w_coarse).astype(jnp.float32) + b_coarse, axis=-1)
    p_grp, g_idx = lax.top_k(coarse_p, 1)
    fine_logits = ((xt @ w_fine).astype(jnp.float32) + b_fine).reshape(-1, N_EXPERT_GROUPS, EXPERTS_PER_GROUP)
    sel = jnp.take_along_axis(fine_logits, g_idx[:, :, None], axis=1)[:, 0]
    top_v, top_i = lax.top_k(sel, TOP_K_FINE)
    w_top = jax.nn.softmax(top_v, axis=-1)
    within = jnp.sum(jax.nn.one_hot(top_i, EXPERTS_PER_GROUP, dtype=jnp.float32) * w_top[..., None], axis=1)
    gates = (jax.nn.one_hot(g_idx[:, 0], N_EXPERT_GROUPS, dtype=jnp.float32)[:, :, None]
             * (p_grp * within)[:, None, :]).reshape(-1, N_EXPERTS)
    y = jnp.zeros((B * S, D), jnp.float32)
    for e in range(N_EXPERTS):
        h = xt @ w_up[e]
        a, b = h[:, :EXPERT_FF], h[:, EXPERT_FF:]
        y = y + gates[:, e:e + 1] * ((jax.nn.silu(a) * b) @ w_down[e]).astype(jnp.float32)
    return y.reshape(B, S, D).astype(x.dtype)


def setup_inputs(seed: int = 0) -> dict:
    key = jax.random.key(seed)
    ks = jax.random.split(key, 16)
    nrm = jax.random.normal
    x = nrm(ks[0], (BATCH, SEQ, D_MODEL), jnp.float32)
    offs = jax.random.randint(ks[1], (BATCH, 1), 0, 4096, dtype=jnp.int32)
    positions = (jnp.arange(SEQ, dtype=jnp.int32)[None, :] + offs).astype(jnp.int32)
    w_in = nrm(ks[2], (DEPTH, D_MODEL, IN_WIDTH), jnp.float32) * D_MODEL ** -0.5
    p_a = nrm(ks[3], (DEPTH, OUT_A, D_MODEL), jnp.float32) * OUT_A ** -0.5
    p_b = nrm(ks[4], (DEPTH, WIDTH_B, D_MODEL), jnp.float32) * WIDTH_B ** -0.5
    w_o = nrm(ks[5], (DEPTH, D_MODEL, D_MODEL), jnp.float32) * (D_MODEL ** -0.5 * DEEPNORM_BETA)
    ln_g = 1.0 + 0.02 * nrm(ks[6], (DEPTH, 2, D_MODEL), jnp.float32)
    ln_b = 0.02 * nrm(ks[7], (DEPTH, 2, D_MODEL), jnp.float32)
    router_coarse = nrm(ks[8], (DEPTH, D_MODEL, N_EXPERT_GROUPS), jnp.float32) * D_MODEL ** -0.5
    router_coarse_bias = 0.01 * nrm(ks[9], (DEPTH, N_EXPERT_GROUPS), jnp.float32)
    router_fine = nrm(ks[10], (DEPTH, D_MODEL, N_EXPERTS), jnp.float32) * D_MODEL ** -0.5
    router_fine_bias = 0.01 * nrm(ks[11], (DEPTH, N_EXPERTS), jnp.float32)
    w_up = nrm(ks[12], (DEPTH, N_EXPERTS, D_MODEL, 2 * EXPERT_FF), jnp.float32) * D_MODEL ** -0.5
    w_down = nrm(ks[13], (DEPTH, N_EXPERTS, EXPERT_FF, D_MODEL), jnp.float32) * (EXPERT_FF ** -0.5 * DEEPNORM_BETA)
    return {"x": x, "positions": positions, "w_in": w_in, "p_a": p_a, "p_b": p_b, "w_o": w_o,
            "ln_g": ln_g, "ln_b": ln_b, "router_coarse": router_coarse,
            "router_coarse_bias": router_coarse_bias, "router_fine": router_fine,
            "router_fine_bias": router_fine_bias, "w_up": w_up, "w_down": w_down}


def reference(x, positions, w_in, p_a, p_b, w_o, ln_g, ln_b, router_coarse, router_coarse_bias,
              router_fine, router_fine_bias, w_up, w_down):
    h = x
    for l in range(DEPTH):
        y = hybrid_mixer(h, positions, w_in[l], p_a[l], p_b[l], w_o[l])
        h = layer_norm(DEEPNORM_ALPHA * h + y, ln_g[l, 0], ln_b[l, 0])
        y = hierarchical_moe(h, router_coarse[l], router_coarse_bias[l], router_fine[l],
                             router_fine_bias[l], w_up[l], w_down[l])
        h = layer_norm(DEEPNORM_ALPHA * h + y, ln_g[l, 1], ln_b[l, 1])
    return h
```

```cpp
#include <hip/hip_runtime.h>
#include <cstdio>
#include <cstdint>

#define LAS __attribute__((address_space(3)))
#define GAS __attribute__((address_space(1)))
typedef unsigned short bf16_t;
typedef short bf16x8 __attribute__((ext_vector_type(8)));
typedef short s16x4 __attribute__((ext_vector_type(4)));
typedef float f32x4 __attribute__((ext_vector_type(4)));
typedef float f32x2 __attribute__((ext_vector_type(2)));
typedef float f32x16 __attribute__((ext_vector_type(16)));
typedef unsigned u32x4 __attribute__((ext_vector_type(4)));
typedef unsigned u32x2 __attribute__((ext_vector_type(2)));

constexpr int BATCH = 8, SEQ = 2048, DM = 2048, DEPTH = 2, MTOK = BATCH * SEQ;
constexpr int HD = 128, WA = 1536, WB = 1024, NIN = 11776;
constexpr int NEXP = 16, FF = 512, ECAP = 16384;
constexpr float LN_EPS = 1e-5f;
constexpr float ALPHA = 1.4142135623730951f;
constexpr float LOG2E = 1.4426950408889634f;
constexpr float QK_C2 = 0.08838834764831845f * LOG2E;

__device__ __forceinline__ unsigned cvt_pk_bf16(float lo, float hi) { unsigned r; asm volatile("v_cvt_pk_bf16_f32 %0, %1, %2" : "=v"(r) : "v"(lo), "v"(hi)); return r; }
__device__ __forceinline__ float bf_lo(unsigned w) { return __uint_as_float(w << 16); }
__device__ __forceinline__ float bf_hi(unsigned w) { return __uint_as_float(w & 0xffff0000u); }
__device__ __forceinline__ float sigmoidf_fast(float x) { return __builtin_amdgcn_rcpf(1.0f + __builtin_amdgcn_exp2f(-x * LOG2E)); }

namespace pg8 {
constexpr int BM = 256, BK = 64, HALF = 128, HTB = HALF * BK * 2, STAGE_BYTES = 8 * HTB, NXCD = 8, WGM = 8;
__host__ __device__ __forceinline__ int lds_byte(int r, int c) { const int st = (r >> 4) * 2 + (c >> 5), rr = r & 15, cc = c & 31, ob = rr * 64 + cc * 2; return st * 1024 + (ob ^ (((ob >> 9) & 1) << 5)); }
__host__ __device__ __forceinline__ void stage_rc(int b, int& R, int& C) { const int st = b / 1024, sb = b % 1024, swz = sb ^ (((sb >> 9) & 1) << 5); R = (st >> 1) * 16 + swz / 64; C = (st & 1) * 32 + (swz % 64) / 2; }
__host__ __device__ __forceinline__ int perm32(int rho) { const int n = rho >> 4, i = rho & 15; return 8 * (i >> 2) + 4 * n + (i & 3); }

struct Unit { int pm, pn, pb, e, r0; };
struct Gemm { const bf16_t* A; const bf16_t* Bt; int K; };

struct StaticOrder {
    int nM, nN, nwg, G, c;
    __device__ void init(int M, int N, int G_, int c_) { nM = M / BM; nN = N / BM; nwg = nM * nN; G = G_; c = c_; }
    __device__ bool next(int i, Unit& u) const {
        const long L = (long)i * G + c; if (L >= nwg) return false;
        int wgid = (int)L; { const int q = nwg / NXCD, r = nwg % NXCD, xcd = wgid % NXCD, off = wgid / NXCD; wgid = (xcd < r ? xcd * (q + 1) : r * (q + 1) + (xcd - r) * q) + off; }
        const int nig = WGM * nN, gid = wgid / nig, fm = gid * WGM, gsz = (nM - fm) < WGM ? (nM - fm) : WGM;
        u.pm = fm + ((wgid % nig) % gsz); u.pn = (wgid % nig) / gsz; u.pb = u.pn; u.e = 0; u.r0 = 0; return true;
    }
    __device__ __forceinline__ int tok(const Unit&, int) const { return 0; }
};
struct MoeOrder {
    int nct, G, c, total; const LAS int* tb; const LAS int* cnt; const int* list;
    __device__ bool next(int i, Unit& u) const {
        const long L = (long)i * G + c; if (L >= total) return false;
        const int rt = (int)L / nct, ct = (int)L % nct; const int e = __builtin_amdgcn_readfirstlane(tb[64 + rt]);
        u.pm = rt; u.pn = ct; u.pb = e * nct + ct; u.e = e; u.r0 = (rt - __builtin_amdgcn_readfirstlane(tb[e])) * BM; return true;
    }
    __device__ __forceinline__ int tok(const Unit& u, int row) const { const int cn = cnt[u.e]; int pos = u.r0 + row; pos = pos < cn ? pos : cn - 1; return list[u.e * ECAP + pos]; }
};

template <class Epi, class Sched, bool ALIGN_EPI, bool GATHER>
__device__ __forceinline__ void gemm_phase(LAS unsigned char* lds, const Gemm g, const Sched& S, const Epi& E) {
    int tid = threadIdx.x; asm volatile("" : "+v"(tid));
    const int wid = __builtin_amdgcn_readfirstlane(tid >> 6), lane = tid & 63, wr = wid >> 2, wc = wid & 3, fr = lane & 15, fq = lane >> 4;
    const int K = g.K, nt = K / BK;
    const size_t kstep = (size_t)(BK * 2);
    const size_t hstep = (size_t)HALF * K * 2;
    const size_t tstep = 2 * hstep;
    int RA[2], CA[2]; unsigned voffB[2];
#pragma unroll
    for (int i = 0; i < 2; ++i) { int R, C; stage_rc(tid * 16 + i * 8192, R, C); const int Rb = Epi::PERM ? ((R & ~31) + perm32(R & 31)) : R; RA[i] = R; CA[i] = C; voffB[i] = (unsigned)(Rb * K + C) * 2u; }
    const unsigned ldsw = (unsigned)wid * 1024u;
    const int aoff = lds_byte(wr * 64 + fr, fq * 8), boff = lds_byte(wc * 32 + fr, fq * 8);
#define PG8_SA(b, h) (((b) * 2 + (h)) * HTB)
#define PG8_SB(b, h) ((4 + (b) * 2 + (h)) * HTB)
#define PG8_STAGE(bufoff, gbase, v0, v1) do { \
        __builtin_amdgcn_global_load_lds((const unsigned*)((const char*)(gbase) + (v0)), (LAS unsigned*)(lds + (bufoff) + ldsw), 16, 0, 0); \
        __builtin_amdgcn_global_load_lds((const unsigned*)((const char*)(gbase) + (v1)), (LAS unsigned*)(lds + (bufoff) + ldsw + 8192), 16, 0, 0); } while (0)
#define PG8_LDA(dst, b, h) do { _Pragma("unroll") for (int m = 0; m < 4; ++m) _Pragma("unroll") for (int k = 0; k < 2; ++k) dst[m][k] = *(const LAS bf16x8*)(lds + PG8_SA(b, h) + aoff + m * 2048 + k * 1024); } while (0)
#define PG8_LDB(dst, b, h) do { _Pragma("unroll") for (int n = 0; n < 2; ++n) _Pragma("unroll") for (int k = 0; k < 2; ++k) dst[n][k] = *(const LAS bf16x8*)(lds + PG8_SB(b, h) + boff + n * 2048 + k * 1024); } while (0)
#define PG8_MMA(ai, bj, At, Bt) do { __builtin_amdgcn_s_setprio(1); _Pragma("unroll") for (int m = 0; m < 4; ++m) _Pragma("unroll") for (int n = 0; n < 2; ++n) _Pragma("unroll") for (int k = 0; k < 2; ++k) \
        acc[ai][bj][m][n] = __builtin_amdgcn_mfma_f32_16x16x32_bf16(Bt[n][k], At[m][k], acc[ai][bj][m][n], 0, 0, 0); __builtin_amdgcn_s_setprio(0); } while (0)
#define PG8_WAIT_V(n) asm volatile("s_waitcnt vmcnt(" #n ")" ::: "memory")
#define PG8_WAIT_L(n) asm volatile("s_waitcnt lgkmcnt(" #n ")" ::: "memory")
#define PG8_BAR __builtin_amdgcn_s_barrier()
#define PG8_SCHED __builtin_amdgcn_sched_barrier(0)
    Unit cur, nxt; int ui = 0;
    if (!S.next(0, cur)) return;
    f32x4 acc[2][2][4][2];
#pragma unroll
    for (int a = 0; a < 2; ++a)
#pragma unroll
        for (int b = 0; b < 2; ++b)
#pragma unroll
            for (int m = 0; m < 4; ++m)
#pragma unroll
                for (int n = 0; n < 2; ++n) acc[a][b][m][n] = (f32x4){0.f, 0.f, 0.f, 0.f};
    bf16x8 At[4][2], B0[2][2], B1[2][2];
    unsigned c00, c01, c10, c11, n00, n01, n10, n11;
    if constexpr (GATHER) {
        c00 = (unsigned)(S.tok(cur, RA[0]) * K + CA[0]) * 2u; c01 = (unsigned)(S.tok(cur, RA[1]) * K + CA[1]) * 2u;
        c10 = (unsigned)(S.tok(cur, HALF + RA[0]) * K + CA[0]) * 2u; c11 = (unsigned)(S.tok(cur, HALF + RA[1]) * K + CA[1]) * 2u;
    } else {
        c00 = (unsigned)(RA[0] * K + CA[0]) * 2u; c01 = (unsigned)(RA[1] * K + CA[1]) * 2u; c10 = c00 + (unsigned)hstep; c11 = c01 + (unsigned)hstep;
    }
    n00 = c00; n01 = c01; n10 = c10; n11 = c11;
    const char* cA = GATHER ? (const char*)g.A : (const char*)g.A + (size_t)cur.pm * tstep; const char* cB = (const char*)g.Bt + (size_t)cur.pb * tstep;
    PG8_STAGE(PG8_SB(0, 0), cB, voffB[0], voffB[1]); PG8_STAGE(PG8_SB(0, 1), cB + hstep, voffB[0], voffB[1]); PG8_STAGE(PG8_SA(0, 0), cA, c00, c01); PG8_STAGE(PG8_SA(0, 1), cA, c10, c11);
    if (wr == 1) PG8_BAR;
    PG8_WAIT_V(2); PG8_BAR;
    PG8_STAGE(PG8_SB(1, 0), cB + kstep, voffB[0], voffB[1]); PG8_STAGE(PG8_SA(1, 0), cA + kstep, c00, c01); PG8_STAGE(PG8_SB(1, 1), cB + hstep + kstep, voffB[0], voffB[1]);
    PG8_WAIT_V(6); PG8_BAR;
    for (;;) {
        const bool has_next = S.next(ui + 1, nxt);
        const char* nA = has_next ? (GATHER ? (const char*)g.A : (const char*)g.A + (size_t)nxt.pm * tstep) : cA; const char* nB = has_next ? (const char*)g.Bt + (size_t)nxt.pb * tstep : cB;
        if constexpr (GATHER) {
            if (has_next) {
                n00 = (unsigned)(S.tok(nxt, RA[0]) * K + CA[0]) * 2u; n01 = (unsigned)(S.tok(nxt, RA[1]) * K + CA[1]) * 2u;
                n10 = (unsigned)(S.tok(nxt, HALF + RA[0]) * K + CA[0]) * 2u; n11 = (unsigned)(S.tok(nxt, HALF + RA[1]) * K + CA[1]) * 2u;
            } else { n00 = c00; n01 = c01; n10 = c10; n11 = c11; }
        }
        for (int t = 0; t < nt; t += 2) {
            const bool last = (t == nt - 2);
            const char* a1 = cA + (size_t)(t + 1) * kstep;
            const char* a2 = last ? nA : cA + (size_t)(t + 2) * kstep; const char* b2 = last ? nB : cB + (size_t)(t + 2) * kstep;
            const char* a3 = a2 + kstep; const char* b3 = b2 + kstep;
            const unsigned o00 = last ? n00 : c00, o01 = last ? n01 : c01, o10 = last ? n10 : c10, o11 = last ? n11 : c11;
            PG8_LDB(B0, 0, 0); PG8_LDB(B1, 0, 1); PG8_SCHED; PG8_LDA(At, 0, 0); PG8_STAGE(PG8_SA(1, 1), a1, c10, c11);
            PG8_WAIT_V(8); PG8_WAIT_L(0); PG8_BAR; PG8_MMA(0, 0, At, B0); PG8_MMA(0, 1, At, B1); PG8_BAR; PG8_SCHED;
            PG8_LDA(At, 0, 1); PG8_STAGE(PG8_SB(0, 0), b2, voffB[0], voffB[1]); PG8_STAGE(PG8_SB(0, 1), b2 + hstep, voffB[0], voffB[1]); PG8_STAGE(PG8_SA(0, 0), a2, o00, o01);
            PG8_WAIT_V(8); PG8_WAIT_L(0); PG8_BAR; PG8_MMA(1, 0, At, B0); PG8_MMA(1, 1, At, B1); PG8_BAR; PG8_SCHED;
            PG8_LDB(B0, 1, 0); PG8_LDB(B1, 1, 1); PG8_SCHED; PG8_LDA(At, 1, 0); PG8_STAGE(PG8_SA(0, 1), a2, o10, o11);
            PG8_WAIT_V(8); PG8_WAIT_L(0); PG8_BAR; PG8_MMA(0, 0, At, B0); PG8_MMA(0, 1, At, B1); PG8_BAR; PG8_SCHED;
            PG8_LDA(At, 1, 1); PG8_STAGE(PG8_SB(1, 0), b3, voffB[0], voffB[1]); PG8_STAGE(PG8_SB(1, 1), b3 + hstep, voffB[0], voffB[1]); PG8_STAGE(PG8_SA(1, 0), a3, o00, o01);
            PG8_WAIT_V(8); PG8_WAIT_L(0); PG8_BAR; PG8_MMA(1, 0, At, B0); PG8_MMA(1, 1, At, B1); PG8_BAR; PG8_SCHED;
        }
        if constexpr (ALIGN_EPI) { if (wr == 0) PG8_BAR; }
        E(acc, cur, wr, wc, fr, fq);
        if (!has_next) break;
#pragma unroll
        for (int a = 0; a < 2; ++a)
#pragma unroll
            for (int b = 0; b < 2; ++b)
#pragma unroll
                for (int m = 0; m < 4; ++m)
#pragma unroll
                    for (int n = 0; n < 2; ++n) acc[a][b][m][n] = (f32x4){0.f, 0.f, 0.f, 0.f};
        cur = nxt; cA = nA; cB = nB; ++ui; c00 = n00; c01 = n01; c10 = n10; c11 = n11;
        if constexpr (ALIGN_EPI) { if (wr == 1) PG8_BAR; }
    }
    PG8_WAIT_V(0);
    if constexpr (!ALIGN_EPI) { if (wr == 0) PG8_BAR; }
    PG8_BAR;
#undef PG8_SA
#undef PG8_SB
#undef PG8_STAGE
#undef PG8_LDA
#undef PG8_LDB
#undef PG8_MMA
#undef PG8_WAIT_V
#undef PG8_WAIT_L
#undef PG8_BAR
#undef PG8_SCHED
}
}
namespace pg8 {
struct EpiProj {
    static constexpr bool PERM = true;
    bf16_t* qkv;
    bf16_t* gates;
    const float* rope;
    __device__ __forceinline__ void operator()(const f32x4 (&acc)[2][2][4][2], const Unit& u, int wr, int wc, int fr, int fq) const {
        const int pn = u.pn; bf16_t* base; int ldc, ct0;
        if (pn < 18) { const int t = pn / 6; base = qkv + (size_t)t * MTOK * WA; ldc = WA; ct0 = t * 6; }
        else if (pn < 30) { const int t = (pn - 18) / 4; base = qkv + (size_t)3 * MTOK * WA + (size_t)t * MTOK * WB; ldc = WB; ct0 = 18 + t * 4; }
        else { const int t = (pn - 30) / 8; base = gates + (size_t)t * MTOK * DM; ldc = DM; ct0 = 30 + t * 8; }
        const int row0 = u.pm * BM + wr * 64 + fr, col0 = (pn - ct0) * BM + wc * 32 + 8 * fq;
        const bool do_rope = (pn < 12) && (wc == 0);
#pragma unroll
        for (int ai = 0; ai < 2; ++ai)
#pragma unroll
            for (int m = 0; m < 4; ++m) { const int row = row0 + ai * HALF + m * 16; bf16_t* rowp = base + (size_t)row * ldc + col0;
                f32x4 cs = (f32x4){1.f, 1.f, 1.f, 1.f}, sn = (f32x4){0.f, 0.f, 0.f, 0.f};
                if (do_rope) { cs = *(const f32x4*)(rope + (size_t)row * 32 + 4 * fq); sn = *(const f32x4*)(rope + (size_t)row * 32 + 16 + 4 * fq); }
#pragma unroll
                for (int bj = 0; bj < 2; ++bj) { f32x4 v0 = acc[ai][bj][m][0], v1 = acc[ai][bj][m][1];
                    if (do_rope) { const f32x4 y0 = v0 * cs - v1 * sn, y1 = v1 * cs + v0 * sn; v0 = y0; v1 = y1; }
                    u32x4 w; w.x = cvt_pk_bf16(v0[0], v0[1]); w.y = cvt_pk_bf16(v0[2], v0[3]); w.z = cvt_pk_bf16(v1[0], v1[1]); w.w = cvt_pk_bf16(v1[2], v1[3]);
                    *(u32x4*)(rowp + bj * HALF) = w; } }
    }
};
struct EpiBf16 {
    static constexpr bool PERM = true;
    bf16_t* O; int ldc;
    __device__ __forceinline__ void operator()(const f32x4 (&acc)[2][2][4][2], const Unit& u, int wr, int wc, int fr, int fq) const {
        const int row0 = u.pm * BM + wr * 64 + fr, col0 = u.pn * BM + wc * 32 + 8 * fq;
#pragma unroll
        for (int ai = 0; ai < 2; ++ai)
#pragma unroll
            for (int m = 0; m < 4; ++m) { bf16_t* rowp = O + (size_t)(row0 + ai * HALF + m * 16) * ldc + col0;
#pragma unroll
                for (int bj = 0; bj < 2; ++bj) { const f32x4 v0 = acc[ai][bj][m][0], v1 = acc[ai][bj][m][1];
                    u32x4 w; w.x = cvt_pk_bf16(v0[0], v0[1]); w.y = cvt_pk_bf16(v0[2], v0[3]); w.z = cvt_pk_bf16(v1[0], v1[1]); w.w = cvt_pk_bf16(v1[2], v1[3]);
                    *(u32x4*)(rowp + bj * HALF) = w; } }
    }
};
template <bool SECOND> struct EpiGate {
    static constexpr bool PERM = true;
    const bf16_t* gate; bf16_t* P1; bf16_t* out;
    __device__ __forceinline__ void operator()(const f32x4 (&acc)[2][2][4][2], const Unit& u, int wr, int wc, int fr, int fq) const {
        const int row0 = u.pm * BM + wr * 64 + fr, col0 = u.pn * BM + wc * 32 + 8 * fq;
#pragma unroll
        for (int ai = 0; ai < 2; ++ai)
#pragma unroll
            for (int m = 0; m < 4; ++m) { const size_t off = (size_t)(row0 + ai * HALF + m * 16) * DM + col0;
#pragma unroll
                for (int bj = 0; bj < 2; ++bj) { const f32x4 v0 = acc[ai][bj][m][0], v1 = acc[ai][bj][m][1];
                    const u32x4 gw = *(const u32x4*)(gate + off + bj * HALF);
                    float r[8];
                    r[0] = sigmoidf_fast(bf_lo(gw.x)) * v0[0]; r[1] = sigmoidf_fast(bf_hi(gw.x)) * v0[1]; r[2] = sigmoidf_fast(bf_lo(gw.y)) * v0[2]; r[3] = sigmoidf_fast(bf_hi(gw.y)) * v0[3];
                    r[4] = sigmoidf_fast(bf_lo(gw.z)) * v1[0]; r[5] = sigmoidf_fast(bf_hi(gw.z)) * v1[1]; r[6] = sigmoidf_fast(bf_lo(gw.w)) * v1[2]; r[7] = sigmoidf_fast(bf_hi(gw.w)) * v1[3];
                    if (SECOND) { const u32x4 pw = *(const u32x4*)(P1 + off + bj * HALF);
                        r[0] += bf_lo(pw.x); r[1] += bf_hi(pw.x); r[2] += bf_lo(pw.y); r[3] += bf_hi(pw.y); r[4] += bf_lo(pw.z); r[5] += bf_hi(pw.z); r[6] += bf_lo(pw.w); r[7] += bf_hi(pw.w); }
                    u32x4 w; w.x = cvt_pk_bf16(r[0], r[1]); w.y = cvt_pk_bf16(r[2], r[3]); w.z = cvt_pk_bf16(r[4], r[5]); w.w = cvt_pk_bf16(r[6], r[7]);
                    *(u32x4*)((SECOND ? out : P1) + off + bj * HALF) = w; }
                asm volatile("" ::: "memory"); }
    }
};
struct EpiResid {
    static constexpr bool PERM = false;
    const float* h; float* out;
    __device__ __forceinline__ void operator()(const f32x4 (&acc)[2][2][4][2], const Unit& u, int wr, int wc, int fr, int fq) const {
        const int row0 = u.pm * BM + wr * 64 + fr, col0 = u.pn * BM + wc * 32 + 4 * fq;
#pragma unroll
        for (int ai = 0; ai < 2; ++ai)
#pragma unroll
            for (int m = 0; m < 4; ++m) { const size_t off = (size_t)(row0 + ai * HALF + m * 16) * DM + col0;
#pragma unroll
                for (int bj = 0; bj < 2; ++bj)
#pragma unroll
                    for (int n = 0; n < 2; ++n) { const f32x4 hv = *(const f32x4*)(h + off + bj * HALF + n * 16); *(f32x4*)(out + off + bj * HALF + n * 16) = hv * ALPHA + acc[ai][bj][m][n]; } }
    }
};
struct EpiSwiglu {
    static constexpr bool PERM = true;
    bf16_t* Hd;
    __device__ __forceinline__ void operator()(const f32x4 (&acc)[2][2][4][2], const Unit& u, int wr, int wc, int fr, int fq) const {
        const int row0 = u.pm * BM + wr * 64 + fr, col0 = u.pn * HALF + wc * 32 + 8 * fq;
#pragma unroll
        for (int ai = 0; ai < 2; ++ai)
#pragma unroll
            for (int m = 0; m < 4; ++m) { bf16_t* rowp = Hd + (size_t)(row0 + ai * HALF + m * 16) * FF + col0;
                float r[8];
#pragma unroll
                for (int n = 0; n < 2; ++n)
#pragma unroll
                    for (int j = 0; j < 4; ++j) { const float a = acc[ai][0][m][n][j], b = acc[ai][1][m][n][j]; r[4 * n + j] = a * sigmoidf_fast(a) * b; }
                u32x4 w; w.x = cvt_pk_bf16(r[0], r[1]); w.y = cvt_pk_bf16(r[2], r[3]); w.z = cvt_pk_bf16(r[4], r[5]); w.w = cvt_pk_bf16(r[6], r[7]);
                *(u32x4*)rowp = w; }
    }
};
}
namespace att {
#define SBAR() __builtin_amdgcn_sched_barrier(0)
#define KSWZ(row, colB) ((row) * 256 + ((colB) ^ (((row) & 7) << 4)))
__device__ __forceinline__ int v_st(int k, int c) { const int kk = (k & ~0xC) | ((k & 4) << 1) | ((k & 8) >> 1); return ((kk >> 3) * 4 + (c >> 5)) * 512 + ((kk & 7) * 32 + (c & 31)) * 2; }
__device__ __forceinline__ int v_rd_base(int lane) { return ((lane & 3) << 3) | (((lane >> 2) & 3) << 6) | (((lane >> 4) & 1) << 5) | (((lane >> 5) & 1) << 8); }
__device__ __forceinline__ int crow(int r, int hi) { return (r & 3) + 8 * (r >> 2) + 4 * hi; }
__device__ __forceinline__ float partner_f(float x, int hi) { auto rr = __builtin_amdgcn_permlane32_swap(__float_as_uint(x), __float_as_uint(x), false, false); return __uint_as_float(hi ? rr[0] : rr[1]); }
#define PK4(P, B_, OUT) do { unsigned a0 = cvt_pk_bf16(P[B_+0], P[B_+1]), a1 = cvt_pk_bf16(P[B_+2], P[B_+3]);                          \
        unsigned b0 = cvt_pk_bf16(P[B_+4], P[B_+5]), b1 = cvt_pk_bf16(P[B_+6], P[B_+7]);                                             \
        auto r0 = __builtin_amdgcn_permlane32_swap(a0, b0, false, false); auto r1 = __builtin_amdgcn_permlane32_swap(a1, b1, false, false); \
        u32x4 w = {r0[0], r1[0], r0[1], r1[1]}; OUT = *reinterpret_cast<bf16x8*>(&w); } while (0)
#define TRRD(dst, addr, off) asm volatile("ds_read_b64_tr_b16 %0, %1 offset:%2" : "=&v"(dst) : "v"(addr), "i"(off) : "memory")

__device__ __forceinline__ void qkt32(f32x16& p, unsigned kaddr, int r32, int hi, const bf16x8* qr) {
    p = f32x16{};
    unsigned kb[4];
#pragma unroll
    for (int dd = 0; dd < 4; ++dd) kb[dd] = kaddr + KSWZ(r32, (dd * 16 + hi * 8) * 2);
#pragma unroll
    for (int d0 = 0; d0 < 8; ++d0) { const bf16x8 b0 = *(const LAS bf16x8*)(uintptr_t)(kb[d0 & 3] + (d0 >> 2) * 128);
        p = __builtin_amdgcn_mfma_f32_32x32x16_bf16(b0, qr[d0], p, 0, 0, 0); }
}
__device__ __forceinline__ void pv32(f32x16* o, unsigned vaddr, bf16x8 pa0, bf16x8 pa1) {
#define PV_D0(d0) do { s16x4 l0, l1, h0, h1; constexpr int b_ = (d0) * 512; \
        TRRD(l0, vaddr, b_); TRRD(h0, vaddr, b_ + 2048); TRRD(l1, vaddr, b_ + 4096); TRRD(h1, vaddr, b_ + 6144); \
        asm volatile("s_waitcnt lgkmcnt(0)" ::: "memory"); SBAR(); \
        o[d0] = __builtin_amdgcn_mfma_f32_32x32x16_bf16(pa0, (bf16x8){l0[0], l0[1], l0[2], l0[3], h0[0], h0[1], h0[2], h0[3]}, o[d0], 0, 0, 0); \
        o[d0] = __builtin_amdgcn_mfma_f32_32x32x16_bf16(pa1, (bf16x8){l1[0], l1[1], l1[2], l1[3], h1[0], h1[1], h1[2], h1[3]}, o[d0], 0, 0, 0); } while (0)
    PV_D0(0); PV_D0(1); PV_D0(2); PV_D0(3);
#undef PV_D0
}
template <class RowPtr>
__device__ __forceinline__ void store_o_bf16(const f32x16* o, const float* rscale, int r32, int hi, const RowPtr& rowp) {
#pragma unroll
    for (int r = 0; r < 16; ++r) { bf16_t* rp = rowp(crow(r, hi));
#pragma unroll
        for (int d0 = 0; d0 < 4; ++d0) { const float v = o[d0][r] * rscale[r]; const float vn = __shfl_xor(v, 1);
            if ((r32 & 1) == 0) *(unsigned*)(rp + d0 * 32 + r32) = cvt_pk_bf16(v, vn); } }
}

template <bool MASK>
__device__ __forceinline__ void sb_half(f32x16& p, float& C, int dq, int hi) {
    float om[16];
#pragma unroll
    for (int r = 0; r < 16; ++r) {
        float z = p[r] * QK_C2; z = fminf(fmaxf(z, -115.f), 115.f);
        const float e = __builtin_amdgcn_exp2f(-z); float b = __builtin_amdgcn_rcpf(1.0f + e); float o = e * b;
        if (MASK) { const bool v = ((r & 3) + 8 * (r >> 2)) < dq; b = v ? b : 0.f; o = v ? o : 1.f; }
        p[r] = b; om[r] = o; }
    float g[4], pg[4], eh[4];
#pragma unroll
    for (int c = 0; c < 4; ++c) { g[c] = (om[4 * c] * om[4 * c + 1]) * (om[4 * c + 2] * om[4 * c + 3]); pg[c] = partner_f(g[c], hi); }
    eh[3] = C; eh[2] = eh[3] * (g[3] * pg[3]); eh[1] = eh[2] * (g[2] * pg[2]); eh[0] = eh[1] * (g[1] * pg[1]); C = eh[0] * (g[0] * pg[0]);
#pragma unroll
    for (int c = 3; c >= 0; --c) { float E = hi ? eh[c] : eh[c] * pg[c];
#pragma unroll
        for (int r = 4 * c + 3; r >= 4 * c; --r) { p[r] *= E; E *= om[r]; } }
}

struct SbTensors { const bf16_t* Q; const bf16_t* K; const bf16_t* V; bf16_t* O; };
__device__ __forceinline__ void sb_unit(const SbTensors& T, int b, int head, int qb, LAS unsigned char* lds) {
    int tid = threadIdx.x; asm volatile("" : "+v"(tid));
    const int wid = __builtin_amdgcn_readfirstlane(tid >> 6), lane = tid & 63, r32 = lane & 31, hi = lane >> 5;
    const size_t rowbase = (size_t)b * SEQ;
    const int q0 = qb * 256 + wid * 32;
    const int tq = q0 + r32;
    bf16x8 qr[8];
    { const bf16_t* qp = T.Q + (rowbase + tq) * WB + head * HD + hi * 8;
#pragma unroll
      for (int d0 = 0; d0 < 8; ++d0) qr[d0] = *(const bf16x8*)(qp + d0 * 16); }
    const bf16_t* Kh = T.K + rowbase * WB + head * HD; const bf16_t* Vh = T.V + rowbase * WB + head * HD;
    const int sr = tid >> 4, sc = (tid & 15) * 8;
    const int kws = KSWZ(sr, sc * 2), vst0 = v_st(sr, sc), vst1 = v_st(32 + sr, sc);
    const unsigned Kl = (unsigned)(uintptr_t)lds, Vl = Kl + 32768u, vrb = (unsigned)v_rd_base(lane);
    f32x16 o[4] = {}; float C = 1.0f;
    const int NT = 4 * qb + 4;
    bf16x8 sk0, sk1, sv0, sv1;
#define SB_LOAD(jt) do { const bf16_t* kp = Kh + (size_t)((jt) * 64 + sr) * WB + sc; const bf16_t* vp = Vh + (size_t)((jt) * 64 + sr) * WB + sc; \
        sk0 = *(const bf16x8*)kp; sk1 = *(const bf16x8*)(kp + 32 * WB); sv0 = *(const bf16x8*)vp; sv1 = *(const bf16x8*)(vp + 32 * WB); } while (0)
#define SB_WRITE(bf) do { *(LAS bf16x8*)(lds + (bf) * 16384 + kws) = sk0; *(LAS bf16x8*)(lds + (bf) * 16384 + kws + 32 * 256) = sk1; \
        *(LAS bf16x8*)(lds + 32768 + (bf) * 16384 + vst0) = sv0; *(LAS bf16x8*)(lds + 32768 + (bf) * 16384 + vst1) = sv1; } while (0)
    SB_LOAD(NT - 1); SB_WRITE(0);
    __syncthreads();
    for (int it = 0; it < NT; ++it) {
        const int jt = NT - 1 - it, bf = it & 1, kb = jt * 64;
        if (it + 1 < NT) SB_LOAD(jt - 1);
        if (kb <= q0 + 30) {
            const unsigned ka = Kl + bf * 16384u, va = Vl + bf * 16384u + vrb;
            f32x16 p0, p1; bf16x8 pa0, pa1, pa2, pa3;
            qkt32(p0, ka, r32, hi, qr); qkt32(p1, ka + 32 * 256, r32, hi, qr);
            if (kb + 63 >= q0) { sb_half<true>(p1, C, tq - kb - 32 - 4 * hi, hi); sb_half<true>(p0, C, tq - kb - 4 * hi, hi); }
            else { sb_half<false>(p1, C, 0, hi); sb_half<false>(p0, C, 0, hi); }
            PK4(p0, 0, pa0); PK4(p0, 8, pa1); PK4(p1, 0, pa2); PK4(p1, 8, pa3);
            pv32(o, va, pa0, pa1); pv32(o, va + 8192, pa2, pa3);
        }
        if (it + 1 < NT) SB_WRITE(bf ^ 1);
        __syncthreads();
    }
#undef SB_LOAD
#undef SB_WRITE
    float ones[16];
#pragma unroll
    for (int r = 0; r < 16; ++r) ones[r] = 1.0f;
    bf16_t* Ob = T.O + (rowbase + q0) * WB + head * HD;
    store_o_bf16(o, ones, r32, hi, [&](int row) { return Ob + (size_t)row * WB; });
}

struct DaTensors { const bf16_t* Q; const bf16_t* K; const bf16_t* V; bf16_t* PO; float* PL; };
__device__ __forceinline__ void da_job(const DaTensors& T, int b, int h, int g, int rho, int u0, LAS unsigned char* wl, LAS float* ws) {
    int lane = threadIdx.x & 63; asm volatile("" : "+v"(lane));
    const int r32 = lane & 31, hi = lane >> 5;
    const int dsh = 2 * g, dil = 1 << dsh;
    const size_t rowbase = (size_t)b * SEQ; const int colh = g * 512 + h * HD;
    bf16x8 qr[8];
    { const bf16_t* qp = T.Q + (rowbase + (size_t)(((u0 + r32) << dsh) + rho)) * WA + colh + hi * 8;
#pragma unroll
      for (int d0 = 0; d0 < 8; ++d0) qr[d0] = *(const bf16x8*)(qp + d0 * 16); }
    const unsigned Kl = (unsigned)(uintptr_t)wl, Vl = Kl + 8192u + (unsigned)v_rd_base(lane);
    LAS float* al_l = ws; LAS float* li_l = ws + 32;
    f32x16 o[4] = {}; float m_reg = -1e30f, l_reg = 0.f;
    const int srow = lane >> 4, sc = (lane & 15) * 8;
    for (int tau = 0; tau < 5; ++tau) {
        const int ub = u0 - 128 + 32 * tau;
        if (ub < 0) continue;
        { bf16x8 kk[8];
#pragma unroll
        for (int c = 0; c < 8; ++c) { const int ki = srow + 4 * c; const size_t ro = (rowbase + (size_t)(((ub + ki) << dsh) + rho)) * WA + colh + sc; kk[c] = *(const bf16x8*)(T.K + ro); }
#pragma unroll
        for (int c = 0; c < 8; ++c) { const int ki = srow + 4 * c; *(LAS bf16x8*)(wl + KSWZ(ki, sc * 2)) = kk[c]; } }
        asm volatile("" ::: "memory");
        { bf16x8 vv[8];
#pragma unroll
        for (int c = 0; c < 8; ++c) { const int ki = srow + 4 * c; const size_t ro = (rowbase + (size_t)(((ub + ki) << dsh) + rho)) * WA + colh + sc; vv[c] = *(const bf16x8*)(T.V + ro); }
#pragma unroll
        for (int c = 0; c < 8; ++c) { const int ki = srow + 4 * c; *(LAS bf16x8*)(wl + 8192 + v_st(ki, sc)) = vv[c]; } }
        asm volatile("s_waitcnt lgkmcnt(0)" ::: "memory"); SBAR();
        f32x16 p; qkt32(p, Kl, r32, hi, qr);
        if (tau == 0 || tau == 4) { const int dq = u0 + r32 - ub - 4 * hi; const float NEG = -__builtin_inff();
#pragma unroll
            for (int r = 0; r < 16; ++r) { const int c = (r & 3) + 8 * (r >> 2); if ((unsigned)(dq - c) >= 129u) p[r] = NEG; } }
        float pmax = p[0];
#pragma unroll
        for (int r = 1; r < 16; ++r) pmax = fmaxf(pmax, p[r]);
        pmax = fmaxf(pmax, partner_f(pmax, hi));
        float alpha = 1.f;
        if (!__all((pmax - m_reg) * QK_C2 <= 8.0f * LOG2E)) {
            const float mn = fmaxf(m_reg, pmax); alpha = __builtin_amdgcn_exp2f((m_reg - mn) * QK_C2); m_reg = mn;
            if (hi == 0) al_l[r32] = alpha; asm volatile("s_waitcnt lgkmcnt(0)" ::: "memory");
#pragma unroll
            for (int r = 0; r < 16; ++r) { const float a = al_l[crow(r, hi)];
#pragma unroll
                for (int d0 = 0; d0 < 4; ++d0) o[d0][r] *= a; }
        }
        const float mnL = -m_reg * QK_C2; float ps = 0.f;
#pragma unroll
        for (int r = 0; r < 16; ++r) { p[r] = __builtin_amdgcn_exp2f(fmaf(p[r], QK_C2, mnL)); ps += p[r]; }
        ps += partner_f(ps, hi);
        l_reg = l_reg * alpha + ps;
        bf16x8 pa0, pa1; PK4(p, 0, pa0); PK4(p, 8, pa1);
        pv32(o, Vl, pa0, pa1);
    }
    if (hi == 0) li_l[r32] = l_reg; asm volatile("s_waitcnt lgkmcnt(0)" ::: "memory");
    float rli[16];
#pragma unroll
    for (int r = 0; r < 16; ++r) rli[r] = __builtin_amdgcn_rcpf(li_l[crow(r, hi)]);
    bf16_t* Pg = T.PO + (size_t)g * MTOK * 512 + h * HD;
    store_o_bf16(o, rli, r32, hi, [&](int row) { return Pg + (rowbase + (size_t)(((u0 + row) << dsh) + rho)) * 512; });
    if (hi == 0) T.PL[((size_t)g * MTOK + rowbase + (size_t)(((u0 + r32) << dsh) + rho)) * 4 + h] = m_reg * QK_C2 + __builtin_amdgcn_logf(l_reg);
}
__device__ __forceinline__ void da_unit(const DaTensors& T, bf16_t* OA, int b, int h, int chunk, LAS unsigned char* lds, LAS float* wscr) {
    int tid = threadIdx.x; asm volatile("" : "+v"(tid)); const int wid = __builtin_amdgcn_readfirstlane(tid >> 6);
    for (int jj = 0; jj < 6; ++jj) {
        const int job = wid + 8 * jj, g = job >> 4, idx = job & 15;
        int rho, u0;
        if (g == 0) { rho = 0; u0 = chunk * 512 + 32 * idx; }
        else if (g == 1) { rho = idx >> 2; u0 = chunk * 128 + 32 * (idx & 3); }
        else { rho = idx; u0 = chunk * 32; }
        da_job(T, b, h, g, rho, u0, lds + wid * 16384, wscr + wid * 64);
    }
    asm volatile("s_waitcnt vmcnt(0)" ::: "memory");
    __syncthreads();
    const size_t rowbase = (size_t)b * SEQ + (size_t)chunk * 512;
    for (int it = tid; it < 512 * 16; it += 512) {
        const int tk = it >> 4, ch = it & 15; const size_t row = rowbase + tk;
        const float l0 = T.PL[(0 * (size_t)MTOK + row) * 4 + h], l1 = T.PL[(1 * (size_t)MTOK + row) * 4 + h], l2 = T.PL[(2 * (size_t)MTOK + row) * 4 + h];
        const float mx = fmaxf(l0, fmaxf(l1, l2));
        float w0 = __builtin_amdgcn_exp2f(l0 - mx), w1 = __builtin_amdgcn_exp2f(l1 - mx), w2 = __builtin_amdgcn_exp2f(l2 - mx);
        const float inv = 1.0f / (w0 + w1 + w2); w0 *= inv; w1 *= inv; w2 *= inv;
        const size_t off = row * 512 + h * HD + ch * 8;
        const u32x4 a = *(const u32x4*)(T.PO + off), bq = *(const u32x4*)(T.PO + (size_t)MTOK * 512 + off), c = *(const u32x4*)(T.PO + (size_t)2 * MTOK * 512 + off);
        u32x4 w;
        w.x = cvt_pk_bf16(w0 * bf_lo(a.x) + w1 * bf_lo(bq.x) + w2 * bf_lo(c.x), w0 * bf_hi(a.x) + w1 * bf_hi(bq.x) + w2 * bf_hi(c.x));
        w.y = cvt_pk_bf16(w0 * bf_lo(a.y) + w1 * bf_lo(bq.y) + w2 * bf_lo(c.y), w0 * bf_hi(a.y) + w1 * bf_hi(bq.y) + w2 * bf_hi(c.y));
        w.z = cvt_pk_bf16(w0 * bf_lo(a.z) + w1 * bf_lo(bq.z) + w2 * bf_lo(c.z), w0 * bf_hi(a.z) + w1 * bf_hi(bq.z) + w2 * bf_hi(c.z));
        w.w = cvt_pk_bf16(w0 * bf_lo(a.w) + w1 * bf_lo(bq.w) + w2 * bf_lo(c.w), w0 * bf_hi(a.w) + w1 * bf_hi(bq.w) + w2 * bf_hi(c.w));
        *(u32x4*)(OA + off) = w;
    }
    __syncthreads();
}
#undef SBAR
}
#define MK_ONE_LAUNCH 0
constexpr int NWAVES = 8;
#ifndef MK_ONE_LAUNCH
#define MK_ONE_LAUNCH 1
#endif
constexpr size_t MiB = 1u << 20;
constexpr size_t WS_CTL = 0, CTL_ZERO_BYTES = 1 * MiB;
constexpr size_t WS_ROPE = 2 * MiB;
constexpr size_t WS_WRT = 4 * MiB;
constexpr size_t WS_TOK = 5 * MiB;
constexpr size_t WS_LIST = 6 * MiB;
constexpr size_t WS_PL = 7 * MiB;
constexpr size_t WS_W = 8 * MiB;
constexpr size_t LW_IN = 0, LW_PA = LW_IN + (size_t)NIN * DM * 2, LW_PB = LW_PA + (size_t)DM * 512 * 2, LW_WO = LW_PB + (size_t)DM * 1024 * 2,
                 LW_UP = LW_WO + (size_t)DM * DM * 2, LW_DN = LW_UP + (size_t)NEXP * 1024 * DM * 2, LW_BYTES = LW_DN + (size_t)NEXP * DM * FF * 2;
static_assert(LW_BYTES == 156 * MiB, "weights per layer");
constexpr size_t WS_HB = WS_W + 2 * LW_BYTES;
constexpr size_t WS_OA = WS_HB + 64 * MiB;
constexpr size_t WS_OB = WS_OA + 16 * MiB;
constexpr size_t WS_PO = WS_OB + 32 * MiB;
constexpr size_t WS_GATES = WS_PO + 48 * MiB;
constexpr size_t WS_QKV = WS_GATES + 128 * MiB;
constexpr size_t WS_P1 = WS_QKV;
constexpr size_t WS_MRG = WS_QKV + 64 * MiB;
constexpr size_t WS_HID = WS_QKV + 144 * MiB;
constexpr size_t WS_YP = WS_QKV;
constexpr size_t WS_END = WS_QKV + 240 * MiB;
static_assert(WS_HID >= WS_YP + (size_t)36864 * DM * 2 || WS_YP >= WS_HID + (size_t)36864 * FF * 2, "YP / HID overlap");
static_assert(WS_END <= 1024 * MiB, "workspace");
constexpr int CW_TMO = 0, CW_CODE = 1, CW_BAR = 4096, CW_ECNT = 16384;
#define XB_TMO      128
#define XB_XCNT(j)  (256  + 64 * (j))
#define XB_XSUB(j)  (1280 + 64 * (j))
#define XB_XGEN(j)  (2304 + 64 * (j))
#define XB_TOP      3328
#define XB_TOPGEN   3392
#define XCD_BAR_WORDS 3456
#define XB_SPIN_CAP (1u << 18)
constexpr int RING_BYTES = 131072, LDSCTL_OFF = RING_BYTES, MISC_OFF = LDSCTL_OFF + 320, LT_OFF = LDSCTL_OFF + 1024  , WSCR_OFF = LDSCTL_OFF + 2048  ;
constexpr int LDS_BYTES = 147456;

__device__ __forceinline__ unsigned xb_ld(unsigned* p)              { return __hip_atomic_load(p, __ATOMIC_RELAXED, __HIP_MEMORY_SCOPE_AGENT); }
__device__ __forceinline__ unsigned xb_add(unsigned* p, unsigned v) { return __hip_atomic_fetch_add(p, v, __ATOMIC_RELAXED, __HIP_MEMORY_SCOPE_AGENT); }
__device__ __forceinline__ unsigned xb_xcc_id() { return (unsigned)__builtin_amdgcn_s_getreg((3 << 11) | 20) & 0xFu; }
#define XB_SPIN(cond, bar) do { unsigned _sp = 0; while (cond) { __builtin_amdgcn_s_sleep(1); \
    if ((++_sp & 255u) == 0u) { if (xb_ld(&(bar)[XB_TMO])) break; if (_sp > XB_SPIN_CAP) { atomicAdd(&(bar)[XB_TMO], 1u); break; } } } } while (0)
struct XcdBarrier { unsigned* bar; unsigned x; volatile LAS unsigned* st; };
__device__ __forceinline__ XcdBarrier xcd_barrier_post(unsigned* bar, volatile LAS unsigned* st) {
    XcdBarrier b; b.bar = bar; b.x = xb_xcc_id(); b.st = st;
    if (threadIdx.x == 0) (void)xb_add(&bar[XB_XCNT(b.x)], 1u);
    return b;
}
__device__ __forceinline__ void xcd_barrier_complete(unsigned* bar, unsigned x, unsigned& nloc, unsigned& nx) {
    const unsigned G = gridDim.x * gridDim.y * gridDim.z;
    unsigned sum, cnt, mine, sp = 0u;
    for (;;) {
        sum = 0u; cnt = 0u; mine = 0u;
#pragma unroll
        for (unsigned j = 0; j < 16; ++j) { const unsigned c = xb_ld(&bar[XB_XCNT(j)]); sum += c; cnt += (c > 0u) ? 1u : 0u; mine = (j == x) ? c : mine; }
        if (sum == G) break;
        __builtin_amdgcn_s_sleep(1);
        if ((++sp & 255u) == 0u) { if (xb_ld(&bar[XB_TMO])) break; if (sp > XB_SPIN_CAP) { atomicAdd(&bar[XB_TMO], 1u); break; } }
    }
    nloc = mine > 0u ? mine : 1u; nx = cnt > 0u ? cnt : 1u;
}
__device__ __forceinline__ void xcd_barrier(const XcdBarrier& b) {
    asm volatile("s_waitcnt vmcnt(0)" ::: "memory");
    __syncthreads();
    if (threadIdx.x == 0) {
        unsigned* bar = b.bar;
        __builtin_amdgcn_s_waitcnt(0);
        unsigned nloc = b.st[0], nx = b.st[1];
        if (nloc == 0u) { xcd_barrier_complete(bar, b.x, nloc, nx); b.st[0] = nloc; b.st[1] = nx; }
        const unsigned old = xb_add(&bar[XB_XSUB(b.x)], 1u);
        const unsigned gen = old / nloc;
        if (old + 1u == (gen + 1u) * nloc) {
            __builtin_amdgcn_fence(__ATOMIC_RELEASE, "agent");
            asm volatile("s_waitcnt vmcnt(0)" ::: "memory");
            const unsigned og = xb_add(&bar[XB_TOP], 1u);
            const unsigned tg = og / nx;
            if (og + 1u == (tg + 1u) * nx) xb_add(&bar[XB_TOPGEN], 1u);
            else XB_SPIN(xb_ld(&bar[XB_TOPGEN]) == tg, bar);
            __builtin_amdgcn_fence(__ATOMIC_ACQUIRE, "agent");
            xb_add(&bar[XB_XGEN(b.x)], 1u);
            asm volatile("s_waitcnt vmcnt(0)" ::: "memory");
        } else {
            XB_SPIN(xb_ld(&bar[XB_XGEN(b.x)]) == gen, bar);
            __builtin_amdgcn_fence(__ATOMIC_ACQUIRE, "agent");
            asm volatile("s_waitcnt vmcnt(0)" ::: "memory");
        }
    }
    __syncthreads();
}

struct Args { const float* in[14]; float* out; unsigned char* ws; int ph_lo, ph_hi; };
static_assert(sizeof(Args) == 14 * 8 + 8 + 8 + 8, "Args has no padding");

__device__ __forceinline__ float wave_sum(float v) {
#pragma unroll
    for (int o = 1; o < 64; o <<= 1) v += __shfl_xor(v, o);
    return v;
}
__device__ __forceinline__ unsigned f2bf(float f) { unsigned u = __builtin_bit_cast(unsigned, f); return (u + 0x7fffu + ((u >> 16) & 1u)) >> 16; }
__device__ __forceinline__ unsigned pk2(float lo, float hi) { return f2bf(lo) | (f2bf(hi) << 16); }

template <int MAP> __device__ __forceinline__ int wmap(int n) {
    if (MAP == 1) {
        if (n < 2 * WA) { const int d = n & 127; if (d < 32) { const int dd = (d < 16) ? (((d >> 2) << 3) + (d & 3)) : ((((d - 16) >> 2) << 3) + 4 + (d & 3)); return (n & ~127) + dd; } }
        return n;
    } else if (MAP == 2) {
        if (n < FF) return ((n >> 7) << 8) + (n & 127);
        const int j = n - FF; return ((j >> 7) << 8) + 128 + (j & 127);
    }
    return n;
}
template <int MAP>
__device__ __forceinline__ void xpose_item(const float* W, int K, int N, bf16_t* WT, LAS float* scr, int item, int lane) {
    const int nblk = N / 32, kb = item / nblk, nb = item % nblk, k0 = 64 * kb, n0 = 32 * nb;
#pragma unroll 8
    for (int i = 0; i < 32; ++i) { const int kk = 2 * i + (lane >> 5); scr[kk * 33 + (lane & 31)] = W[(size_t)(k0 + kk) * N + n0 + (lane & 31)]; }
    asm volatile("s_waitcnt lgkmcnt(0)" ::: "memory");
    const int c = lane & 7;
#pragma unroll
    for (int j = 0; j < 4; ++j) { const int n = (lane >> 3) + 8 * j; const LAS float* s = scr + (8 * c) * 33 + n;
        u32x4 o; o.x = pk2(s[0 * 33], s[1 * 33]); o.y = pk2(s[2 * 33], s[3 * 33]); o.z = pk2(s[4 * 33], s[5 * 33]); o.w = pk2(s[6 * 33], s[7 * 33]);
        *(u32x4*)(WT + (size_t)wmap<MAP>(n0 + n) * K + k0 + 8 * c) = o; }
    asm volatile("s_waitcnt lgkmcnt(0)" ::: "memory");
}
__device__ __forceinline__ int opq(int x) { asm volatile("" : "+v"(x)); return x; }
struct Frame {
    LAS unsigned char* lds; volatile LAS unsigned* MISC; unsigned* ctl; unsigned char* ws;
    int tid, lane, wave, vcu, G;
    const Args* A; float* out;
};
constexpr int I_IN = (DM / 64) * (NIN / 32), I_PA = (512 / 64) * (DM / 32), I_PB = (1024 / 64) * (DM / 32), I_WO = (DM / 64) * (DM / 32),
              I_UP1 = (DM / 64) * (1024 / 32), I_UP = NEXP * I_UP1, I_DN1 = (FF / 64) * (DM / 32), I_DN = NEXP * I_DN1, I_LAYER = I_IN + I_PA + I_PB + I_WO + I_UP + I_DN;

__device__ __forceinline__ void p0_prologue(Frame& F) {
    LAS float* scr = (LAS float*)(F.lds + F.wave * 16384);
    const int gw = F.vcu * NWAVES + F.wave, NGW = F.G * NWAVES;
    for (int it = gw; it < DEPTH * I_LAYER; it += NGW) {
        const int l = it / I_LAYER; int r = it % I_LAYER;
        bf16_t* LW = (bf16_t*)(F.ws + WS_W + (size_t)l * LW_BYTES);
        if (r < I_IN) { xpose_item<1>(F.A->in[2] + (size_t)l * DM * NIN, DM, NIN, LW + LW_IN / 2, scr, r, F.lane); continue; } r -= I_IN;
        if (r < I_PA) { xpose_item<0>(F.A->in[3] + (size_t)l * 512 * DM, 512, DM, LW + LW_PA / 2, scr, r, F.lane); continue; } r -= I_PA;
        if (r < I_PB) { xpose_item<0>(F.A->in[4] + (size_t)l * 1024 * DM, 1024, DM, LW + LW_PB / 2, scr, r, F.lane); continue; } r -= I_PB;
        if (r < I_WO) { xpose_item<0>(F.A->in[5] + (size_t)l * DM * DM, DM, DM, LW + LW_WO / 2, scr, r, F.lane); continue; } r -= I_WO;
        if (r < I_UP) { const int e = r / I_UP1; xpose_item<2>(F.A->in[12] + ((size_t)l * NEXP + e) * DM * 1024, DM, 1024, LW + LW_UP / 2 + (size_t)e * 1024 * DM, scr, r % I_UP1, F.lane); continue; } r -= I_UP;
        { const int e = r / I_DN1; xpose_item<0>(F.A->in[13] + ((size_t)l * NEXP + e) * FF * DM, FF, DM, LW + LW_DN / 2 + (size_t)e * DM * FF, scr, r % I_DN1, F.lane); }
    }
    bf16_t* HB = (bf16_t*)(F.ws + WS_HB);
    for (int m = gw; m < MTOK; m += NGW) {
        const f32x4* xr = (const f32x4*)(F.A->in[0] + (size_t)m * DM) + F.lane; unsigned long long* o8 = (unsigned long long*)(HB + (size_t)m * DM) + F.lane;
#pragma unroll
        for (int j = 0; j < 8; ++j) { const f32x4 v = xr[64 * j]; o8[64 * j] = (unsigned long long)cvt_pk_bf16(v.x, v.y) | ((unsigned long long)cvt_pk_bf16(v.z, v.w) << 32); }
    }
    {
        float* rope = (float*)(F.ws + WS_ROPE); const int* pos = (const int*)F.A->in[1];
        const int f = F.tid & 15;
        const float IF[16] = {1.0f, 0.44036659598350525f, 0.1939227432012558f, 0.08539710193872452f, 0.03760603070259094f, 0.016560440883040428f, 0.007292664609849453f, 0.0032114461064338684f,
                              0.0014142135623842478f, 0.0006227724370546639f, 0.00027424818836152554f, 0.00012076973507646471f, 5.3182957344688475e-05f, 2.34199997066753e-05f, 1.0313385246263351e-05f, 4.541670477919979e-06f};
        float inv = 0.f;
#pragma unroll
        for (int k = 0; k < 16; ++k) inv = (f == k) ? IF[k] : inv;
        for (int i = F.vcu * 512 + F.tid; i < MTOK * 16; i += F.G * 512) {
            const int row = i >> 4; const float ang = (float)pos[row] * inv;
            double rev = (double)ang * 0.15915494309189535; rev -= __builtin_rint(rev); const float rv = (float)rev;
            rope[(size_t)row * 32 + f] = __builtin_amdgcn_cosf(rv); rope[(size_t)row * 32 + 16 + f] = __builtin_amdgcn_sinf(rv);
        }
    }
    {
        float* WrT = (float*)(F.ws + WS_WRT);
        for (int i = F.vcu * 512 + F.tid; i < DEPTH * 20 * DM; i += F.G * 512) {
            const int l = i / (20 * DM), o = (i / DM) % 20, k = i % DM;
            WrT[i] = (o < 4) ? F.A->in[8][((size_t)l * DM + k) * 4 + o] : F.A->in[10][((size_t)l * DM + k) * 16 + (o - 4)];
        }
    }
}

__device__ __forceinline__ void ln1_router(Frame& F0, int l) {
    struct { LAS unsigned char* lds; unsigned* ctl; unsigned char* ws; int tid, lane, wave, vcu; const Args* A; float* out; } F;
    F.lds = F0.lds; F.ctl = F0.ctl; F.ws = F0.ws; F.tid = opq(F0.tid); F.lane = F.tid & 63; F.wave = __builtin_amdgcn_readfirstlane(F.tid >> 6); F.vcu = F0.vcu; F.A = F0.A; F.out = F0.out;
    LAS float* Wl = (LAS float*)F.lds;
    LAS float* Pt = (LAS float*)(F.lds + 81920);
    const float* gam = F.A->in[6] + (size_t)(l * 2) * DM; const float* bet = F.A->in[7] + (size_t)(l * 2) * DM;
    const float* WrT = (const float*)(F.ws + WS_WRT) + (size_t)l * 20 * DM;
    bf16_t* HB = (bf16_t*)(F.ws + WS_HB);
    const int row0 = F.vcu * 64;
    for (int pass = 0; pass < 2; ++pass) {
        for (int i = F.tid; i < 20 * 256; i += 512) { const int o = i >> 8, k4 = i & 255; *(LAS f32x4*)(Wl + o * 1024 + 4 * k4) = *(const f32x4*)(WrT + (size_t)o * DM + pass * 1024 + 4 * k4); }
        __syncthreads();
        for (int i = 0; i < 8; ++i) {
            const int rl = F.wave * 8 + i, row = row0 + rl;
            f32x4* xr = (f32x4*)(F.out + (size_t)row * DM) + F.lane;
            f32x4 v[8]; float s = 0.f;
#pragma unroll
            for (int j = 0; j < 8; ++j) { v[j] = xr[64 * j]; s += (v[j].x + v[j].y) + (v[j].z + v[j].w); }
            const float mean = wave_sum(s) * (1.f / DM); float s2 = 0.f;
#pragma unroll
            for (int j = 0; j < 8; ++j) { v[j] = v[j] - mean; s2 += (v[j].x * v[j].x + v[j].y * v[j].y) + (v[j].z * v[j].z + v[j].w * v[j].w); }
            const float rstd = 1.f / sqrtf(wave_sum(s2) * (1.f / DM) + LN_EPS);
#pragma unroll
            for (int j = 0; j < 8; ++j) { const f32x4 g4 = ((const f32x4*)gam)[F.lane + 64 * j], b4 = ((const f32x4*)bet)[F.lane + 64 * j]; v[j] = v[j] * rstd * g4 + b4; }
            if (pass == 1) {
                unsigned long long* o8 = (unsigned long long*)(HB + (size_t)row * DM) + F.lane;
#pragma unroll
                for (int j = 0; j < 8; ++j) { xr[64 * j] = v[j]; o8[64 * j] = (unsigned long long)cvt_pk_bf16(v[j].x, v[j].y) | ((unsigned long long)cvt_pk_bf16(v[j].z, v[j].w) << 32); }
            }
            float acc[20];
#pragma unroll
            for (int o = 0; o < 20; ++o) acc[o] = 0.f;
#pragma unroll
            for (int jj = 0; jj < 4; ++jj) { const f32x4 x = pass == 0 ? v[jj] : v[4 + jj];
#pragma unroll
                for (int o = 0; o < 20; ++o) { const f32x4 w = *(const LAS f32x4*)(Wl + o * 1024 + 4 * F.lane + 256 * jj); acc[o] += (x.x * w.x + x.y * w.y) + (x.z * w.z + x.w * w.w); } }
            float mine = 0.f;
#pragma unroll
            for (int o = 0; o < 20; ++o) { const float t = wave_sum(acc[o]); mine = (F.lane == o) ? t : mine; }
            if (F.lane < 20) { if (pass == 0) Pt[rl * 20 + F.lane] = mine; else Pt[rl * 20 + F.lane] += mine; }
        }
        __syncthreads();
    }
    if (F.wave == 0) {
        const int rl = F.lane, row = row0 + rl;
        const float* cb = F.A->in[9] + l * 4; const float* fb = F.A->in[11] + l * 16;
        float c[4], f[16];
#pragma unroll
        for (int j = 0; j < 4; ++j) c[j] = Pt[rl * 20 + j] + cb[j];
#pragma unroll
        for (int j = 0; j < 16; ++j) f[j] = Pt[rl * 20 + 4 + j] + fb[j];
        float cmax = c[0]; int g = 0;
#pragma unroll
        for (int j = 1; j < 4; ++j) if (c[j] > cmax) { cmax = c[j]; g = j; }
        float se = 0.f;
#pragma unroll
        for (int j = 0; j < 4; ++j) se += __expf(c[j] - cmax);
        const float pgrp = 1.0f / se;
        float sel[4];
#pragma unroll
        for (int i = 0; i < 4; ++i) sel[i] = (g == 0) ? f[i] : (g == 1) ? f[4 + i] : (g == 2) ? f[8 + i] : f[12 + i];
        float v1 = sel[0]; int i1 = 0;
#pragma unroll
        for (int i = 1; i < 4; ++i) if (sel[i] > v1) { v1 = sel[i]; i1 = i; }
        float v2 = -__builtin_inff(); int i2 = 0;
#pragma unroll
        for (int i = 0; i < 4; ++i) if (i != i1 && sel[i] > v2) { v2 = sel[i]; i2 = i; }
        const float w1 = 1.0f / (1.0f + __expf(v2 - v1)), w2 = 1.0f - w1;
        const int e1 = 4 * g + i1, e2 = 4 * g + i2;
        const unsigned long long lt = (1ull << F.lane) - 1ull;
        int r1 = 0, r2 = 0, mycnt = 0;
#pragma unroll
        for (int e = 0; e < NEXP; ++e) { const unsigned long long m1 = __ballot(e1 == e), m2 = __ballot(e2 == e); const int c1 = __popcll(m1);
            if (e1 == e) r1 = __popcll(m1 & lt); if (e2 == e) r2 = c1 + __popcll(m2 & lt); if (F.lane == e) mycnt = c1 + __popcll(m2); }
        int base = 0;
        if (F.lane < NEXP && mycnt > 0) base = (int)__hip_atomic_fetch_add(F.ctl + CW_ECNT + 64 * l + F.lane, (unsigned)mycnt, __ATOMIC_RELAXED, __HIP_MEMORY_SCOPE_AGENT);
        const int pos1 = __shfl(base, e1) + r1, pos2 = __shfl(base, e2) + r2;
        int* list = (int*)(F.ws + WS_LIST);
        list[e1 * ECAP + pos1] = row; list[e2 * ECAP + pos2] = row;
        ((u32x4*)(F.ws + WS_TOK))[row] = (u32x4){(unsigned)(e1 << 16 | pos1), __float_as_uint(pgrp * w1), (unsigned)(e2 << 16 | pos2), __float_as_uint(pgrp * w2)};
    }
    __syncthreads();
}
__device__ __forceinline__ void moe_tables(Frame& F, int l) {
    LAS int* LT = (LAS int*)(F.lds + LT_OFF);
    if (F.tid == 0) { int t = 0;
        for (int e = 0; e < NEXP; ++e) { const int c = (int)__hip_atomic_load(F.ctl + CW_ECNT + 64 * l + e, __ATOMIC_RELAXED, __HIP_MEMORY_SCOPE_AGENT); LT[e] = t; LT[32 + e] = c; t += (c + 255) >> 8; }
        LT[16] = t; }
    __syncthreads();
    if (F.tid < 160) { const int rt = F.tid; int e = 0;
#pragma unroll
        for (int j = 1; j < NEXP; ++j) e += (LT[j] <= rt) ? 1 : 0;
        LT[64 + rt] = e; }
    __syncthreads();
}
__device__ __forceinline__ void ln2_phase(Frame& F0, int l) {
    struct { LAS unsigned char* lds; unsigned char* ws; int lane, wave, vcu, G; const Args* A; float* out; } F;
    F.lds = F0.lds; F.ws = F0.ws; { const int t = opq(F0.tid); F.lane = t & 63; F.wave = __builtin_amdgcn_readfirstlane(t >> 6); } F.vcu = F0.vcu; F.G = F0.G; F.A = F0.A; F.out = F0.out;
    const LAS int* LT = (const LAS int*)(F.lds + LT_OFF);
    const float* gam = F.A->in[6] + (size_t)(l * 2 + 1) * DM; const float* bet = F.A->in[7] + (size_t)(l * 2 + 1) * DM;
    bf16_t* HB = (bf16_t*)(F.ws + WS_HB); const bf16_t* YP = (const bf16_t*)(F.ws + WS_YP);
    const int gw = F.vcu * NWAVES + F.wave, NGW = F.G * NWAVES;
    for (int row = gw; row < MTOK; row += NGW) {
        const u32x4 ti = ((const u32x4*)(F.ws + WS_TOK))[row];
        const int e1 = ti.x >> 16, p1 = ti.x & 0xffff, e2 = ti.z >> 16, p2 = ti.z & 0xffff; const float g1 = __uint_as_float(ti.y), g2 = __uint_as_float(ti.w);
        const size_t s1 = (size_t)LT[e1] * 256 + p1, s2 = (size_t)LT[e2] * 256 + p2;
        f32x4* xr = (f32x4*)(F.out + (size_t)row * DM) + F.lane;
        const u32x2* y1 = (const u32x2*)(YP + s1 * DM) + F.lane; const u32x2* y2 = (const u32x2*)(YP + s2 * DM) + F.lane;
        f32x4 v[8]; float s = 0.f;
#pragma unroll
        for (int j = 0; j < 8; ++j) { const f32x4 h = xr[64 * j]; const u32x2 a = y1[64 * j], b = y2[64 * j];
            v[j].x = ALPHA * h.x + g1 * bf_lo(a.x) + g2 * bf_lo(b.x); v[j].y = ALPHA * h.y + g1 * bf_hi(a.x) + g2 * bf_hi(b.x);
            v[j].z = ALPHA * h.z + g1 * bf_lo(a.y) + g2 * bf_lo(b.y); v[j].w = ALPHA * h.w + g1 * bf_hi(a.y) + g2 * bf_hi(b.y);
            s += (v[j].x + v[j].y) + (v[j].z + v[j].w); }
        const float mean = wave_sum(s) * (1.f / DM); float s2v = 0.f;
#pragma unroll
        for (int j = 0; j < 8; ++j) { v[j] = v[j] - mean; s2v += (v[j].x * v[j].x + v[j].y * v[j].y) + (v[j].z * v[j].z + v[j].w * v[j].w); }
        const float rstd = 1.f / sqrtf(wave_sum(s2v) * (1.f / DM) + LN_EPS);
        unsigned long long* o8 = (unsigned long long*)(HB + (size_t)row * DM) + F.lane;
#pragma unroll
        for (int j = 0; j < 8; ++j) { const f32x4 g4 = ((const f32x4*)gam)[F.lane + 64 * j], b4 = ((const f32x4*)bet)[F.lane + 64 * j]; const f32x4 o = v[j] * rstd * g4 + b4;
            xr[64 * j] = o; if (l + 1 < DEPTH) o8[64 * j] = (unsigned long long)cvt_pk_bf16(o.x, o.y) | ((unsigned long long)cvt_pk_bf16(o.z, o.w) << 32); }
    }
}

constexpr int N_PHASES = 1 + 8 * DEPTH;
__global__ void __launch_bounds__(NWAVES * 64, 2) mk_fwd(Args args) {
    extern __shared__ __attribute__((aligned(16))) unsigned char lds_raw[];
    Frame F;
    F.lds = (LAS unsigned char*)lds_raw; F.MISC = (volatile LAS unsigned*)(F.lds + MISC_OFF);
    F.tid = threadIdx.x; F.lane = F.tid & 63; F.wave = __builtin_amdgcn_readfirstlane(F.tid >> 6);
    F.G = gridDim.x; { const int bx = blockIdx.x; F.vcu = (F.G % 8 == 0) ? (bx % 8) * (F.G / 8) + bx / 8 : bx; }
    F.ws = args.ws; F.ctl = (unsigned*)(args.ws + WS_CTL); F.out = args.out;
    F.A = &args;
    for (int u = F.tid; u < (LDS_BYTES - LDSCTL_OFF) / 4; u += NWAVES * 64) ((LAS unsigned*)(F.lds + LDSCTL_OFF))[u] = 0u;
    __syncthreads();
    const int lo = args.ph_lo, hi = args.ph_hi;
    XcdBarrier bar; bar.bar = F.ctl + CW_BAR; bar.x = 0; bar.st = nullptr;
    if (hi - lo > 1) bar = xcd_barrier_post(F.ctl + CW_BAR, F.MISC + 8);
#ifndef PHMASK
#define PHMASK 0x1ff
#endif
#define IN(k) (lo <= (k) && (k) < hi)
#define PH(s) ((PHMASK >> (s)) & 1)
#define SEAM(k) do { if (IN(k) && IN((k) + 1)) xcd_barrier(bar); } while (0)
    if (PH(0) && IN(0)) { p0_prologue(F); SEAM(0); }
    bf16_t* HB = (bf16_t*)(F.ws + WS_HB);
    bf16_t* QKV = (bf16_t*)(F.ws + WS_QKV); bf16_t* GATES = (bf16_t*)(F.ws + WS_GATES);
    bf16_t* OA = (bf16_t*)(F.ws + WS_OA); bf16_t* OB = (bf16_t*)(F.ws + WS_OB);
    for (int l = 0; l < DEPTH; ++l) {
        const int pb = 1 + 8 * l;
        const bf16_t* LW = (const bf16_t*)(F.ws + WS_W + (size_t)l * LW_BYTES);
        if (PH(1) && IN(pb + 0)) {
            pg8::Gemm g{HB, LW + LW_IN / 2, DM}; pg8::StaticOrder S; S.init(MTOK, NIN, F.G, (int)blockIdx.x);
            pg8::EpiProj E{QKV, GATES, (const float*)(F.ws + WS_ROPE)};
            pg8::gemm_phase<pg8::EpiProj, pg8::StaticOrder, true, false>(F.lds, g, S, E);
            SEAM(pb + 0);
        }
        if (PH(2) && IN(pb + 1)) {
            att::SbTensors TB{QKV + (size_t)3 * MTOK * WA, QKV + (size_t)3 * MTOK * WA + (size_t)MTOK * WB, QKV + (size_t)3 * MTOK * WA + (size_t)2 * MTOK * WB, OB};
            for (int c = F.vcu; c < 256; c += F.G) { const int bh = c >> 2, pr = c & 3;
                att::sb_unit(TB, bh >> 3, bh & 7, 7 - pr, F.lds); att::sb_unit(TB, bh >> 3, bh & 7, pr, F.lds); }
            att::DaTensors TA{QKV, QKV + (size_t)MTOK * WA, QKV + (size_t)2 * MTOK * WA, (bf16_t*)(F.ws + WS_PO), (float*)(F.ws + WS_PL)};
            for (int a = F.vcu; a < 128; a += F.G) att::da_unit(TA, OA, a >> 4, (a >> 2) & 3, a & 3, F.lds, (LAS float*)(F.lds + WSCR_OFF));
            SEAM(pb + 1);
        }
        if (PH(3) && IN(pb + 2)) {
            bf16_t* P1 = (bf16_t*)(F.ws + WS_P1); bf16_t* MRG = (bf16_t*)(F.ws + WS_MRG);
            pg8::StaticOrder S; S.init(MTOK, DM, F.G, (int)blockIdx.x);
            { pg8::Gemm g{OA, LW + LW_PA / 2, 512}; pg8::EpiGate<false> E{GATES, P1, MRG}; pg8::gemm_phase<pg8::EpiGate<false>, pg8::StaticOrder, true, false>(F.lds, g, S, E); }
            { pg8::Gemm g{OB, LW + LW_PB / 2, 1024}; pg8::EpiGate<true> E{GATES + (size_t)MTOK * DM, P1, MRG}; pg8::gemm_phase<pg8::EpiGate<true>, pg8::StaticOrder, true, false>(F.lds, g, S, E); }
            SEAM(pb + 2);
        }
        if (PH(4) && IN(pb + 3)) {
            pg8::Gemm g{(const bf16_t*)(F.ws + WS_MRG), LW + LW_WO / 2, DM}; pg8::StaticOrder S; S.init(MTOK, DM, F.G, (int)blockIdx.x);
            pg8::EpiResid E{l == 0 ? F.A->in[0] : F.out, F.out};
            pg8::gemm_phase<pg8::EpiResid, pg8::StaticOrder, true, false>(F.lds, g, S, E);
            SEAM(pb + 3);
        }
        if (PH(5) && IN(pb + 4)) { ln1_router(F, l); SEAM(pb + 4); }
        if (PH(6) && IN(pb + 5)) {
            moe_tables(F, l);
            const LAS int* LT = (const LAS int*)(F.lds + LT_OFF);
            pg8::MoeOrder S{4, F.G, F.vcu, LT[16] * 4, LT, LT + 32, (const int*)(F.ws + WS_LIST)};
            pg8::Gemm g{HB, LW + LW_UP / 2, DM}; pg8::EpiSwiglu E{(bf16_t*)(F.ws + WS_HID)};
            pg8::gemm_phase<pg8::EpiSwiglu, pg8::MoeOrder, true, true>(F.lds, g, S, E);
            SEAM(pb + 5);
        }
        if (PH(7) && IN(pb + 6)) {
            moe_tables(F, l);
            const LAS int* LT = (const LAS int*)(F.lds + LT_OFF);
            pg8::MoeOrder S{8, F.G, F.vcu, LT[16] * 8, LT, LT + 32, (const int*)(F.ws + WS_LIST)};
            pg8::Gemm g{(const bf16_t*)(F.ws + WS_HID), LW + LW_DN / 2, FF}; pg8::EpiBf16 E{(bf16_t*)(F.ws + WS_YP), DM};
            pg8::gemm_phase<pg8::EpiBf16, pg8::MoeOrder, true, false>(F.lds, g, S, E);
            SEAM(pb + 6);
        }
        if (PH(8) && IN(pb + 7)) { moe_tables(F, l); ln2_phase(F, l); SEAM(pb + 7); }
    }
#undef IN
#undef SEAM
}

extern "C" void kernel_launch(void* const* d_in, const int* in_sizes, int n_in, void* d_out, int out_size, void* d_ws, size_t ws_size, hipStream_t stream) {
    static int grid = 0;
    if (grid == 0) {
        if (n_in != 14 || in_sizes[0] != MTOK * DM || out_size != MTOK * DM || ws_size < WS_END) { fprintf(stderr, "kernel_launch: unexpected shapes (n_in %d, in0 %d, out %d, ws %zu)\n", n_in, n_in > 0 ? in_sizes[0] : -1, out_size, ws_size); grid = -1; return; }
        int dev = 0, cus = 0;
        if (hipGetDevice(&dev) != hipSuccess || hipDeviceGetAttribute(&cus, hipDeviceAttributeMultiprocessorCount, dev) != hipSuccess) { grid = -1; return; }
        if (hipFuncSetAttribute((const void*)mk_fwd, hipFuncAttributeMaxDynamicSharedMemorySize, LDS_BYTES) != hipSuccess) { fprintf(stderr, "kernel_launch: hipFuncSetAttribute failed\n"); grid = -1; return; }
        int per_cu = 0;
        if (hipOccupancyMaxActiveBlocksPerMultiprocessor(&per_cu, (const void*)mk_fwd, NWAVES * 64, LDS_BYTES) != hipSuccess || per_cu < 1) fprintf(stderr, "kernel_launch: occupancy query reports %d\n", per_cu);
        (void)hipGetLastError();
        if (cus < 256) { fprintf(stderr, "kernel_launch: needs 256 CUs, device has %d\n", cus); grid = -1; return; }
        grid = 256;
    }
    if (grid < 0) return;
    if (hipMemsetAsync((char*)d_ws + WS_CTL, 0, CTL_ZERO_BYTES, stream) != hipSuccess) return;
    Args a{};
    for (int i = 0; i < 14; ++i) a.in[i] = (const float*)d_in[i];
    a.out = (float*)d_out; a.ws = (unsigned char*)d_ws;
#if MK_ONE_LAUNCH
    a.ph_lo = 0; a.ph_hi = N_PHASES;
    hipLaunchKernelGGL(mk_fwd, dim3(grid), dim3(NWAVES * 64), LDS_BYTES, stream, a);
#else
    for (int p = 0; p < N_PHASES; ++p) { a.ph_lo = p; a.ph_hi = p + 1; hipLaunchKernelGGL(mk_fwd, dim3(grid), dim3(NWAVES * 64), LDS_BYTES, stream, a); }
#endif
}
```

```cpp
#include <hip/hip_runtime.h>
#include <cstdio>
#include <cstdint>

#define LAS __attribute__((address_space(3)))
#define GAS __attribute__((address_space(1)))
typedef unsigned short bf16_t;
typedef short bf16x8 __attribute__((ext_vector_type(8)));
typedef short s16x4 __attribute__((ext_vector_type(4)));
typedef float f32x4 __attribute__((ext_vector_type(4)));
typedef float f32x2 __attribute__((ext_vector_type(2)));
typedef float f32x16 __attribute__((ext_vector_type(16)));
typedef unsigned u32x4 __attribute__((ext_vector_type(4)));
typedef unsigned u32x2 __attribute__((ext_vector_type(2)));

constexpr int BATCH = 8, SEQ = 2048, DM = 2048, DEPTH = 2, MTOK = BATCH * SEQ;
constexpr int HD = 128, WA = 1536, WB = 1024, NIN = 11776;
constexpr int NEXP = 16, FF = 512, ECAP = 16384;
constexpr float LN_EPS = 1e-5f;
constexpr float ALPHA = 1.4142135623730951f;
constexpr float LOG2E = 1.4426950408889634f;
constexpr float QK_C2 = 0.08838834764831845f * LOG2E;

__device__ __forceinline__ unsigned cvt_pk_bf16(float lo, float hi) { unsigned r; asm volatile("v_cvt_pk_bf16_f32 %0, %1, %2" : "=v"(r) : "v"(lo), "v"(hi)); return r; }
__device__ __forceinline__ float bf_lo(unsigned w) { return __uint_as_float(w << 16); }
__device__ __forceinline__ float bf_hi(unsigned w) { return __uint_as_float(w & 0xffff0000u); }
__device__ __forceinline__ float sigmoidf_fast(float x) { return __builtin_amdgcn_rcpf(1.0f + __builtin_amdgcn_exp2f(-x * LOG2E)); }

namespace pg8 {
constexpr int BM = 256, BK = 64, HALF = 128, HTB = HALF * BK * 2, STAGE_BYTES = 8 * HTB, NXCD = 8, WGM = 8;
__host__ __device__ __forceinline__ int lds_byte(int r, int c) { const int st = (r >> 4) * 2 + (c >> 5), rr = r & 15, cc = c & 31, ob = rr * 64 + cc * 2; return st * 1024 + (ob ^ (((ob >> 9) & 1) << 5)); }
__host__ __device__ __forceinline__ void stage_rc(int b, int& R, int& C) { const int st = b / 1024, sb = b % 1024, swz = sb ^ (((sb >> 9) & 1) << 5); R = (st >> 1) * 16 + swz / 64; C = (st & 1) * 32 + (swz % 64) / 2; }
__host__ __device__ __forceinline__ int perm32(int rho) { const int n = rho >> 4, i = rho & 15; return 8 * (i >> 2) + 4 * n + (i & 3); }

struct Unit { int pm, pn, pb, e, r0; };
struct Gemm { const bf16_t* A; const bf16_t* Bt; int K; };

struct StaticOrder {
    int nM, nN, nwg, G, c;
    __device__ void init(int M, int N, int G_, int c_) { nM = M / BM; nN = N / BM; nwg = nM * nN; G = G_; c = c_; }
    __device__ bool next(int i, Unit& u) const {
        const long L = (long)i * G + c; if (L >= nwg) return false;
        int wgid = (int)L; { const int q = nwg / NXCD, r = nwg % NXCD, xcd = wgid % NXCD, off = wgid / NXCD; wgid = (xcd < r ? xcd * (q + 1) : r * (q + 1) + (xcd - r) * q) + off; }
        const int nig = WGM * nN, gid = wgid / nig, fm = gid * WGM, gsz = (nM - fm) < WGM ? (nM - fm) : WGM;
        u.pm = fm + ((wgid % nig) % gsz); u.pn = (wgid % nig) / gsz; u.pb = u.pn; u.e = 0; u.r0 = 0; return true;
    }
    __device__ __forceinline__ int tok(const Unit&, int) const { return 0; }
};
struct MoeOrder {
    int nct, G, c, total; const LAS int* tb; const LAS int* cnt; const int* list;
    __device__ bool next(int i, Unit& u) const {
        const long L = (long)i * G + c; if (L >= total) return false;
        const int rt = (int)L / nct, ct = (int)L % nct; const int e = __builtin_amdgcn_readfirstlane(tb[64 + rt]);
        u.pm = rt; u.pn = ct; u.pb = e * nct + ct; u.e = e; u.r0 = (rt - __builtin_amdgcn_readfirstlane(tb[e])) * BM; return true;
    }
    __device__ __forceinline__ int tok(const Unit& u, int row) const { const int cn = cnt[u.e]; int pos = u.r0 + row; pos = pos < cn ? pos : cn - 1; return list[u.e * ECAP + pos]; }
};

template <class Epi, class Sched, bool ALIGN_EPI, bool GATHER>
__device__ __forceinline__ void gemm_phase(LAS unsigned char* lds, const Gemm g, const Sched& S, const Epi& E) {
    int tid = threadIdx.x; asm volatile("" : "+v"(tid));
    const int wid = __builtin_amdgcn_readfirstlane(tid >> 6), lane = tid & 63, wr = wid >> 2, wc = wid & 3, fr = lane & 15, fq = lane >> 4;
    const int K = g.K, nt = K / BK;
    const size_t kstep = (size_t)(BK * 2);
    const size_t hstep = (size_t)HALF * K * 2;
    const size_t tstep = 2 * hstep;
    int RA[2], CA[2]; unsigned voffB[2];
#pragma unroll
    for (int i = 0; i < 2; ++i) { int R, C; stage_rc(tid * 16 + i * 8192, R, C); const int Rb = Epi::PERM ? ((R & ~31) + perm32(R & 31)) : R; RA[i] = R; CA[i] = C; voffB[i] = (unsigned)(Rb * K + C) * 2u; }
    const unsigned ldsw = (unsigned)wid * 1024u;
    const int aoff = lds_byte(wr * 64 + fr, fq * 8), boff = lds_byte(wc * 32 + fr, fq * 8);
#define PG8_SA(b, h) (((b) * 2 + (h)) * HTB)
#define PG8_SB(b, h) ((4 + (b) * 2 + (h)) * HTB)
#define PG8_STAGE(bufoff, gbase, v0, v1) do { \
        __builtin_amdgcn_global_load_lds((const unsigned*)((const char*)(gbase) + (v0)), (LAS unsigned*)(lds + (bufoff) + ldsw), 16, 0, 0); \
        __builtin_amdgcn_global_load_lds((const unsigned*)((const char*)(gbase) + (v1)), (LAS unsigned*)(lds + (bufoff) + ldsw + 8192), 16, 0, 0); } while (0)
#define PG8_LDA(dst, b, h) do { _Pragma("unroll") for (int m = 0; m < 4; ++m) _Pragma("unroll") for (int k = 0; k < 2; ++k) dst[m][k] = *(const LAS bf16x8*)(lds + PG8_SA(b, h) + aoff + m * 2048 + k * 1024); } while (0)
#define PG8_LDB(dst, b, h) do { _Pragma("unroll") for (int n = 0; n < 2; ++n) _Pragma("unroll") for (int k = 0; k < 2; ++k) dst[n][k] = *(const LAS bf16x8*)(lds + PG8_SB(b, h) + boff + n * 2048 + k * 1024); } while (0)
#define PG8_MMA(ai, bj, At, Bt) do { __builtin_amdgcn_s_setprio(1); _Pragma("unroll") for (int m = 0; m < 4; ++m) _Pragma("unroll") for (int n = 0; n < 2; ++n) _Pragma("unroll") for (int k = 0; k < 2; ++k) \
        acc[ai][bj][m][n] = __builtin_amdgcn_mfma_f32_16x16x32_bf16(Bt[n][k], At[m][k], acc[ai][bj][m][n], 0, 0, 0); __builtin_amdgcn_s_setprio(0); } while (0)
#define PG8_WAIT_V(n) asm volatile("s_waitcnt vmcnt(" #n ")" ::: "memory")
#define PG8_WAIT_L(n) asm volatile("s_waitcnt lgkmcnt(" #n ")" ::: "memory")
#define PG8_BAR __builtin_amdgcn_s_barrier()
#define PG8_SCHED __builtin_amdgcn_sched_barrier(0)
    Unit cur, nxt; int ui = 0;
    if (!S.next(0, cur)) return;
    f32x4 acc[2][2][4][2];
#pragma unroll
    for (int a = 0; a < 2; ++a)
#pragma unroll
        for (int b = 0; b < 2; ++b)
#pragma unroll
            for (int m = 0; m < 4; ++m)
#pragma unroll
                for (int n = 0; n < 2; ++n) acc[a][b][m][n] = (f32x4){0.f, 0.f, 0.f, 0.f};
    bf16x8 At[4][2], B0[2][2], B1[2][2];
    unsigned c00, c01, c10, c11, n00, n01, n10, n11;
    if constexpr (GATHER) {
        c00 = (unsigned)(S.tok(cur, RA[0]) * K + CA[0]) * 2u; c01 = (unsigned)(S.tok(cur, RA[1]) * K + CA[1]) * 2u;
        c10 = (unsigned)(S.tok(cur, HALF + RA[0]) * K + CA[0]) * 2u; c11 = (unsigned)(S.tok(cur, HALF + RA[1]) * K + CA[1]) * 2u;
    } else {
        c00 = (unsigned)(RA[0] * K + CA[0]) * 2u; c01 = (unsigned)(RA[1] * K + CA[1]) * 2u; c10 = c00 + (unsigned)hstep; c11 = c01 + (unsigned)hstep;
    }
    n00 = c00; n01 = c01; n10 = c10; n11 = c11;
    const char* cA = GATHER ? (const char*)g.A : (const char*)g.A + (size_t)cur.pm * tstep; const char* cB = (const char*)g.Bt + (size_t)cur.pb * tstep;
    PG8_STAGE(PG8_SB(0, 0), cB, voffB[0], voffB[1]); PG8_STAGE(PG8_SB(0, 1), cB + hstep, voffB[0], voffB[1]); PG8_STAGE(PG8_SA(0, 0), cA, c00, c01); PG8_STAGE(PG8_SA(0, 1), cA, c10, c11);
    if (wr == 1) PG8_BAR;
    PG8_WAIT_V(2); PG8_BAR;
    PG8_STAGE(PG8_SB(1, 0), cB + kstep, voffB[0], voffB[1]); PG8_STAGE(PG8_SA(1, 0), cA + kstep, c00, c01); PG8_STAGE(PG8_SB(1, 1), cB + hstep + kstep, voffB[0], voffB[1]);
    PG8_WAIT_V(6); PG8_BAR;
    for (;;) {
        const bool has_next = S.next(ui + 1, nxt);
        const char* nA = has_next ? (GATHER ? (const char*)g.A : (const char*)g.A + (size_t)nxt.pm * tstep) : cA; const char* nB = has_next ? (const char*)g.Bt + (size_t)nxt.pb * tstep : cB;
        if constexpr (GATHER) {
            if (has_next) {
                n00 = (unsigned)(S.tok(nxt, RA[0]) * K + CA[0]) * 2u; n01 = (unsigned)(S.tok(nxt, RA[1]) * K + CA[1]) * 2u;
                n10 = (unsigned)(S.tok(nxt, HALF + RA[0]) * K + CA[0]) * 2u; n11 = (unsigned)(S.tok(nxt, HALF + RA[1]) * K + CA[1]) * 2u;
            } else { n00 = c00; n01 = c01; n10 = c10; n11 = c11; }
        }
        for (int t = 0; t < nt; t += 2) {
            const bool last = (t == nt - 2);
            const char* a1 = cA + (size_t)(t + 1) * kstep;
            const char* a2 = last ? nA : cA + (size_t)(t + 2) * kstep; const char* b2 = last ? nB : cB + (size_t)(t + 2) * kstep;
            const char* a3 = a2 + kstep; const char* b3 = b2 + kstep;
            const unsigned o00 = last ? n00 : c00, o01 = last ? n01 : c01, o10 = last ? n10 : c10, o11 = last ? n11 : c11;
            PG8_LDB(B0, 0, 0); PG8_LDB(B1, 0, 1); PG8_SCHED; PG8_LDA(At, 0, 0); PG8_STAGE(PG8_SA(1, 1), a1, c10, c11);
            PG8_WAIT_V(8); PG8_WAIT_L(0); PG8_BAR; PG8_MMA(0, 0, At, B0); PG8_MMA(0, 1, At, B1); PG8_BAR; PG8_SCHED;
            PG8_LDA(At, 0, 1); PG8_STAGE(PG8_SB(0, 0), b2, voffB[0], voffB[1]); PG8_STAGE(PG8_SB(0, 1), b2 + hstep, voffB[0], voffB[1]); PG8_STAGE(PG8_SA(0, 0), a2, o00, o01);
            PG8_WAIT_V(8); PG8_WAIT_L(0); PG8_BAR; PG8_MMA(1, 0, At, B0); PG8_MMA(1, 1, At, B1); PG8_BAR; PG8_SCHED;
            PG8_LDB(B0, 1, 0); PG8_LDB(B1, 1, 1); PG8_SCHED; PG8_LDA(At, 1, 0); PG8_STAGE(PG8_SA(0, 1), a2, o10, o11);
            PG8_WAIT_V(8); PG8_WAIT_L(0); PG8_BAR; PG8_MMA(0, 0, At, B0); PG8_MMA(0, 1, At, B1); PG8_BAR; PG8_SCHED;
            PG8_LDA(At, 1, 1); PG8_STAGE(PG8_SB(1, 0), b3, voffB[0], voffB[1]); PG8_STAGE(PG8_SB(1, 1), b3 + hstep, voffB[0], voffB[1]); PG8_STAGE(PG8_SA(1, 0), a3, o00, o01);
            PG8_WAIT_V(8); PG8_WAIT_L(0); PG8_BAR; PG8_MMA(1, 0, At, B0); PG8_MMA(1, 1, At, B1); PG8_BAR; PG8_SCHED;
        }
        if constexpr (ALIGN_EPI) { if (wr == 0) PG8_BAR; }
        E(acc, cur, wr, wc, fr, fq);
        if (!has_next) break;
#pragma unroll
        for (int a = 0; a < 2; ++a)
#pragma unroll
            for (int b = 0; b < 2; ++b)
#pragma unroll
                for (int m = 0; m < 4; ++m)
#pragma unroll
                    for (int n = 0; n < 2; ++n) acc[a][b][m][n] = (f32x4){0.f, 0.f, 0.f, 0.f};
        cur = nxt; cA = nA; cB = nB; ++ui; c00 = n00; c01 = n01; c10 = n10; c11 = n11;
        if constexpr (ALIGN_EPI) { if (wr == 1) PG8_BAR; }
    }
    PG8_WAIT_V(0);
    if constexpr (!ALIGN_EPI) { if (wr == 0) PG8_BAR; }
    PG8_BAR;
#undef PG8_SA
#undef PG8_SB
#undef PG8_STAGE
#undef PG8_LDA
#undef PG8_LDB
#undef PG8_MMA
#undef PG8_WAIT_V
#undef PG8_WAIT_L
#undef PG8_BAR
#undef PG8_SCHED
}
}
namespace pg8 {
struct EpiProj {
    static constexpr bool PERM = true;
    bf16_t* qkv;
    bf16_t* gates;
    const float* rope;
    __device__ __forceinline__ void operator()(const f32x4 (&acc)[2][2][4][2], const Unit& u, int wr, int wc, int fr, int fq) const {
        const int pn = u.pn; bf16_t* base; int ldc, ct0;
        if (pn < 18) { const int t = pn / 6; base = qkv + (size_t)t * MTOK * WA; ldc = WA; ct0 = t * 6; }
        else if (pn < 30) { const int t = (pn - 18) / 4; base = qkv + (size_t)3 * MTOK * WA + (size_t)t * MTOK * WB; ldc = WB; ct0 = 18 + t * 4; }
        else { const int t = (pn - 30) / 8; base = gates + (size_t)t * MTOK * DM; ldc = DM; ct0 = 30 + t * 8; }
        const int row0 = u.pm * BM + wr * 64 + fr, col0 = (pn - ct0) * BM + wc * 32 + 8 * fq;
        const bool do_rope = (pn < 12) && (wc == 0);
#pragma unroll
        for (int ai = 0; ai < 2; ++ai)
#pragma unroll
            for (int m = 0; m < 4; ++m) { const int row = row0 + ai * HALF + m * 16; bf16_t* rowp = base + (size_t)row * ldc + col0;
                f32x4 cs = (f32x4){1.f, 1.f, 1.f, 1.f}, sn = (f32x4){0.f, 0.f, 0.f, 0.f};
                if (do_rope) { cs = *(const f32x4*)(rope + (size_t)row * 32 + 4 * fq); sn = *(const f32x4*)(rope + (size_t)row * 32 + 16 + 4 * fq); }
#pragma unroll
                for (int bj = 0; bj < 2; ++bj) { f32x4 v0 = acc[ai][bj][m][0], v1 = acc[ai][bj][m][1];
                    if (do_rope) { const f32x4 y0 = v0 * cs - v1 * sn, y1 = v1 * cs + v0 * sn; v0 = y0; v1 = y1; }
                    u32x4 w; w.x = cvt_pk_bf16(v0[0], v0[1]); w.y = cvt_pk_bf16(v0[2], v0[3]); w.z = cvt_pk_bf16(v1[0], v1[1]); w.w = cvt_pk_bf16(v1[2], v1[3]);
                    *(u32x4*)(rowp + bj * HALF) = w; } }
    }
};
struct EpiBf16 {
    static constexpr bool PERM = true;
    bf16_t* O; int ldc;
    __device__ __forceinline__ void operator()(const f32x4 (&acc)[2][2][4][2], const Unit& u, int wr, int wc, int fr, int fq) const {
        const int row0 = u.pm * BM + wr * 64 + fr, col0 = u.pn * BM + wc * 32 + 8 * fq;
#pragma unroll
        for (int ai = 0; ai < 2; ++ai)
#pragma unroll
            for (int m = 0; m < 4; ++m) { bf16_t* rowp = O + (size_t)(row0 + ai * HALF + m * 16) * ldc + col0;
#pragma unroll
                for (int bj = 0; bj < 2; ++bj) { const f32x4 v0 = acc[ai][bj][m][0], v1 = acc[ai][bj][m][1];
                    u32x4 w; w.x = cvt_pk_bf16(v0[0], v0[1]); w.y = cvt_pk_bf16(v0[2], v0[3]); w.z = cvt_pk_bf16(v1[0], v1[1]); w.w = cvt_pk_bf16(v1[2], v1[3]);
                    *(u32x4*)(rowp + bj * HALF) = w; } }
    }
};
template <bool SECOND> struct EpiGate {
    static constexpr bool PERM = true;
    const bf16_t* gate; bf16_t* P1; bf16_t* out;
    __device__ __forceinline__ void operator()(const f32x4 (&acc)[2][2][4][2], const Unit& u, int wr, int wc, int fr, int fq) const {
        const int row0 = u.pm * BM + wr * 64 + fr, col0 = u.pn * BM + wc * 32 + 8 * fq;
#pragma unroll
        for (int ai = 0; ai < 2; ++ai)
#pragma unroll
            for (int m = 0; m < 4; ++m) { const size_t off = (size_t)(row0 + ai * HALF + m * 16) * DM + col0;
#pragma unroll
                for (int bj = 0; bj < 2; ++bj) { const f32x4 v0 = acc[ai][bj][m][0], v1 = acc[ai][bj][m][1];
                    const u32x4 gw = *(const u32x4*)(gate + off + bj * HALF);
                    float r[8];
                    r[0] = sigmoidf_fast(bf_lo(gw.x)) * v0[0]; r[1] = sigmoidf_fast(bf_hi(gw.x)) * v0[1]; r[2] = sigmoidf_fast(bf_lo(gw.y)) * v0[2]; r[3] = sigmoidf_fast(bf_hi(gw.y)) * v0[3];
                    r[4] = sigmoidf_fast(bf_lo(gw.z)) * v1[0]; r[5] = sigmoidf_fast(bf_hi(gw.z)) * v1[1]; r[6] = sigmoidf_fast(bf_lo(gw.w)) * v1[2]; r[7] = sigmoidf_fast(bf_hi(gw.w)) * v1[3];
                    if (SECOND) { const u32x4 pw = *(const u32x4*)(P1 + off + bj * HALF);
                        r[0] += bf_lo(pw.x); r[1] += bf_hi(pw.x); r[2] += bf_lo(pw.y); r[3] += bf_hi(pw.y); r[4] += bf_lo(pw.z); r[5] += bf_hi(pw.z); r[6] += bf_lo(pw.w); r[7] += bf_hi(pw.w); }
                    u32x4 w; w.x = cvt_pk_bf16(r[0], r[1]); w.y = cvt_pk_bf16(r[2], r[3]); w.z = cvt_pk_bf16(r[4], r[5]); w.w = cvt_pk_bf16(r[6], r[7]);
                    *(u32x4*)((SECOND ? out : P1) + off + bj * HALF) = w; }
                asm volatile("" ::: "memory"); }
    }
};
struct EpiResid {
    static constexpr bool PERM = false;
    const float* h; float* out;
    __device__ __forceinline__ void operator()(const f32x4 (&acc)[2][2][4][2], const Unit& u, int wr, int wc, int fr, int fq) const {
        const int row0 = u.pm * BM + wr * 64 + fr, col0 = u.pn * BM + wc * 32 + 4 * fq;
#pragma unroll
        for (int ai = 0; ai < 2; ++ai)
#pragma unroll
            for (int m = 0; m < 4; ++m) { const size_t off = (size_t)(row0 + ai * HALF + m * 16) * DM + col0;
#pragma unroll
                for (int bj = 0; bj < 2; ++bj)
#pragma unroll
                    for (int n = 0; n < 2; ++n) { const f32x4 hv = *(const f32x4*)(h + off + bj * HALF + n * 16); *(f32x4*)(out + off + bj * HALF + n * 16) = hv * ALPHA + acc[ai][bj][m][n]; } }
    }
};
struct EpiSwiglu {
    static constexpr bool PERM = true;
    bf16_t* Hd;
    __device__ __forceinline__ void operator()(const f32x4 (&acc)[2][2][4][2], const Unit& u, int wr, int wc, int fr, int fq) const {
        const int row0 = u.pm * BM + wr * 64 + fr, col0 = u.pn * HALF + wc * 32 + 8 * fq;
#pragma unroll
        for (int ai = 0; ai < 2; ++ai)
#pragma unroll
            for (int m = 0; m < 4; ++m) { bf16_t* rowp = Hd + (size_t)(row0 + ai * HALF + m * 16) * FF + col0;
                float r[8];
#pragma unroll
                for (int n = 0; n < 2; ++n)
#pragma unroll
                    for (int j = 0; j < 4; ++j) { const float a = acc[ai][0][m][n][j], b = acc[ai][1][m][n][j]; r[4 * n + j] = a * sigmoidf_fast(a) * b; }
                u32x4 w; w.x = cvt_pk_bf16(r[0], r[1]); w.y = cvt_pk_bf16(r[2], r[3]); w.z = cvt_pk_bf16(r[4], r[5]); w.w = cvt_pk_bf16(r[6], r[7]);
                *(u32x4*)rowp = w; }
    }
};
}
namespace att {
#define SBAR() __builtin_amdgcn_sched_barrier(0)
#define KSWZ(row, colB) ((row) * 256 + ((colB) ^ (((row) & 7) << 4)))
__device__ __forceinline__ int v_st(int k, int c) { const int kk = (k & ~0xC) | ((k & 4) << 1) | ((k & 8) >> 1); return ((kk >> 3) * 4 + (c >> 5)) * 512 + ((kk & 7) * 32 + (c & 31)) * 2; }
__device__ __forceinline__ int v_rd_base(int lane) { return ((lane & 3) << 3) | (((lane >> 2) & 3) << 6) | (((lane >> 4) & 1) << 5) | (((lane >> 5) & 1) << 8); }
__device__ __forceinline__ int crow(int r, int hi) { return (r & 3) + 8 * (r >> 2) + 4 * hi; }
__device__ __forceinline__ float partner_f(float x, int hi) { auto rr = __builtin_amdgcn_permlane32_swap(__float_as_uint(x), __float_as_uint(x), false, false); return __uint_as_float(hi ? rr[0] : rr[1]); }
#define PK4(P, B_, OUT) do { unsigned a0 = cvt_pk_bf16(P[B_+0], P[B_+1]), a1 = cvt_pk_bf16(P[B_+2], P[B_+3]);                          \
        unsigned b0 = cvt_pk_bf16(P[B_+4], P[B_+5]), b1 = cvt_pk_bf16(P[B_+6], P[B_+7]);                                             \
        auto r0 = __builtin_amdgcn_permlane32_swap(a0, b0, false, false); auto r1 = __builtin_amdgcn_permlane32_swap(a1, b1, false, false); \
        u32x4 w = {r0[0], r1[0], r0[1], r1[1]}; OUT = *reinterpret_cast<bf16x8*>(&w); } while (0)
#define TRRD(dst, addr, off) asm volatile("ds_read_b64_tr_b16 %0, %1 offset:%2" : "=&v"(dst) : "v"(addr), "i"(off) : "memory")

__device__ __forceinline__ void qkt32(f32x16& p, unsigned kaddr, int r32, int hi, const bf16x8* qr) {
    p = f32x16{};
    unsigned kb[4];
#pragma unroll
    for (int dd = 0; dd < 4; ++dd) kb[dd] = kaddr + KSWZ(r32, (dd * 16 + hi * 8) * 2);
#pragma unroll
    for (int d0 = 0; d0 < 8; ++d0) { const bf16x8 b0 = *(const LAS bf16x8*)(uintptr_t)(kb[d0 & 3] + (d0 >> 2) * 128);
        p = __builtin_amdgcn_mfma_f32_32x32x16_bf16(b0, qr[d0], p, 0, 0, 0); }
}
__device__ __forceinline__ void pv32(f32x16* o, unsigned vaddr, bf16x8 pa0, bf16x8 pa1) {
#define PV_D0(d0) do { s16x4 l0, l1, h0, h1; constexpr int b_ = (d0) * 512; \
        TRRD(l0, vaddr, b_); TRRD(h0, vaddr, b_ + 2048); TRRD(l1, vaddr, b_ + 4096); TRRD(h1, vaddr, b_ + 6144); \
        asm volatile("s_waitcnt lgkmcnt(0)" ::: "memory"); SBAR(); \
        o[d0] = __builtin_amdgcn_mfma_f32_32x32x16_bf16(pa0, (bf16x8){l0[0], l0[1], l0[2], l0[3], h0[0], h0[1], h0[2], h0[3]}, o[d0], 0, 0, 0); \
        o[d0] = __builtin_amdgcn_mfma_f32_32x32x16_bf16(pa1, (bf16x8){l1[0], l1[1], l1[2], l1[3], h1[0], h1[1], h1[2], h1[3]}, o[d0], 0, 0, 0); } while (0)
    PV_D0(0); PV_D0(1); PV_D0(2); PV_D0(3);
#undef PV_D0
}
template <class RowPtr>
__device__ __forceinline__ void store_o_bf16(const f32x16* o, const float* rscale, int r32, int hi, const RowPtr& rowp) {
#pragma unroll
    for (int r = 0; r < 16; ++r) { bf16_t* rp = rowp(crow(r, hi));
#pragma unroll
        for (int d0 = 0; d0 < 4; ++d0) { const float v = o[d0][r] * rscale[r]; const float vn = __shfl_xor(v, 1);
            if ((r32 & 1) == 0) *(unsigned*)(rp + d0 * 32 + r32) = cvt_pk_bf16(v, vn); } }
}

template <bool MASK>
__device__ __forceinline__ void sb_half(f32x16& p, float& C, int dq, int hi) {
    float om[16];
#pragma unroll
    for (int r = 0; r < 16; ++r) {
        float z = p[r] * QK_C2; z = fminf(fmaxf(z, -115.f), 115.f);
        const float e = __builtin_amdgcn_exp2f(-z); float b = __builtin_amdgcn_rcpf(1.0f + e); float o = e * b;
        if (MASK) { const bool v = ((r & 3) + 8 * (r >> 2)) < dq; b = v ? b : 0.f; o = v ? o : 1.f; }
        p[r] = b; om[r] = o; }
    float g[4], pg[4], eh[4];
#pragma unroll
    for (int c = 0; c < 4; ++c) { g[c] = (om[4 * c] * om[4 * c + 1]) * (om[4 * c + 2] * om[4 * c + 3]); pg[c] = partner_f(g[c], hi); }
    eh[3] = C; eh[2] = eh[3] * (g[3] * pg[3]); eh[1] = eh[2] * (g[2] * pg[2]); eh[0] = eh[1] * (g[1] * pg[1]); C = eh[0] * (g[0] * pg[0]);
#pragma unroll
    for (int c = 3; c >= 0; --c) { float E = hi ? eh[c] : eh[c] * pg[c];
#pragma unroll
        for (int r = 4 * c + 3; r >= 4 * c; --r) { p[r] *= E; E *= om[r]; } }
}

struct SbTensors { const bf16_t* Q; const bf16_t* K; const bf16_t* V; bf16_t* O; };
__device__ __forceinline__ void sb_unit(const SbTensors& T, int b, int head, int qb, LAS unsigned char* lds) {
    int tid = threadIdx.x; asm volatile("" : "+v"(tid));
    const int wid = __builtin_amdgcn_readfirstlane(tid >> 6), lane = tid & 63, r32 = lane & 31, hi = lane >> 5;
    const size_t rowbase = (size_t)b * SEQ;
    const int q0 = qb * 256 + wid * 32;
    const int tq = q0 + r32;
    bf16x8 qr[8];
    { const bf16_t* qp = T.Q + (rowbase + tq) * WB + head * HD + hi * 8;
#pragma unroll
      for (int d0 = 0; d0 < 8; ++d0) qr[d0] = *(const bf16x8*)(qp + d0 * 16); }
    const bf16_t* Kh = T.K + rowbase * WB + head * HD; const bf16_t* Vh = T.V + rowbase * WB + head * HD;
    const int sr = tid >> 4, sc = (tid & 15) * 8;
    const int kws = KSWZ(sr, sc * 2), vst0 = v_st(sr, sc), vst1 = v_st(32 + sr, sc);
    const unsigned Kl = (unsigned)(uintptr_t)lds, Vl = Kl + 32768u, vrb = (unsigned)v_rd_base(lane);
    f32x16 o[4] = {}; float C = 1.0f;
    const int NT = 4 * qb + 4;
    bf16x8 sk0, sk1, sv0, sv1;
#define SB_LOAD(jt) do { const bf16_t* kp = Kh + (size_t)((jt) * 64 + sr) * WB + sc; const bf16_t* vp = Vh + (size_t)((jt) * 64 + sr) * WB + sc; \
        sk0 = *(const bf16x8*)kp; sk1 = *(const bf16x8*)(kp + 32 * WB); sv0 = *(const bf16x8*)vp; sv1 = *(const bf16x8*)(vp + 32 * WB); } while (0)
#define SB_WRITE(bf) do { *(LAS bf16x8*)(lds + (bf) * 16384 + kws) = sk0; *(LAS bf16x8*)(lds + (bf) * 16384 + kws + 32 * 256) = sk1; \
        *(LAS bf16x8*)(lds + 32768 + (bf) * 16384 + vst0) = sv0; *(LAS bf16x8*)(lds + 32768 + (bf) * 16384 + vst1) = sv1; } while (0)
    SB_LOAD(NT - 1); SB_WRITE(0);
    __syncthreads();
    for (int it = 0; it < NT; ++it) {
        const int jt = NT - 1 - it, bf = it & 1, kb = jt * 64;
        if (it + 1 < NT) SB_LOAD(jt - 1);
        if (kb <= q0 + 30) {
            const unsigned ka = Kl + bf * 16384u, va = Vl + bf * 16384u + vrb;
            f32x16 p0, p1; bf16x8 pa0, pa1, pa2, pa3;
            qkt32(p0, ka, r32, hi, qr); qkt32(p1, ka + 32 * 256, r32, hi, qr);
            if (kb + 63 >= q0) { sb_half<true>(p1, C, tq - kb - 32 - 4 * hi, hi); sb_half<true>(p0, C, tq - kb - 4 * hi, hi); }
            else { sb_half<false>(p1, C, 0, hi); sb_half<false>(p0, C, 0, hi); }
            PK4(p0, 0, pa0); PK4(p0, 8, pa1); PK4(p1, 0, pa2); PK4(p1, 8, pa3);
            pv32(o, va, pa0, pa1); pv32(o, va + 8192, pa2, pa3);
        }
        if (it + 1 < NT) SB_WRITE(bf ^ 1);
        __syncthreads();
    }
#undef SB_LOAD
#undef SB_WRITE
    float ones[16];
#pragma unroll
    for (int r = 0; r < 16; ++r) ones[r] = 1.0f;
    bf16_t* Ob = T.O + (rowbase + q0) * WB + head * HD;
    store_o_bf16(o, ones, r32, hi, [&](int row) { return Ob + (size_t)row * WB; });
}

struct DaTensors { const bf16_t* Q; const bf16_t* K; const bf16_t* V; bf16_t* PO; float* PL; };
__device__ __forceinline__ void da_job(const DaTensors& T, int b, int h, int g, int rho, int u0, LAS unsigned char* wl, LAS float* ws) {
    int lane = threadIdx.x & 63; asm volatile("" : "+v"(lane));
    const int r32 = lane & 31, hi = lane >> 5;
    const int dsh = 2 * g, dil = 1 << dsh;
    const size_t rowbase = (size_t)b * SEQ; const int colh = g * 512 + h * HD;
    bf16x8 qr[8];
    { const bf16_t* qp = T.Q + (rowbase + (size_t)(((u0 + r32) << dsh) + rho)) * WA + colh + hi * 8;
#pragma unroll
      for (int d0 = 0; d0 < 8; ++d0) qr[d0] = *(const bf16x8*)(qp + d0 * 16); }
    const unsigned Kl = (unsigned)(uintptr_t)wl, Vl = Kl + 8192u + (unsigned)v_rd_base(lane);
    LAS float* al_l = ws; LAS float* li_l = ws + 32;
    f32x16 o[4] = {}; float m_reg = -1e30f, l_reg = 0.f;
    const int srow = lane >> 4, sc = (lane & 15) * 8;
    for (int tau = 0; tau < 5; ++tau) {
        const int ub = u0 - 128 + 32 * tau;
        if (ub < 0) continue;
        { bf16x8 kk[8];
#pragma unroll
        for (int c = 0; c < 8; ++c) { const int ki = srow + 4 * c; const size_t ro = (rowbase + (size_t)(((ub + ki) << dsh) + rho)) * WA + colh + sc; kk[c] = *(const bf16x8*)(T.K + ro); }
#pragma unroll
        for (int c = 0; c < 8; ++c) { const int ki = srow + 4 * c; *(LAS bf16x8*)(wl + KSWZ(ki, sc * 2)) = kk[c]; } }
        asm volatile("" ::: "memory");
        { bf16x8 vv[8];
#pragma unroll
        for (int c = 0; c < 8; ++c) { const int ki = srow + 4 * c; const size_t ro = (rowbase + (size_t)(((ub + ki) << dsh) + rho)) * WA + colh + sc; vv[c] = *(const bf16x8*)(T.V + ro); }
#pragma unroll
        for (int c = 0; c < 8; ++c) { const int ki = srow + 4 * c; *(LAS bf16x8*)(wl + 8192 + v_st(ki, sc)) = vv[c]; } }
        asm volatile("s_waitcnt lgkmcnt(0)" ::: "memory"); SBAR();
        f32x16 p; qkt32(p, Kl, r32, hi, qr);
        if (tau == 0 || tau == 4) { const int dq = u0 + r32 - ub - 4 * hi; const float NEG = -__builtin_inff();
#pragma unroll
            for (int r = 0; r < 16; ++r) { const int c = (r & 3) + 8 * (r >> 2); if ((unsigned)(dq - c) >= 129u) p[r] = NEG; } }
        float pmax = p[0];
#pragma unroll
        for (int r = 1; r < 16; ++r) pmax = fmaxf(pmax, p[r]);
        pmax = fmaxf(pmax, partner_f(pmax, hi));
        float alpha = 1.f;
        if (!__all((pmax - m_reg) * QK_C2 <= 8.0f * LOG2E)) {
            const float mn = fmaxf(m_reg, pmax); alpha = __builtin_amdgcn_exp2f((m_reg - mn) * QK_C2); m_reg = mn;
            if (hi == 0) al_l[r32] = alpha; asm volatile("s_waitcnt lgkmcnt(0)" ::: "memory");
#pragma unroll
            for (int r = 0; r < 16; ++r) { const float a = al_l[crow(r, hi)];
#pragma unroll
                for (int d0 = 0; d0 < 4; ++d0) o[d0][r] *= a; }
        }
        const float mnL = -m_reg * QK_C2; float ps = 0.f;
#pragma unroll
        for (int r = 0; r < 16; ++r) { p[r] = __builtin_amdgcn_exp2f(fmaf(p[r], QK_C2, mnL)); ps += p[r]; }
        ps += partner_f(ps, hi);
        l_reg = l_reg * alpha + ps;
        bf16x8 pa0, pa1; PK4(p, 0, pa0); PK4(p, 8, pa1);
        pv32(o, Vl, pa0, pa1);
    }
    if (hi == 0) li_l[r32] = l_reg; asm volatile("s_waitcnt lgkmcnt(0)" ::: "memory");
    float rli[16];
#pragma unroll
    for (int r = 0; r < 16; ++r) rli[r] = __builtin_amdgcn_rcpf(li_l[crow(r, hi)]);
    bf16_t* Pg = T.PO + (size_t)g * MTOK * 512 + h * HD;
    store_o_bf16(o, rli, r32, hi, [&](int row) { return Pg + (rowbase + (size_t)(((u0 + row) << dsh) + rho)) * 512; });
    if (hi == 0) T.PL[((size_t)g * MTOK + rowbase + (size_t)(((u0 + r32) << dsh) + rho)) * 4 + h] = m_reg * QK_C2 + __builtin_amdgcn_logf(l_reg);
}
__device__ __forceinline__ void da_unit(const DaTensors& T, bf16_t* OA, int b, int h, int chunk, LAS unsigned char* lds, LAS float* wscr) {
    int tid = threadIdx.x; asm volatile("" : "+v"(tid)); const int wid = __builtin_amdgcn_readfirstlane(tid >> 6);
    for (int jj = 0; jj < 6; ++jj) {
        const int job = wid + 8 * jj, g = job >> 4, idx = job & 15;
        int rho, u0;
        if (g == 0) { rho = 0; u0 = chunk * 512 + 32 * idx; }
        else if (g == 1) { rho = idx >> 2; u0 = chunk * 128 + 32 * (idx & 3); }
        else { rho = idx; u0 = chunk * 32; }
        da_job(T, b, h, g, rho, u0, lds + wid * 16384, wscr + wid * 64);
    }
    asm volatile("s_waitcnt vmcnt(0)" ::: "memory");
    __syncthreads();
    const size_t rowbase = (size_t)b * SEQ + (size_t)chunk * 512;
    for (int it = tid; it < 512 * 16; it += 512) {
        const int tk = it >> 4, ch = it & 15; const size_t row = rowbase + tk;
        const float l0 = T.PL[(0 * (size_t)MTOK + row) * 4 + h], l1 = T.PL[(1 * (size_t)MTOK + row) * 4 + h], l2 = T.PL[(2 * (size_t)MTOK + row) * 4 + h];
        const float mx = fmaxf(l0, fmaxf(l1, l2));
        float w0 = __builtin_amdgcn_exp2f(l0 - mx), w1 = __builtin_amdgcn_exp2f(l1 - mx), w2 = __builtin_amdgcn_exp2f(l2 - mx);
        const float inv = 1.0f / (w0 + w1 + w2); w0 *= inv; w1 *= inv; w2 *= inv;
        const size_t off = row * 512 + h * HD + ch * 8;
        const u32x4 a = *(const u32x4*)(T.PO + off), bq = *(const u32x4*)(T.PO + (size_t)MTOK * 512 + off), c = *(const u32x4*)(T.PO + (size_t)2 * MTOK * 512 + off);
        u32x4 w;
        w.x = cvt_pk_bf16(w0 * bf_lo(a.x) + w1 * bf_lo(bq.x) + w2 * bf_lo(c.x), w0 * bf_hi(a.x) + w1 * bf_hi(bq.x) + w2 * bf_hi(c.x));
        w.y = cvt_pk_bf16(w0 * bf_lo(a.y) + w1 * bf_lo(bq.y) + w2 * bf_lo(c.y), w0 * bf_hi(a.y) + w1 * bf_hi(bq.y) + w2 * bf_hi(c.y));
        w.z = cvt_pk_bf16(w0 * bf_lo(a.z) + w1 * bf_lo(bq.z) + w2 * bf_lo(c.z), w0 * bf_hi(a.z) + w1 * bf_hi(bq.z) + w2 * bf_hi(c.z));
        w.w = cvt_pk_bf16(w0 * bf_lo(a.w) + w1 * bf_lo(bq.w) + w2 * bf_lo(c.w), w0 * bf_hi(a.w) + w1 * bf_hi(bq.w) + w2 * bf_hi(c.w));
        *(u32x4*)(OA + off) = w;
    }
    __syncthreads();
}
#undef SBAR
}
#define MK_ONE_LAUNCH 1
constexpr int NWAVES = 8;
#ifndef MK_ONE_LAUNCH
#define MK_ONE_LAUNCH 1
#endif
constexpr size_t MiB = 1u << 20;
constexpr size_t WS_CTL = 0, CTL_ZERO_BYTES = 1 * MiB;
constexpr size_t WS_ROPE = 2 * MiB;
constexpr size_t WS_WRT = 4 * MiB;
constexpr size_t WS_TOK = 5 * MiB;
constexpr size_t WS_LIST = 6 * MiB;
constexpr size_t WS_PL = 7 * MiB;
constexpr size_t WS_W = 8 * MiB;
constexpr size_t LW_IN = 0, LW_PA = LW_IN + (size_t)NIN * DM * 2, LW_PB = LW_PA + (size_t)DM * 512 * 2, LW_WO = LW_PB + (size_t)DM * 1024 * 2,
                 LW_UP = LW_WO + (size_t)DM * DM * 2, LW_DN = LW_UP + (size_t)NEXP * 1024 * DM * 2, LW_BYTES = LW_DN + (size_t)NEXP * DM * FF * 2;
static_assert(LW_BYTES == 156 * MiB, "weights per layer");
constexpr size_t WS_HB = WS_W + 2 * LW_BYTES;
constexpr size_t WS_OA = WS_HB + 64 * MiB;
constexpr size_t WS_OB = WS_OA + 16 * MiB;
constexpr size_t WS_PO = WS_OB + 32 * MiB;
constexpr size_t WS_GATES = WS_PO + 48 * MiB;
constexpr size_t WS_QKV = WS_GATES + 128 * MiB;
constexpr size_t WS_P1 = WS_QKV;
constexpr size_t WS_MRG = WS_QKV + 64 * MiB;
constexpr size_t WS_HID = WS_QKV + 144 * MiB;
constexpr size_t WS_YP = WS_QKV;
constexpr size_t WS_END = WS_QKV + 240 * MiB;
static_assert(WS_HID >= WS_YP + (size_t)36864 * DM * 2 || WS_YP >= WS_HID + (size_t)36864 * FF * 2, "YP / HID overlap");
static_assert(WS_END <= 1024 * MiB, "workspace");
constexpr int CW_TMO = 0, CW_CODE = 1, CW_BAR = 4096, CW_ECNT = 16384;
#define XB_TMO      128
#define XB_XCNT(j)  (256  + 64 * (j))
#define XB_XSUB(j)  (1280 + 64 * (j))
#define XB_XGEN(j)  (2304 + 64 * (j))
#define XB_TOP      3328
#define XB_TOPGEN   3392
#define XCD_BAR_WORDS 3456
#define XB_SPIN_CAP (1u << 18)
constexpr int RING_BYTES = 131072, LDSCTL_OFF = RING_BYTES, MISC_OFF = LDSCTL_OFF + 320, LT_OFF = LDSCTL_OFF + 1024  , WSCR_OFF = LDSCTL_OFF + 2048  ;
constexpr int LDS_BYTES = 147456;

__device__ __forceinline__ unsigned xb_ld(unsigned* p)              { return __hip_atomic_load(p, __ATOMIC_RELAXED, __HIP_MEMORY_SCOPE_AGENT); }
__device__ __forceinline__ unsigned xb_add(unsigned* p, unsigned v) { return __hip_atomic_fetch_add(p, v, __ATOMIC_RELAXED, __HIP_MEMORY_SCOPE_AGENT); }
__device__ __forceinline__ unsigned xb_xcc_id() { return (unsigned)__builtin_amdgcn_s_getreg((3 << 11) | 20) & 0xFu; }
#define XB_SPIN(cond, bar) do { unsigned _sp = 0; while (cond) { __builtin_amdgcn_s_sleep(1); \
    if ((++_sp & 255u) == 0u) { if (xb_ld(&(bar)[XB_TMO])) break; if (_sp > XB_SPIN_CAP) { atomicAdd(&(bar)[XB_TMO], 1u); break; } } } } while (0)
struct XcdBarrier { unsigned* bar; unsigned x; volatile LAS unsigned* st; };
__device__ __forceinline__ XcdBarrier xcd_barrier_post(unsigned* bar, volatile LAS unsigned* st) {
    XcdBarrier b; b.bar = bar; b.x = xb_xcc_id(); b.st = st;
    if (threadIdx.x == 0) (void)xb_add(&bar[XB_XCNT(b.x)], 1u);
    return b;
}
__device__ __forceinline__ void xcd_barrier_complete(unsigned* bar, unsigned x, unsigned& nloc, unsigned& nx) {
    const unsigned G = gridDim.x * gridDim.y * gridDim.z;
    unsigned sum, cnt, mine, sp = 0u;
    for (;;) {
        sum = 0u; cnt = 0u; mine = 0u;
#pragma unroll
        for (unsigned j = 0; j < 16; ++j) { const unsigned c = xb_ld(&bar[XB_XCNT(j)]); sum += c; cnt += (c > 0u) ? 1u : 0u; mine = (j == x) ? c : mine; }
        if (sum == G) break;
        __builtin_amdgcn_s_sleep(1);
        if ((++sp & 255u) == 0u) { if (xb_ld(&bar[XB_TMO])) break; if (sp > XB_SPIN_CAP) { atomicAdd(&bar[XB_TMO], 1u); break; } }
    }
    nloc = mine > 0u ? mine : 1u; nx = cnt > 0u ? cnt : 1u;
}
__device__ __forceinline__ void xcd_barrier(const XcdBarrier& b) {
    asm volatile("s_waitcnt vmcnt(0)" ::: "memory");
    __syncthreads();
    if (threadIdx.x == 0) {
        unsigned* bar = b.bar;
        __builtin_amdgcn_s_waitcnt(0);
        unsigned nloc = b.st[0], nx = b.st[1];
        if (nloc == 0u) { xcd_barrier_complete(bar, b.x, nloc, nx); b.st[0] = nloc; b.st[1] = nx; }
        const unsigned old = xb_add(&bar[XB_XSUB(b.x)], 1u);
        const unsigned gen = old / nloc;
        if (old + 1u == (gen + 1u) * nloc) {
            __builtin_amdgcn_fence(__ATOMIC_RELEASE, "agent");
            asm volatile("s_waitcnt vmcnt(0)" ::: "memory");
            const unsigned og = xb_add(&bar[XB_TOP], 1u);
            const unsigned tg = og / nx;
            if (og + 1u == (tg + 1u) * nx) xb_add(&bar[XB_TOPGEN], 1u);
            else XB_SPIN(xb_ld(&bar[XB_TOPGEN]) == tg, bar);
            __builtin_amdgcn_fence(__ATOMIC_ACQUIRE, "agent");
            xb_add(&bar[XB_XGEN(b.x)], 1u);
            asm volatile("s_waitcnt vmcnt(0)" ::: "memory");
        } else {
            XB_SPIN(xb_ld(&bar[XB_XGEN(b.x)]) == gen, bar);
            __builtin_amdgcn_fence(__ATOMIC_ACQUIRE, "agent");
            asm volatile("s_waitcnt vmcnt(0)" ::: "memory");
        }
    }
    __syncthreads();
}

struct Args { const float* in[14]; float* out; unsigned char* ws; int ph_lo, ph_hi; };
static_assert(sizeof(Args) == 14 * 8 + 8 + 8 + 8, "Args has no padding");

__device__ __forceinline__ float wave_sum(float v) {
#pragma unroll
    for (int o = 1; o < 64; o <<= 1) v += __shfl_xor(v, o);
    return v;
}
__device__ __forceinline__ unsigned f2bf(float f) { unsigned u = __builtin_bit_cast(unsigned, f); return (u + 0x7fffu + ((u >> 16) & 1u)) >> 16; }
__device__ __forceinline__ unsigned pk2(float lo, float hi) { return f2bf(lo) | (f2bf(hi) << 16); }

template <int MAP> __device__ __forceinline__ int wmap(int n) {
    if (MAP == 1) {
        if (n < 2 * WA) { const int d = n & 127; if (d < 32) { const int dd = (d < 16) ? (((d >> 2) << 3) + (d & 3)) : ((((d - 16) >> 2) << 3) + 4 + (d & 3)); return (n & ~127) + dd; } }
        return n;
    } else if (MAP == 2) {
        if (n < FF) return ((n >> 7) << 8) + (n & 127);
        const int j = n - FF; return ((j >> 7) << 8) + 128 + (j & 127);
    }
    return n;
}
template <int MAP>
__device__ __forceinline__ void xpose_item(const float* W, int K, int N, bf16_t* WT, LAS float* scr, int item, int lane) {
    const int nblk = N / 32, kb = item / nblk, nb = item % nblk, k0 = 64 * kb, n0 = 32 * nb;
#pragma unroll 8
    for (int i = 0; i < 32; ++i) { const int kk = 2 * i + (lane >> 5); scr[kk * 33 + (lane & 31)] = W[(size_t)(k0 + kk) * N + n0 + (lane & 31)]; }
    asm volatile("s_waitcnt lgkmcnt(0)" ::: "memory");
    const int c = lane & 7;
#pragma unroll
    for (int j = 0; j < 4; ++j) { const int n = (lane >> 3) + 8 * j; const LAS float* s = scr + (8 * c) * 33 + n;
        u32x4 o; o.x = pk2(s[0 * 33], s[1 * 33]); o.y = pk2(s[2 * 33], s[3 * 33]); o.z = pk2(s[4 * 33], s[5 * 33]); o.w = pk2(s[6 * 33], s[7 * 33]);
        *(u32x4*)(WT + (size_t)wmap<MAP>(n0 + n) * K + k0 + 8 * c) = o; }
    asm volatile("s_waitcnt lgkmcnt(0)" ::: "memory");
}
__device__ __forceinline__ int opq(int x) { asm volatile("" : "+v"(x)); return x; }
struct Frame {
    LAS unsigned char* lds; volatile LAS unsigned* MISC; unsigned* ctl; unsigned char* ws;
    int tid, lane, wave, vcu, G;
    const Args* A; float* out;
};
constexpr int I_IN = (DM / 64) * (NIN / 32), I_PA = (512 / 64) * (DM / 32), I_PB = (1024 / 64) * (DM / 32), I_WO = (DM / 64) * (DM / 32),
              I_UP1 = (DM / 64) * (1024 / 32), I_UP = NEXP * I_UP1, I_DN1 = (FF / 64) * (DM / 32), I_DN = NEXP * I_DN1, I_LAYER = I_IN + I_PA + I_PB + I_WO + I_UP + I_DN;

__device__ __forceinline__ void p0_prologue(Frame& F) {
    LAS float* scr = (LAS float*)(F.lds + F.wave * 16384);
    const int gw = F.vcu * NWAVES + F.wave, NGW = F.G * NWAVES;
    for (int it = gw; it < DEPTH * I_LAYER; it += NGW) {
        const int l = it / I_LAYER; int r = it % I_LAYER;
        bf16_t* LW = (bf16_t*)(F.ws + WS_W + (size_t)l * LW_BYTES);
        if (r < I_IN) { xpose_item<1>(F.A->in[2] + (size_t)l * DM * NIN, DM, NIN, LW + LW_IN / 2, scr, r, F.lane); continue; } r -= I_IN;
        if (r < I_PA) { xpose_item<0>(F.A->in[3] + (size_t)l * 512 * DM, 512, DM, LW + LW_PA / 2, scr, r, F.lane); continue; } r -= I_PA;
        if (r < I_PB) { xpose_item<0>(F.A->in[4] + (size_t)l * 1024 * DM, 1024, DM, LW + LW_PB / 2, scr, r, F.lane); continue; } r -= I_PB;
        if (r < I_WO) { xpose_item<0>(F.A->in[5] + (size_t)l * DM * DM, DM, DM, LW + LW_WO / 2, scr, r, F.lane); continue; } r -= I_WO;
        if (r < I_UP) { const int e = r / I_UP1; xpose_item<2>(F.A->in[12] + ((size_t)l * NEXP + e) * DM * 1024, DM, 1024, LW + LW_UP / 2 + (size_t)e * 1024 * DM, scr, r % I_UP1, F.lane); continue; } r -= I_UP;
        { const int e = r / I_DN1; xpose_item<0>(F.A->in[13] + ((size_t)l * NEXP + e) * FF * DM, FF, DM, LW + LW_DN / 2 + (size_t)e * DM * FF, scr, r % I_DN1, F.lane); }
    }
    bf16_t* HB = (bf16_t*)(F.ws + WS_HB);
    for (int m = gw; m < MTOK; m += NGW) {
        const f32x4* xr = (const f32x4*)(F.A->in[0] + (size_t)m * DM) + F.lane; unsigned long long* o8 = (unsigned long long*)(HB + (size_t)m * DM) + F.lane;
#pragma unroll
        for (int j = 0; j < 8; ++j) { const f32x4 v = xr[64 * j]; o8[64 * j] = (unsigned long long)cvt_pk_bf16(v.x, v.y) | ((unsigned long long)cvt_pk_bf16(v.z, v.w) << 32); }
    }
    {
        float* rope = (float*)(F.ws + WS_ROPE); const int* pos = (const int*)F.A->in[1];
        const int f = F.tid & 15;
        const float IF[16] = {1.0f, 0.44036659598350525f, 0.1939227432012558f, 0.08539710193872452f, 0.03760603070259094f, 0.016560440883040428f, 0.007292664609849453f, 0.0032114461064338684f,
                              0.0014142135623842478f, 0.0006227724370546639f, 0.00027424818836152554f, 0.00012076973507646471f, 5.3182957344688475e-05f, 2.34199997066753e-05f, 1.0313385246263351e-05f, 4.541670477919979e-06f};
        float inv = 0.f;
#pragma unroll
        for (int k = 0; k < 16; ++k) inv = (f == k) ? IF[k] : inv;
        for (int i = F.vcu * 512 + F.tid; i < MTOK * 16; i += F.G * 512) {
            const int row = i >> 4; const float ang = (float)pos[row] * inv;
            double rev = (double)ang * 0.15915494309189535; rev -= __builtin_rint(rev); const float rv = (float)rev;
            rope[(size_t)row * 32 + f] = __builtin_amdgcn_cosf(rv); rope[(size_t)row * 32 + 16 + f] = __builtin_amdgcn_sinf(rv);
        }
    }
    {
        float* WrT = (float*)(F.ws + WS_WRT);
        for (int i = F.vcu * 512 + F.tid; i < DEPTH * 20 * DM; i += F.G * 512) {
            const int l = i / (20 * DM), o = (i / DM) % 20, k = i % DM;
            WrT[i] = (o < 4) ? F.A->in[8][((size_t)l * DM + k) * 4 + o] : F.A->in[10][((size_t)l * DM + k) * 16 + (o - 4)];
        }
    }
}

__device__ __forceinline__ void ln1_router(Frame& F0, int l) {
    struct { LAS unsigned char* lds; unsigned* ctl; unsigned char* ws; int tid, lane, wave, vcu; const Args* A; float* out; } F;
    F.lds = F0.lds; F.ctl = F0.ctl; F.ws = F0.ws; F.tid = opq(F0.tid); F.lane = F.tid & 63; F.wave = __builtin_amdgcn_readfirstlane(F.tid >> 6); F.vcu = F0.vcu; F.A = F0.A; F.out = F0.out;
    LAS float* Wl = (LAS float*)F.lds;
    LAS float* Pt = (LAS float*)(F.lds + 81920);
    const float* gam = F.A->in[6] + (size_t)(l * 2) * DM; const float* bet = F.A->in[7] + (size_t)(l * 2) * DM;
    const float* WrT = (const float*)(F.ws + WS_WRT) + (size_t)l * 20 * DM;
    bf16_t* HB = (bf16_t*)(F.ws + WS_HB);
    const int row0 = F.vcu * 64;
    for (int pass = 0; pass < 2; ++pass) {
        for (int i = F.tid; i < 20 * 256; i += 512) { const int o = i >> 8, k4 = i & 255; *(LAS f32x4*)(Wl + o * 1024 + 4 * k4) = *(const f32x4*)(WrT + (size_t)o * DM + pass * 1024 + 4 * k4); }
        __syncthreads();
        for (int i = 0; i < 8; ++i) {
            const int rl = F.wave * 8 + i, row = row0 + rl;
            f32x4* xr = (f32x4*)(F.out + (size_t)row * DM) + F.lane;
            f32x4 v[8]; float s = 0.f;
#pragma unroll
            for (int j = 0; j < 8; ++j) { v[j] = xr[64 * j]; s += (v[j].x + v[j].y) + (v[j].z + v[j].w); }
            const float mean = wave_sum(s) * (1.f / DM); float s2 = 0.f;
#pragma unroll
            for (int j = 0; j < 8; ++j) { v[j] = v[j] - mean; s2 += (v[j].x * v[j].x + v[j].y * v[j].y) + (v[j].z * v[j].z + v[j].w * v[j].w); }
            const float rstd = 1.f / sqrtf(wave_sum(s2) * (1.f / DM) + LN_EPS);
#pragma unroll
            for (int j = 0; j < 8; ++j) { const f32x4 g4 = ((const f32x4*)gam)[F.lane + 64 * j], b4 = ((const f32x4*)bet)[F.lane + 64 * j]; v[j] = v[j] * rstd * g4 + b4; }
            if (pass == 1) {
                unsigned long long* o8 = (unsigned long long*)(HB + (size_t)row * DM) + F.lane;
#pragma unroll
                for (int j = 0; j < 8; ++j) { xr[64 * j] = v[j]; o8[64 * j] = (unsigned long long)cvt_pk_bf16(v[j].x, v[j].y) | ((unsigned long long)cvt_pk_bf16(v[j].z, v[j].w) << 32); }
            }
            float acc[20];
#pragma unroll
            for (int o = 0; o < 20; ++o) acc[o] = 0.f;
#pragma unroll
            for (int jj = 0; jj < 4; ++jj) { const f32x4 x = pass == 0 ? v[jj] : v[4 + jj];
#pragma unroll
                for (int o = 0; o < 20; ++o) { const f32x4 w = *(const LAS f32x4*)(Wl + o * 1024 + 4 * F.lane + 256 * jj); acc[o] += (x.x * w.x + x.y * w.y) + (x.z * w.z + x.w * w.w); } }
            float mine = 0.f;
#pragma unroll
            for (int o = 0; o < 20; ++o) { const float t = wave_sum(acc[o]); mine = (F.lane == o) ? t : mine; }
            if (F.lane < 20) { if (pass == 0) Pt[rl * 20 + F.lane] = mine; else Pt[rl * 20 + F.lane] += mine; }
        }
        __syncthreads();
    }
    if (F.wave == 0) {
        const int rl = F.lane, row = row0 + rl;
        const float* cb = F.A->in[9] + l * 4; const float* fb = F.A->in[11] + l * 16;
        float c[4], f[16];
#pragma unroll
        for (int j = 0; j < 4; ++j) c[j] = Pt[rl * 20 + j] + cb[j];
#pragma unroll
        for (int j = 0; j < 16; ++j) f[j] = Pt[rl * 20 + 4 + j] + fb[j];
        float cmax = c[0]; int g = 0;
#pragma unroll
        for (int j = 1; j < 4; ++j) if (c[j] > cmax) { cmax = c[j]; g = j; }
        float se = 0.f;
#pragma unroll
        for (int j = 0; j < 4; ++j) se += __expf(c[j] - cmax);
        const float pgrp = 1.0f / se;
        float sel[4];
#pragma unroll
        for (int i = 0; i < 4; ++i) sel[i] = (g == 0) ? f[i] : (g == 1) ? f[4 + i] : (g == 2) ? f[8 + i] : f[12 + i];
        float v1 = sel[0]; int i1 = 0;
#pragma unroll
        for (int i = 1; i < 4; ++i) if (sel[i] > v1) { v1 = sel[i]; i1 = i; }
        float v2 = -__builtin_inff(); int i2 = 0;
#pragma unroll
        for (int i = 0; i < 4; ++i) if (i != i1 && sel[i] > v2) { v2 = sel[i]; i2 = i; }
        const float w1 = 1.0f / (1.0f + __expf(v2 - v1)), w2 = 1.0f - w1;
        const int e1 = 4 * g + i1, e2 = 4 * g + i2;
        const unsigned long long lt = (1ull << F.lane) - 1ull;
        int r1 = 0, r2 = 0, mycnt = 0;
#pragma unroll
        for (int e = 0; e < NEXP; ++e) { const unsigned long long m1 = __ballot(e1 == e), m2 = __ballot(e2 == e); const int c1 = __popcll(m1);
            if (e1 == e) r1 = __popcll(m1 & lt); if (e2 == e) r2 = c1 + __popcll(m2 & lt); if (F.lane == e) mycnt = c1 + __popcll(m2); }
        int base = 0;
        if (F.lane < NEXP && mycnt > 0) base = (int)__hip_atomic_fetch_add(F.ctl + CW_ECNT + 64 * l + F.lane, (unsigned)mycnt, __ATOMIC_RELAXED, __HIP_MEMORY_SCOPE_AGENT);
        const int pos1 = __shfl(base, e1) + r1, pos2 = __shfl(base, e2) + r2;
        int* list = (int*)(F.ws + WS_LIST);
        list[e1 * ECAP + pos1] = row; list[e2 * ECAP + pos2] = row;
        ((u32x4*)(F.ws + WS_TOK))[row] = (u32x4){(unsigned)(e1 << 16 | pos1), __float_as_uint(pgrp * w1), (unsigned)(e2 << 16 | pos2), __float_as_uint(pgrp * w2)};
    }
    __syncthreads();
}
__device__ __forceinline__ void moe_tables(Frame& F, int l) {
    LAS int* LT = (LAS int*)(F.lds + LT_OFF);
    if (F.tid == 0) { int t = 0;
        for (int e = 0; e < NEXP; ++e) { const int c = (int)__hip_atomic_load(F.ctl + CW_ECNT + 64 * l + e, __ATOMIC_RELAXED, __HIP_MEMORY_SCOPE_AGENT); LT[e] = t; LT[32 + e] = c; t += (c + 255) >> 8; }
        LT[16] = t; }
    __syncthreads();
    if (F.tid < 160) { const int rt = F.tid; int e = 0;
#pragma unroll
        for (int j = 1; j < NEXP; ++j) e += (LT[j] <= rt) ? 1 : 0;
        LT[64 + rt] = e; }
    __syncthreads();
}
__device__ __forceinline__ void ln2_phase(Frame& F0, int l) {
    struct { LAS unsigned char* lds; unsigned char* ws; int lane, wave, vcu, G; const Args* A; float* out; } F;
    F.lds = F0.lds; F.ws = F0.ws; { const int t = opq(F0.tid); F.lane = t & 63; F.wave = __builtin_amdgcn_readfirstlane(t >> 6); } F.vcu = F0.vcu; F.G = F0.G; F.A = F0.A; F.out = F0.out;
    const LAS int* LT = (const LAS int*)(F.lds + LT_OFF);
    const float* gam = F.A->in[6] + (size_t)(l * 2 + 1) * DM; const float* bet = F.A->in[7] + (size_t)(l * 2 + 1) * DM;
    bf16_t* HB = (bf16_t*)(F.ws + WS_HB); const bf16_t* YP = (const bf16_t*)(F.ws + WS_YP);
    const int gw = F.vcu * NWAVES + F.wave, NGW = F.G * NWAVES;
    for (int row = gw; row < MTOK; row += NGW) {
        const u32x4 ti = ((const u32x4*)(F.ws + WS_TOK))[row];
        const int e1 = ti.x >> 16, p1 = ti.x & 0xffff, e2 = ti.z >> 16, p2 = ti.z & 0xffff; const float g1 = __uint_as_float(ti.y), g2 = __uint_as_float(ti.w);
        const size_t s1 = (size_t)LT[e1] * 256 + p1, s2 = (size_t)LT[e2] * 256 + p2;
        f32x4* xr = (f32x4*)(F.out + (size_t)row * DM) + F.lane;
        const u32x2* y1 = (const u32x2*)(YP + s1 * DM) + F.lane; const u32x2* y2 = (const u32x2*)(YP + s2 * DM) + F.lane;
        f32x4 v[8]; float s = 0.f;
#pragma unroll
        for (int j = 0; j < 8; ++j) { const f32x4 h = xr[64 * j]; const u32x2 a = y1[64 * j], b = y2[64 * j];
            v[j].x = ALPHA * h.x + g1 * bf_lo(a.x) + g2 * bf_lo(b.x); v[j].y = ALPHA * h.y + g1 * bf_hi(a.x) + g2 * bf_hi(b.x);
            v[j].z = ALPHA * h.z + g1 * bf_lo(a.y) + g2 * bf_lo(b.y); v[j].w = ALPHA * h.w + g1 * bf_hi(a.y) + g2 * bf_hi(b.y);
            s += (v[j].x + v[j].y) + (v[j].z + v[j].w); }
        const float mean = wave_sum(s) * (1.f / DM); float s2v = 0.f;
#pragma unroll
        for (int j = 0; j < 8; ++j) { v[j] = v[j] - mean; s2v += (v[j].x * v[j].x + v[j].y * v[j].y) + (v[j].z * v[j].z + v[j].w * v[j].w); }
        const float rstd = 1.f / sqrtf(wave_sum(s2v) * (1.f / DM) + LN_EPS);
        unsigned long long* o8 = (unsigned long long*)(HB + (size_t)row * DM) + F.lane;
#pragma unroll
        for (int j = 0; j < 8; ++j) { const f32x4 g4 = ((const f32x4*)gam)[F.lane + 64 * j], b4 = ((const f32x4*)bet)[F.lane + 64 * j]; const f32x4 o = v[j] * rstd * g4 + b4;
            xr[64 * j] = o; if (l + 1 < DEPTH) o8[64 * j] = (unsigned long long)cvt_pk_bf16(o.x, o.y) | ((unsigned long long)cvt_pk_bf16(o.z, o.w) << 32); }
    }
}

constexpr int N_PHASES = 1 + 8 * DEPTH;
__global__ void __launch_bounds__(NWAVES * 64, 2) mk_fwd(Args args) {
    extern __shared__ __attribute__((aligned(16))) unsigned char lds_raw[];
    Frame F;
    F.lds = (LAS unsigned char*)lds_raw; F.MISC = (volatile LAS unsigned*)(F.lds + MISC_OFF);
    F.tid = threadIdx.x; F.lane = F.tid & 63; F.wave = __builtin_amdgcn_readfirstlane(F.tid >> 6);
    F.G = gridDim.x; { const int bx = blockIdx.x; F.vcu = (F.G % 8 == 0) ? (bx % 8) * (F.G / 8) + bx / 8 : bx; }
    F.ws = args.ws; F.ctl = (unsigned*)(args.ws + WS_CTL); F.out = args.out;
    F.A = &args;
    for (int u = F.tid; u < (LDS_BYTES - LDSCTL_OFF) / 4; u += NWAVES * 64) ((LAS unsigned*)(F.lds + LDSCTL_OFF))[u] = 0u;
    __syncthreads();
    const int lo = args.ph_lo, hi = args.ph_hi;
    XcdBarrier bar; bar.bar = F.ctl + CW_BAR; bar.x = 0; bar.st = nullptr;
    if (hi - lo > 1) bar = xcd_barrier_post(F.ctl + CW_BAR, F.MISC + 8);
#ifndef PHMASK
#define PHMASK 0x1ff
#endif
#define IN(k) (lo <= (k) && (k) < hi)
#define PH(s) ((PHMASK >> (s)) & 1)
#define SEAM(k) do { if (IN(k) && IN((k) + 1)) xcd_barrier(bar); } while (0)
    if (PH(0) && IN(0)) { p0_prologue(F); SEAM(0); }
    bf16_t* HB = (bf16_t*)(F.ws + WS_HB);
    bf16_t* QKV = (bf16_t*)(F.ws + WS_QKV); bf16_t* GATES = (bf16_t*)(F.ws + WS_GATES);
    bf16_t* OA = (bf16_t*)(F.ws + WS_OA); bf16_t* OB = (bf16_t*)(F.ws + WS_OB);
    for (int l = 0; l < DEPTH; ++l) {
        const int pb = 1 + 8 * l;
        const bf16_t* LW = (const bf16_t*)(F.ws + WS_W + (size_t)l * LW_BYTES);
        if (PH(1) && IN(pb + 0)) {
            pg8::Gemm g{HB, LW + LW_IN / 2, DM}; pg8::StaticOrder S; S.init(MTOK, NIN, F.G, (int)blockIdx.x);
            pg8::EpiProj E{QKV, GATES, (const float*)(F.ws + WS_ROPE)};
            pg8::gemm_phase<pg8::EpiProj, pg8::StaticOrder, true, false>(F.lds, g, S, E);
            SEAM(pb + 0);
        }
        if (PH(2) && IN(pb + 1)) {
            att::SbTensors TB{QKV + (size_t)3 * MTOK * WA, QKV + (size_t)3 * MTOK * WA + (size_t)MTOK * WB, QKV + (size_t)3 * MTOK * WA + (size_t)2 * MTOK * WB, OB};
            for (int c = F.vcu; c < 256; c += F.G) { const int bh = c >> 2, pr = c & 3;
                att::sb_unit(TB, bh >> 3, bh & 7, 7 - pr, F.lds); att::sb_unit(TB, bh >> 3, bh & 7, pr, F.lds); }
            att::DaTensors TA{QKV, QKV + (size_t)MTOK * WA, QKV + (size_t)2 * MTOK * WA, (bf16_t*)(F.ws + WS_PO), (float*)(F.ws + WS_PL)};
            for (int a = F.vcu; a < 128; a += F.G) att::da_unit(TA, OA, a >> 4, (a >> 2) & 3, a & 3, F.lds, (LAS float*)(F.lds + WSCR_OFF));
            SEAM(pb + 1);
        }
        if (PH(3) && IN(pb + 2)) {
            bf16_t* P1 = (bf16_t*)(F.ws + WS_P1); bf16_t* MRG = (bf16_t*)(F.ws + WS_MRG);
            pg8::StaticOrder S; S.init(MTOK, DM, F.G, (int)blockIdx.x);
            { pg8::Gemm g{OA, LW + LW_PA / 2, 512}; pg8::EpiGate<false> E{GATES, P1, MRG}; pg8::gemm_phase<pg8::EpiGate<false>, pg8::StaticOrder, true, false>(F.lds, g, S, E); }
            { pg8::Gemm g{OB, LW + LW_PB / 2, 1024}; pg8::EpiGate<true> E{GATES + (size_t)MTOK * DM, P1, MRG}; pg8::gemm_phase<pg8::EpiGate<true>, pg8::StaticOrder, true, false>(F.lds, g, S, E); }
            SEAM(pb + 2);
        }
        if (PH(4) && IN(pb + 3)) {
            pg8::Gemm g{(const bf16_t*)(F.ws + WS_MRG), LW + LW_WO / 2, DM}; pg8::StaticOrder S; S.init(MTOK, DM, F.G, (int)blockIdx.x);
            pg8::EpiResid E{l == 0 ? F.A->in[0] : F.out, F.out};
            pg8::gemm_phase<pg8::EpiResid, pg8::StaticOrder, true, false>(F.lds, g, S, E);
            SEAM(pb + 3);
        }
        if (PH(5) && IN(pb + 4)) { ln1_router(F, l); SEAM(pb + 4); }
        if (PH(6) && IN(pb + 5)) {
            moe_tables(F, l);
            const LAS int* LT = (const LAS int*)(F.lds + LT_OFF);
            pg8::MoeOrder S{4, F.G, F.vcu, LT[16] * 4, LT, LT + 32, (const int*)(F.ws + WS_LIST)};
            pg8::Gemm g{HB, LW + LW_UP / 2, DM}; pg8::EpiSwiglu E{(bf16_t*)(F.ws + WS_HID)};
            pg8::gemm_phase<pg8::EpiSwiglu, pg8::MoeOrder, true, true>(F.lds, g, S, E);
            SEAM(pb + 5);
        }
        if (PH(7) && IN(pb + 6)) {
            moe_tables(F, l);
            const LAS int* LT = (const LAS int*)(F.lds + LT_OFF);
            pg8::MoeOrder S{8, F.G, F.vcu, LT[16] * 8, LT, LT + 32, (const int*)(F.ws + WS_LIST)};
            pg8::Gemm g{(const bf16_t*)(F.ws + WS_HID), LW + LW_DN / 2, FF}; pg8::EpiBf16 E{(bf16_t*)(F.ws + WS_YP), DM};
            pg8::gemm_phase<pg8::EpiBf16, pg8::MoeOrder, true, false>(F.lds, g, S, E);
            SEAM(pb + 6);
        }
        if (PH(8) && IN(pb + 7)) { moe_tables(F, l); ln2_phase(F, l); SEAM(pb + 7); }
    }
#undef IN
#undef SEAM
}

extern "C" void kernel_launch(void* const* d_in, const int* in_sizes, int n_in, void* d_out, int out_size, void* d_ws, size_t ws_size, hipStream_t stream) {
    static int grid = 0;
    if (grid == 0) {
        if (n_in != 14 || in_sizes[0] != MTOK * DM || out_size != MTOK * DM || ws_size < WS_END) { fprintf(stderr, "kernel_launch: unexpected shapes (n_in %d, in0 %d, out %d, ws %zu)\n", n_in, n_in > 0 ? in_sizes[0] : -1, out_size, ws_size); grid = -1; return; }
        int dev = 0, cus = 0;
        if (hipGetDevice(&dev) != hipSuccess || hipDeviceGetAttribute(&cus, hipDeviceAttributeMultiprocessorCount, dev) != hipSuccess) { grid = -1; return; }
        if (hipFuncSetAttribute((const void*)mk_fwd, hipFuncAttributeMaxDynamicSharedMemorySize, LDS_BYTES) != hipSuccess) { fprintf(stderr, "kernel_launch: hipFuncSetAttribute failed\n"); grid = -1; return; }
        int per_cu = 0;
        if (hipOccupancyMaxActiveBlocksPerMultiprocessor(&per_cu, (const void*)mk_fwd, NWAVES * 64, LDS_BYTES) != hipSuccess || per_cu < 1) fprintf(stderr, "kernel_launch: occupancy query reports %d\n", per_cu);
        (void)hipGetLastError();
        if (cus < 256) { fprintf(stderr, "kernel_launch: needs 256 CUs, device has %d\n", cus); grid = -1; return; }
        grid = 256;
    }
    if (grid < 0) return;
    if (hipMemsetAsync((char*)d_ws + WS_CTL, 0, CTL_ZERO_BYTES, stream) != hipSuccess) return;
    Args a{};
    for (int i = 0; i < 14; ++i) a.in[i] = (const float*)d_in[i];
    a.out = (float*)d_out; a.ws = (unsigned char*)d_ws;
#if MK_ONE_LAUNCH
    a.ph_lo = 0; a.ph_hi = N_PHASES;
    hipLaunchKernelGGL(mk_fwd, dim3(grid), dim3(NWAVES * 64), LDS_BYTES, stream, a);
#else
    for (int p = 0; p < N_PHASES; ++p) { a.ph_lo = p; a.ph_hi = p + 1; hipLaunchKernelGGL(mk_fwd, dim3(grid), dim3(NWAVES * 64), LDS_BYTES, stream, a); }
#endif
}
```

```cpp
#include <hip/hip_runtime.h>
#include <cstdio>
#include <cstdint>

#define LAS __attribute__((address_space(3)))
#define GAS __attribute__((address_space(1)))
typedef unsigned short bf16_t;
typedef short bf16x8 __attribute__((ext_vector_type(8)));
typedef short s16x4 __attribute__((ext_vector_type(4)));
typedef float f32x4 __attribute__((ext_vector_type(4)));
typedef float f32x2 __attribute__((ext_vector_type(2)));
typedef float f32x16 __attribute__((ext_vector_type(16)));
typedef unsigned u32x4 __attribute__((ext_vector_type(4)));
typedef unsigned u32x2 __attribute__((ext_vector_type(2)));
typedef int i32x4 __attribute__((ext_vector_type(4)));

constexpr int BATCH = 8, SEQ = 2048, DM = 2048, DEPTH = 2, MTOK = BATCH * SEQ;
constexpr int HD = 128, WA = 1536, WB = 1024, NIN = 11776;
constexpr int NEXP = 16, FF = 512, ECAP = 16384;
constexpr float LN_EPS = 1e-5f;
constexpr float ALPHA = 1.4142135623730951f;
constexpr float LOG2E = 1.4426950408889634f;
constexpr float QK_C2 = 0.08838834764831845f * LOG2E;

__device__ __forceinline__ unsigned cvt_pk_bf16(float lo, float hi) { unsigned r; asm volatile("v_cvt_pk_bf16_f32 %0, %1, %2" : "=v"(r) : "v"(lo), "v"(hi)); return r; }
__device__ __forceinline__ float bf_lo(unsigned w) { return __uint_as_float(w << 16); }
__device__ __forceinline__ float bf_hi(unsigned w) { return __uint_as_float(w & 0xffff0000u); }
__device__ __forceinline__ float sigmoidf_fast(float x) { return __builtin_amdgcn_rcpf(1.0f + __builtin_amdgcn_exp2f(-x * LOG2E)); }

namespace pg8 {
constexpr int BM = 256, BK = 64, HALF = 128, HTB = HALF * BK * 2, STAGE_BYTES = 8 * HTB, NXCD = 8, WGM = 8;
__host__ __device__ __forceinline__ int lds_byte(int r, int c) { const int st = (r >> 4) * 2 + (c >> 5), rr = r & 15, cc = c & 31, ob = rr * 64 + cc * 2; return st * 1024 + (ob ^ (((ob >> 9) & 1) << 5)); }
__host__ __device__ __forceinline__ void stage_rc(int b, int& R, int& C) { const int st = b / 1024, sb = b % 1024, swz = sb ^ (((sb >> 9) & 1) << 5); R = (st >> 1) * 16 + swz / 64; C = (st & 1) * 32 + (swz % 64) / 2; }
__host__ __device__ __forceinline__ int perm32(int rho) { const int n = rho >> 4, i = rho & 15; return 8 * (i >> 2) + 4 * n + (i & 3); }

struct Unit { int pm, pn, pb, e, r0; };
struct Gemm { const bf16_t* A; const bf16_t* Bt; int K; };

struct StaticOrder {
    int nM, nN, nwg, G, c;
    __device__ void init(int M, int N, int G_, int c_) { nM = M / BM; nN = N / BM; nwg = nM * nN; G = G_; c = c_; }
    __device__ bool next(int i, Unit& u) const {
        const long L = (long)i * G + c; if (L >= nwg) return false;
        int wgid = (int)L; { const int q = nwg / NXCD, r = nwg % NXCD, xcd = wgid % NXCD, off = wgid / NXCD; wgid = (xcd < r ? xcd * (q + 1) : r * (q + 1) + (xcd - r) * q) + off; }
        const int nig = WGM * nN, gid = wgid / nig, fm = gid * WGM, gsz = (nM - fm) < WGM ? (nM - fm) : WGM;
        u.pm = fm + ((wgid % nig) % gsz); u.pn = (wgid % nig) / gsz; u.pb = u.pn; u.e = 0; u.r0 = 0; return true;
    }
    __device__ __forceinline__ int tok(const Unit&, int) const { return 0; }
};
struct MoeOrder {
    int nct, G, c, total; const LAS int* tb; const LAS int* cnt; const int* list;
    __device__ bool next(int i, Unit& u) const {
        const long L = (long)i * G + c; if (L >= total) return false;
        const int rt = (int)L / nct, ct = (int)L % nct; const int e = __builtin_amdgcn_readfirstlane(tb[64 + rt]);
        u.pm = rt; u.pn = ct; u.pb = e * nct + ct; u.e = e; u.r0 = (rt - __builtin_amdgcn_readfirstlane(tb[e])) * BM; return true;
    }
    __device__ __forceinline__ int tok(const Unit& u, int row) const { const int cn = cnt[u.e]; int pos = u.r0 + row; pos = pos < cn ? pos : cn - 1; return list[u.e * ECAP + pos]; }
};

template <class Epi, class Sched, bool ALIGN_EPI, bool GATHER, bool I8 = false>
__device__ __forceinline__ void gemm_phase(LAS unsigned char* lds, const Gemm g, const Sched& S, const Epi& E) {
    int tid = threadIdx.x; asm volatile("" : "+v"(tid));
    const int wid = __builtin_amdgcn_readfirstlane(tid >> 6), lane = tid & 63, wr = wid >> 2, wc = wid & 3, fr = lane & 15, fq = lane >> 4;
    const int K = g.K, nt = K / BK;
    const size_t kstep = (size_t)(BK * 2);
    const size_t hstep = (size_t)HALF * K * 2;
    const size_t tstep = 2 * hstep;
    int RA[2], CA[2]; unsigned voffB[2];
#pragma unroll
    for (int i = 0; i < 2; ++i) { int R, C; stage_rc(tid * 16 + i * 8192, R, C); const int Rb = Epi::PERM ? ((R & ~31) + perm32(R & 31)) : R; RA[i] = R; CA[i] = C; voffB[i] = (unsigned)(Rb * K + C) * 2u; }
    const unsigned ldsw = (unsigned)wid * 1024u;
    const int aoff = lds_byte(wr * 64 + fr, fq * 8), boff = lds_byte(wc * 32 + fr, fq * 8);
#define PG8_SA(b, h) (((b) * 2 + (h)) * HTB)
#define PG8_SB(b, h) ((4 + (b) * 2 + (h)) * HTB)
#define PG8_STAGE(bufoff, gbase, v0, v1) do { \
        __builtin_amdgcn_global_load_lds((const unsigned*)((const char*)(gbase) + (v0)), (LAS unsigned*)(lds + (bufoff) + ldsw), 16, 0, 0); \
        __builtin_amdgcn_global_load_lds((const unsigned*)((const char*)(gbase) + (v1)), (LAS unsigned*)(lds + (bufoff) + ldsw + 8192), 16, 0, 0); } while (0)
#define PG8_LDA(dst, b, h) do { _Pragma("unroll") for (int m = 0; m < 4; ++m) _Pragma("unroll") for (int k = 0; k < 2; ++k) dst[m][k] = *(const LAS bf16x8*)(lds + PG8_SA(b, h) + aoff + m * 2048 + k * 1024); } while (0)
#define PG8_LDB(dst, b, h) do { _Pragma("unroll") for (int n = 0; n < 2; ++n) _Pragma("unroll") for (int k = 0; k < 2; ++k) dst[n][k] = *(const LAS bf16x8*)(lds + PG8_SB(b, h) + boff + n * 2048 + k * 1024); } while (0)
#define PG8_MMA(ai, bj, At, Bt) do { __builtin_amdgcn_s_setprio(1); _Pragma("unroll") for (int m = 0; m < 4; ++m) _Pragma("unroll") for (int n = 0; n < 2; ++n) _Pragma("unroll") for (int k = 0; k < 2; ++k) { \
        if constexpr (I8) acc[ai][bj][m][n] = __builtin_bit_cast(AccT, __builtin_amdgcn_mfma_i32_16x16x64_i8(__builtin_bit_cast(i32x4, Bt[n][k]), __builtin_bit_cast(i32x4, At[m][k]), __builtin_bit_cast(i32x4, acc[ai][bj][m][n]), 0, 0, 0)); \
        else acc[ai][bj][m][n] = __builtin_bit_cast(AccT, __builtin_amdgcn_mfma_f32_16x16x32_bf16(Bt[n][k], At[m][k], __builtin_bit_cast(f32x4, acc[ai][bj][m][n]), 0, 0, 0)); } __builtin_amdgcn_s_setprio(0); } while (0)
#define PG8_WAIT_V(n) asm volatile("s_waitcnt vmcnt(" #n ")" ::: "memory")
#define PG8_WAIT_L(n) asm volatile("s_waitcnt lgkmcnt(" #n ")" ::: "memory")
#define PG8_BAR __builtin_amdgcn_s_barrier()
#define PG8_SCHED __builtin_amdgcn_sched_barrier(0)
    Unit cur, nxt; int ui = 0;
    if (!S.next(0, cur)) return;
    typedef typename Epi::AccT AccT;
    AccT acc[2][2][4][2];
#pragma unroll
    for (int a = 0; a < 2; ++a)
#pragma unroll
        for (int b = 0; b < 2; ++b)
#pragma unroll
            for (int m = 0; m < 4; ++m)
#pragma unroll
                for (int n = 0; n < 2; ++n) acc[a][b][m][n] = AccT{};
    bf16x8 At[4][2], B0[2][2], B1[2][2];
    unsigned c00, c01, c10, c11, n00, n01, n10, n11;
    if constexpr (GATHER) {
        c00 = (unsigned)(S.tok(cur, RA[0]) * K + CA[0]) * 2u; c01 = (unsigned)(S.tok(cur, RA[1]) * K + CA[1]) * 2u;
        c10 = (unsigned)(S.tok(cur, HALF + RA[0]) * K + CA[0]) * 2u; c11 = (unsigned)(S.tok(cur, HALF + RA[1]) * K + CA[1]) * 2u;
    } else {
        c00 = (unsigned)(RA[0] * K + CA[0]) * 2u; c01 = (unsigned)(RA[1] * K + CA[1]) * 2u; c10 = c00 + (unsigned)hstep; c11 = c01 + (unsigned)hstep;
    }
    n00 = c00; n01 = c01; n10 = c10; n11 = c11;
    const char* cA = GATHER ? (const char*)g.A : (const char*)g.A + (size_t)cur.pm * tstep; const char* cB = (const char*)g.Bt + (size_t)cur.pb * tstep;
    PG8_STAGE(PG8_SB(0, 0), cB, voffB[0], voffB[1]); PG8_STAGE(PG8_SB(0, 1), cB + hstep, voffB[0], voffB[1]); PG8_STAGE(PG8_SA(0, 0), cA, c00, c01); PG8_STAGE(PG8_SA(0, 1), cA, c10, c11);
    if (wr == 1) PG8_BAR;
    PG8_WAIT_V(2); PG8_BAR;
    PG8_STAGE(PG8_SB(1, 0), cB + kstep, voffB[0], voffB[1]); PG8_STAGE(PG8_SA(1, 0), cA + kstep, c00, c01); PG8_STAGE(PG8_SB(1, 1), cB + hstep + kstep, voffB[0], voffB[1]);
    PG8_WAIT_V(6); PG8_BAR;
    for (;;) {
        const bool has_next = S.next(ui + 1, nxt);
        const char* nA = has_next ? (GATHER ? (const char*)g.A : (const char*)g.A + (size_t)nxt.pm * tstep) : cA; const char* nB = has_next ? (const char*)g.Bt + (size_t)nxt.pb * tstep : cB;
        if constexpr (GATHER) {
            if (has_next) {
                n00 = (unsigned)(S.tok(nxt, RA[0]) * K + CA[0]) * 2u; n01 = (unsigned)(S.tok(nxt, RA[1]) * K + CA[1]) * 2u;
                n10 = (unsigned)(S.tok(nxt, HALF + RA[0]) * K + CA[0]) * 2u; n11 = (unsigned)(S.tok(nxt, HALF + RA[1]) * K + CA[1]) * 2u;
            } else { n00 = c00; n01 = c01; n10 = c10; n11 = c11; }
        }
        for (int t = 0; t < nt; t += 2) {
            const bool last = (t == nt - 2);
            const char* a1 = cA + (size_t)(t + 1) * kstep;
            const char* a2 = last ? nA : cA + (size_t)(t + 2) * kstep; const char* b2 = last ? nB : cB + (size_t)(t + 2) * kstep;
            const char* a3 = a2 + kstep; const char* b3 = b2 + kstep;
            const unsigned o00 = last ? n00 : c00, o01 = last ? n01 : c01, o10 = last ? n10 : c10, o11 = last ? n11 : c11;
            PG8_LDB(B0, 0, 0); PG8_LDB(B1, 0, 1); PG8_SCHED; PG8_LDA(At, 0, 0); PG8_STAGE(PG8_SA(1, 1), a1, c10, c11);
            PG8_WAIT_V(8); PG8_WAIT_L(0); PG8_BAR; PG8_MMA(0, 0, At, B0); PG8_MMA(0, 1, At, B1); PG8_BAR; PG8_SCHED;
            PG8_LDA(At, 0, 1); PG8_STAGE(PG8_SB(0, 0), b2, voffB[0], voffB[1]); PG8_STAGE(PG8_SB(0, 1), b2 + hstep, voffB[0], voffB[1]); PG8_STAGE(PG8_SA(0, 0), a2, o00, o01);
            PG8_WAIT_V(8); PG8_WAIT_L(0); PG8_BAR; PG8_MMA(1, 0, At, B0); PG8_MMA(1, 1, At, B1); PG8_BAR; PG8_SCHED;
            PG8_LDB(B0, 1, 0); PG8_LDB(B1, 1, 1); PG8_SCHED; PG8_LDA(At, 1, 0); PG8_STAGE(PG8_SA(0, 1), a2, o10, o11);
            PG8_WAIT_V(8); PG8_WAIT_L(0); PG8_BAR; PG8_MMA(0, 0, At, B0); PG8_MMA(0, 1, At, B1); PG8_BAR; PG8_SCHED;
            PG8_LDA(At, 1, 1); PG8_STAGE(PG8_SB(1, 0), b3, voffB[0], voffB[1]); PG8_STAGE(PG8_SB(1, 1), b3 + hstep, voffB[0], voffB[1]); PG8_STAGE(PG8_SA(1, 0), a3, o00, o01);
            PG8_WAIT_V(8); PG8_WAIT_L(0); PG8_BAR; PG8_MMA(1, 0, At, B0); PG8_MMA(1, 1, At, B1); PG8_BAR; PG8_SCHED;
        }
        if constexpr (ALIGN_EPI) { if (wr == 0) PG8_BAR; }
        E(acc, cur, wr, wc, fr, fq);
        if (!has_next) break;
#pragma unroll
        for (int a = 0; a < 2; ++a)
#pragma unroll
            for (int b = 0; b < 2; ++b)
#pragma unroll
                for (int m = 0; m < 4; ++m)
#pragma unroll
                    for (int n = 0; n < 2; ++n) acc[a][b][m][n] = AccT{};
        cur = nxt; cA = nA; cB = nB; ++ui; c00 = n00; c01 = n01; c10 = n10; c11 = n11;
        if constexpr (ALIGN_EPI) { if (wr == 1) PG8_BAR; }
    }
    PG8_WAIT_V(0);
    if constexpr (!ALIGN_EPI) { if (wr == 0) PG8_BAR; }
    PG8_BAR;
#undef PG8_SA
#undef PG8_SB
#undef PG8_STAGE
#undef PG8_LDA
#undef PG8_LDB
#undef PG8_MMA
#undef PG8_WAIT_V
#undef PG8_WAIT_L
#undef PG8_BAR
#undef PG8_SCHED
}
}
namespace pg8 {
struct EpiProj {
    static constexpr bool PERM = true; typedef i32x4 AccT;
    bf16_t* qkv;
    bf16_t* gates;
    const float* rope;
    const float* sa;
    const float* sb;
    __device__ __forceinline__ void operator()(const i32x4 (&acc)[2][2][4][2], const Unit& u, int wr, int wc, int fr, int fq) const {
        const int pn = u.pn; bf16_t* base; int ldc, ct0;
        if (pn < 18) { const int t = pn / 6; base = qkv + (size_t)t * MTOK * WA; ldc = WA; ct0 = t * 6; }
        else if (pn < 30) { const int t = (pn - 18) / 4; base = qkv + (size_t)3 * MTOK * WA + (size_t)t * MTOK * WB; ldc = WB; ct0 = 18 + t * 4; }
        else { const int t = (pn - 30) / 8; base = gates + (size_t)t * MTOK * DM; ldc = DM; ct0 = 30 + t * 8; }
        const int row0 = u.pm * BM + wr * 64 + fr, col0 = (pn - ct0) * BM + wc * 32 + 8 * fq, bcol0 = pn * BM + wc * 32 + 8 * fq;
        const bool do_rope = (pn < 12) && (wc == 0);
        f32x4 sbv[2][2];
#pragma unroll
        for (int bj = 0; bj < 2; ++bj)
#pragma unroll
            for (int n = 0; n < 2; ++n) sbv[bj][n] = *(const f32x4*)(sb + bcol0 + bj * HALF + 4 * n);
#pragma unroll
        for (int ai = 0; ai < 2; ++ai)
#pragma unroll
            for (int m = 0; m < 4; ++m) { const int row = row0 + ai * HALF + m * 16; bf16_t* rowp = base + (size_t)row * ldc + col0;
                const float sar = sa[row];
                f32x4 cs = (f32x4){1.f, 1.f, 1.f, 1.f}, sn = (f32x4){0.f, 0.f, 0.f, 0.f};
                if (do_rope) { cs = *(const f32x4*)(rope + (size_t)row * 32 + 4 * fq); sn = *(const f32x4*)(rope + (size_t)row * 32 + 16 + 4 * fq); }
#pragma unroll
                for (int bj = 0; bj < 2; ++bj) { f32x4 v0 = __builtin_convertvector(acc[ai][bj][m][0], f32x4) * (sbv[bj][0] * sar), v1 = __builtin_convertvector(acc[ai][bj][m][1], f32x4) * (sbv[bj][1] * sar);
                    if (do_rope) { const f32x4 y0 = v0 * cs - v1 * sn, y1 = v1 * cs + v0 * sn; v0 = y0; v1 = y1; }
                    u32x4 w; w.x = cvt_pk_bf16(v0[0], v0[1]); w.y = cvt_pk_bf16(v0[2], v0[3]); w.z = cvt_pk_bf16(v1[0], v1[1]); w.w = cvt_pk_bf16(v1[2], v1[3]);
                    *(u32x4*)(rowp + bj * HALF) = w; }
                asm volatile("" ::: "memory"); }
    }
};
struct EpiBf16 {
    static constexpr bool PERM = true; typedef f32x4 AccT;
    bf16_t* O; int ldc;
    __device__ __forceinline__ void operator()(const f32x4 (&acc)[2][2][4][2], const Unit& u, int wr, int wc, int fr, int fq) const {
        const int row0 = u.pm * BM + wr * 64 + fr, col0 = u.pn * BM + wc * 32 + 8 * fq;
#pragma unroll
        for (int ai = 0; ai < 2; ++ai)
#pragma unroll
            for (int m = 0; m < 4; ++m) { bf16_t* rowp = O + (size_t)(row0 + ai * HALF + m * 16) * ldc + col0;
#pragma unroll
                for (int bj = 0; bj < 2; ++bj) { const f32x4 v0 = acc[ai][bj][m][0], v1 = acc[ai][bj][m][1];
                    u32x4 w; w.x = cvt_pk_bf16(v0[0], v0[1]); w.y = cvt_pk_bf16(v0[2], v0[3]); w.z = cvt_pk_bf16(v1[0], v1[1]); w.w = cvt_pk_bf16(v1[2], v1[3]);
                    *(u32x4*)(rowp + bj * HALF) = w; } }
    }
};
template <bool SECOND> struct EpiGate {
    static constexpr bool PERM = true; typedef f32x4 AccT;
    const bf16_t* gate; bf16_t* P1; bf16_t* out;
    __device__ __forceinline__ void operator()(const f32x4 (&acc)[2][2][4][2], const Unit& u, int wr, int wc, int fr, int fq) const {
        const int row0 = u.pm * BM + wr * 64 + fr, col0 = u.pn * BM + wc * 32 + 8 * fq;
#pragma unroll
        for (int ai = 0; ai < 2; ++ai)
#pragma unroll
            for (int m = 0; m < 4; ++m) { const size_t off = (size_t)(row0 + ai * HALF + m * 16) * DM + col0;
#pragma unroll
                for (int bj = 0; bj < 2; ++bj) { const f32x4 v0 = acc[ai][bj][m][0], v1 = acc[ai][bj][m][1];
                    const u32x4 gw = *(const u32x4*)(gate + off + bj * HALF);
                    float r[8];
                    r[0] = sigmoidf_fast(bf_lo(gw.x)) * v0[0]; r[1] = sigmoidf_fast(bf_hi(gw.x)) * v0[1]; r[2] = sigmoidf_fast(bf_lo(gw.y)) * v0[2]; r[3] = sigmoidf_fast(bf_hi(gw.y)) * v0[3];
                    r[4] = sigmoidf_fast(bf_lo(gw.z)) * v1[0]; r[5] = sigmoidf_fast(bf_hi(gw.z)) * v1[1]; r[6] = sigmoidf_fast(bf_lo(gw.w)) * v1[2]; r[7] = sigmoidf_fast(bf_hi(gw.w)) * v1[3];
                    if (SECOND) { const u32x4 pw = *(const u32x4*)(P1 + off + bj * HALF);
                        r[0] += bf_lo(pw.x); r[1] += bf_hi(pw.x); r[2] += bf_lo(pw.y); r[3] += bf_hi(pw.y); r[4] += bf_lo(pw.z); r[5] += bf_hi(pw.z); r[6] += bf_lo(pw.w); r[7] += bf_hi(pw.w); }
                    u32x4 w; w.x = cvt_pk_bf16(r[0], r[1]); w.y = cvt_pk_bf16(r[2], r[3]); w.z = cvt_pk_bf16(r[4], r[5]); w.w = cvt_pk_bf16(r[6], r[7]);
                    *(u32x4*)((SECOND ? out : P1) + off + bj * HALF) = w; }
                asm volatile("" ::: "memory"); }
    }
};
struct EpiResid {
    static constexpr bool PERM = true; typedef f32x4 AccT;
    const bf16_t* h; bf16_t* z;
    __device__ __forceinline__ void operator()(const f32x4 (&acc)[2][2][4][2], const Unit& u, int wr, int wc, int fr, int fq) const {
        const int row0 = u.pm * BM + wr * 64 + fr, col0 = u.pn * BM + wc * 32 + 8 * fq;
#pragma unroll
        for (int ai = 0; ai < 2; ++ai)
#pragma unroll
            for (int m = 0; m < 4; ++m) { const size_t off = (size_t)(row0 + ai * HALF + m * 16) * DM + col0;
#pragma unroll
                for (int bj = 0; bj < 2; ++bj) { const f32x4 v0 = acc[ai][bj][m][0], v1 = acc[ai][bj][m][1];
                    const u32x4 hw = *(const u32x4*)(h + off + bj * HALF);
                    u32x4 w; w.x = cvt_pk_bf16(ALPHA * bf_lo(hw.x) + v0[0], ALPHA * bf_hi(hw.x) + v0[1]); w.y = cvt_pk_bf16(ALPHA * bf_lo(hw.y) + v0[2], ALPHA * bf_hi(hw.y) + v0[3]);
                    w.z = cvt_pk_bf16(ALPHA * bf_lo(hw.z) + v1[0], ALPHA * bf_hi(hw.z) + v1[1]); w.w = cvt_pk_bf16(ALPHA * bf_lo(hw.w) + v1[2], ALPHA * bf_hi(hw.w) + v1[3]);
                    *(u32x4*)(z + off + bj * HALF) = w; }
                asm volatile("" ::: "memory"); }
    }
};
struct EpiSwiglu {
    static constexpr bool PERM = true; typedef f32x4 AccT;
    bf16_t* Hd;
    __device__ __forceinline__ void operator()(const f32x4 (&acc)[2][2][4][2], const Unit& u, int wr, int wc, int fr, int fq) const {
        const int row0 = u.pm * BM + wr * 64 + fr, col0 = u.pn * HALF + wc * 32 + 8 * fq;
#pragma unroll
        for (int ai = 0; ai < 2; ++ai)
#pragma unroll
            for (int m = 0; m < 4; ++m) { bf16_t* rowp = Hd + (size_t)(row0 + ai * HALF + m * 16) * FF + col0;
                float r[8];
#pragma unroll
                for (int n = 0; n < 2; ++n)
#pragma unroll
                    for (int j = 0; j < 4; ++j) { const float a = acc[ai][0][m][n][j], b = acc[ai][1][m][n][j]; r[4 * n + j] = a * sigmoidf_fast(a) * b; }
                u32x4 w; w.x = cvt_pk_bf16(r[0], r[1]); w.y = cvt_pk_bf16(r[2], r[3]); w.z = cvt_pk_bf16(r[4], r[5]); w.w = cvt_pk_bf16(r[6], r[7]);
                *(u32x4*)rowp = w; }
    }
};
}
namespace att {
#define SBAR() __builtin_amdgcn_sched_barrier(0)
#define KSWZ(row, colB) ((row) * 256 + ((colB) ^ (((row) & 7) << 4)))
__device__ __forceinline__ int v_st(int k, int c) { const int kk = (k & ~0xC) | ((k & 4) << 1) | ((k & 8) >> 1); return ((kk >> 3) * 4 + (c >> 5)) * 512 + ((kk & 7) * 32 + (c & 31)) * 2; }
__device__ __forceinline__ int v_rd_base(int lane) { return ((lane & 3) << 3) | (((lane >> 2) & 3) << 6) | (((lane >> 4) & 1) << 5) | (((lane >> 5) & 1) << 8); }
__device__ __forceinline__ int crow(int r, int hi) { return (r & 3) + 8 * (r >> 2) + 4 * hi; }
__device__ __forceinline__ float partner_f(float x, int hi) { auto rr = __builtin_amdgcn_permlane32_swap(__float_as_uint(x), __float_as_uint(x), false, false); return __uint_as_float(hi ? rr[0] : rr[1]); }
#define PK4(P, B_, OUT) do { unsigned a0 = cvt_pk_bf16(P[B_+0], P[B_+1]), a1 = cvt_pk_bf16(P[B_+2], P[B_+3]);                          \
        unsigned b0 = cvt_pk_bf16(P[B_+4], P[B_+5]), b1 = cvt_pk_bf16(P[B_+6], P[B_+7]);                                             \
        auto r0 = __builtin_amdgcn_permlane32_swap(a0, b0, false, false); auto r1 = __builtin_amdgcn_permlane32_swap(a1, b1, false, false); \
        u32x4 w = {r0[0], r1[0], r0[1], r1[1]}; OUT = *reinterpret_cast<bf16x8*>(&w); } while (0)
#define TRRD(dst, addr, off) asm volatile("ds_read_b64_tr_b16 %0, %1 offset:%2" : "=&v"(dst) : "v"(addr), "i"(off) : "memory")

__device__ __forceinline__ void qkt32(f32x16& p, unsigned kaddr, int r32, int hi, const bf16x8* qr) {
    p = f32x16{};
    unsigned kb[4];
#pragma unroll
    for (int dd = 0; dd < 4; ++dd) kb[dd] = kaddr + KSWZ(r32, (dd * 16 + hi * 8) * 2);
#pragma unroll
    for (int d0 = 0; d0 < 8; ++d0) { const bf16x8 b0 = *(const LAS bf16x8*)(uintptr_t)(kb[d0 & 3] + (d0 >> 2) * 128);
        p = __builtin_amdgcn_mfma_f32_32x32x16_bf16(b0, qr[d0], p, 0, 0, 0); }
}
__device__ __forceinline__ void pv32(f32x16* o, unsigned vaddr, bf16x8 pa0, bf16x8 pa1) {
#define PV_D0(d0) do { s16x4 l0, l1, h0, h1; constexpr int b_ = (d0) * 512; \
        TRRD(l0, vaddr, b_); TRRD(h0, vaddr, b_ + 2048); TRRD(l1, vaddr, b_ + 4096); TRRD(h1, vaddr, b_ + 6144); \
        asm volatile("s_waitcnt lgkmcnt(0)" ::: "memory"); SBAR(); \
        o[d0] = __builtin_amdgcn_mfma_f32_32x32x16_bf16(pa0, (bf16x8){l0[0], l0[1], l0[2], l0[3], h0[0], h0[1], h0[2], h0[3]}, o[d0], 0, 0, 0); \
        o[d0] = __builtin_amdgcn_mfma_f32_32x32x16_bf16(pa1, (bf16x8){l1[0], l1[1], l1[2], l1[3], h1[0], h1[1], h1[2], h1[3]}, o[d0], 0, 0, 0); } while (0)
    PV_D0(0); PV_D0(1); PV_D0(2); PV_D0(3);
#undef PV_D0
}
template <class RowPtr>
__device__ __forceinline__ void store_o_bf16(const f32x16* o, const float* rscale, int r32, int hi, const RowPtr& rowp) {
#pragma unroll
    for (int r = 0; r < 16; ++r) { bf16_t* rp = rowp(crow(r, hi));
#pragma unroll
        for (int d0 = 0; d0 < 4; ++d0) { const float v = o[d0][r] * rscale[r]; const float vn = __shfl_xor(v, 1);
            if ((r32 & 1) == 0) *(unsigned*)(rp + d0 * 32 + r32) = cvt_pk_bf16(v, vn); } }
}

template <bool MASK>
__device__ __forceinline__ void sb_half(f32x16& p, float& C, int dq, int hi) {
    float om[16];
#pragma unroll
    for (int r = 0; r < 16; ++r) {
        float z = p[r] * QK_C2; z = fminf(fmaxf(z, -115.f), 115.f);
        const float e = __builtin_amdgcn_exp2f(-z); float b = __builtin_amdgcn_rcpf(1.0f + e); float o = e * b;
        if (MASK) { const bool v = ((r & 3) + 8 * (r >> 2)) < dq; b = v ? b : 0.f; o = v ? o : 1.f; }
        p[r] = b; om[r] = o; }
    float g[4], pg[4], eh[4];
#pragma unroll
    for (int c = 0; c < 4; ++c) { g[c] = (om[4 * c] * om[4 * c + 1]) * (om[4 * c + 2] * om[4 * c + 3]); pg[c] = partner_f(g[c], hi); }
    eh[3] = C; eh[2] = eh[3] * (g[3] * pg[3]); eh[1] = eh[2] * (g[2] * pg[2]); eh[0] = eh[1] * (g[1] * pg[1]); C = eh[0] * (g[0] * pg[0]);
#pragma unroll
    for (int c = 3; c >= 0; --c) { float E = hi ? eh[c] : eh[c] * pg[c];
#pragma unroll
        for (int r = 4 * c + 3; r >= 4 * c; --r) { p[r] *= E; E *= om[r]; } }
}

struct SbTensors { const bf16_t* Q; const bf16_t* K; const bf16_t* V; bf16_t* O; };
__device__ __forceinline__ void sb_unit(const SbTensors& T, int b, int head, int qb, LAS unsigned char* lds) {
    int tid = threadIdx.x; asm volatile("" : "+v"(tid));
    const int wid = __builtin_amdgcn_readfirstlane(tid >> 6), lane = tid & 63, r32 = lane & 31, hi = lane >> 5;
    const size_t rowbase = (size_t)b * SEQ;
    const int q0 = qb * 256 + wid * 32;
    const int tq = q0 + r32;
    bf16x8 qr[8];
    { const bf16_t* qp = T.Q + (rowbase + tq) * WB + head * HD + hi * 8;
#pragma unroll
      for (int d0 = 0; d0 < 8; ++d0) qr[d0] = *(const bf16x8*)(qp + d0 * 16); }
    const bf16_t* Kh = T.K + rowbase * WB + head * HD; const bf16_t* Vh = T.V + rowbase * WB + head * HD;
    const int sr = tid >> 4, sc = (tid & 15) * 8;
    const int kws = KSWZ(sr, sc * 2), vst0 = v_st(sr, sc), vst1 = v_st(32 + sr, sc);
    const unsigned Kl = (unsigned)(uintptr_t)lds, Vl = Kl + 32768u, vrb = (unsigned)v_rd_base(lane);
    f32x16 o[4] = {}; float C = 1.0f;
    const int NT = 4 * qb + 4;
    bf16x8 sk0, sk1, sv0, sv1;
#define SB_LOAD(jt) do { const bf16_t* kp = Kh + (size_t)((jt) * 64 + sr) * WB + sc; const bf16_t* vp = Vh + (size_t)((jt) * 64 + sr) * WB + sc; \
        sk0 = *(const bf16x8*)kp; sk1 = *(const bf16x8*)(kp + 32 * WB); sv0 = *(const bf16x8*)vp; sv1 = *(const bf16x8*)(vp + 32 * WB); } while (0)
#define SB_WRITE(bf) do { *(LAS bf16x8*)(lds + (bf) * 16384 + kws) = sk0; *(LAS bf16x8*)(lds + (bf) * 16384 + kws + 32 * 256) = sk1; \
        *(LAS bf16x8*)(lds + 32768 + (bf) * 16384 + vst0) = sv0; *(LAS bf16x8*)(lds + 32768 + (bf) * 16384 + vst1) = sv1; } while (0)
    SB_LOAD(NT - 1); SB_WRITE(0);
    __syncthreads();
    for (int it = 0; it < NT; ++it) {
        const int jt = NT - 1 - it, bf = it & 1, kb = jt * 64;
        if (it + 1 < NT) SB_LOAD(jt - 1);
        if (kb <= q0 + 30) {
            const unsigned ka = Kl + bf * 16384u, va = Vl + bf * 16384u + vrb;
            f32x16 p0, p1; bf16x8 pa0, pa1, pa2, pa3;
            qkt32(p0, ka, r32, hi, qr); qkt32(p1, ka + 32 * 256, r32, hi, qr);
            if (kb + 63 >= q0) { sb_half<true>(p1, C, tq - kb - 32 - 4 * hi, hi); sb_half<true>(p0, C, tq - kb - 4 * hi, hi); }
            else { sb_half<false>(p1, C, 0, hi); sb_half<false>(p0, C, 0, hi); }
            PK4(p0, 0, pa0); PK4(p0, 8, pa1); PK4(p1, 0, pa2); PK4(p1, 8, pa3);
            pv32(o, va, pa0, pa1); pv32(o, va + 8192, pa2, pa3);
        }
        if (it + 1 < NT) SB_WRITE(bf ^ 1);
        __syncthreads();
    }
#undef SB_LOAD
#undef SB_WRITE
    float ones[16];
#pragma unroll
    for (int r = 0; r < 16; ++r) ones[r] = 1.0f;
    bf16_t* Ob = T.O + (rowbase + q0) * WB + head * HD;
    store_o_bf16(o, ones, r32, hi, [&](int row) { return Ob + (size_t)row * WB; });
}

struct DaTensors { const bf16_t* Q; const bf16_t* K; const bf16_t* V; bf16_t* PO; float* PL; };
__device__ __forceinline__ void da_job(const DaTensors& T, int b, int h, int g, int rho, int u0, LAS unsigned char* wl, LAS float* ws) {
    int lane = threadIdx.x & 63; asm volatile("" : "+v"(lane));
    const int r32 = lane & 31, hi = lane >> 5;
    const int dsh = 2 * g, dil = 1 << dsh;
    const size_t rowbase = (size_t)b * SEQ; const int colh = g * 512 + h * HD;
    bf16x8 qr[8];
    { const bf16_t* qp = T.Q + (rowbase + (size_t)(((u0 + r32) << dsh) + rho)) * WA + colh + hi * 8;
#pragma unroll
      for (int d0 = 0; d0 < 8; ++d0) qr[d0] = *(const bf16x8*)(qp + d0 * 16); }
    const unsigned Kl = (unsigned)(uintptr_t)wl, Vl = Kl + 8192u + (unsigned)v_rd_base(lane);
    LAS float* al_l = ws; LAS float* li_l = ws + 32;
    f32x16 o[4] = {}; float m_reg = -1e30f, l_reg = 0.f;
    const int srow = lane >> 4, sc = (lane & 15) * 8;
    for (int tau = 0; tau < 5; ++tau) {
        const int ub = u0 - 128 + 32 * tau;
        if (ub < 0) continue;
        { bf16x8 kk[8];
#pragma unroll
        for (int c = 0; c < 8; ++c) { const int ki = srow + 4 * c; const size_t ro = (rowbase + (size_t)(((ub + ki) << dsh) + rho)) * WA + colh + sc; kk[c] = *(const bf16x8*)(T.K + ro); }
#pragma unroll
        for (int c = 0; c < 8; ++c) { const int ki = srow + 4 * c; *(LAS bf16x8*)(wl + KSWZ(ki, sc * 2)) = kk[c]; } }
        asm volatile("" ::: "memory");
        { bf16x8 vv[8];
#pragma unroll
        for (int c = 0; c < 8; ++c) { const int ki = srow + 4 * c; const size_t ro = (rowbase + (size_t)(((ub + ki) << dsh) + rho)) * WA + colh + sc; vv[c] = *(const bf16x8*)(T.V + ro); }
#pragma unroll
        for (int c = 0; c < 8; ++c) { const int ki = srow + 4 * c; *(LAS bf16x8*)(wl + 8192 + v_st(ki, sc)) = vv[c]; } }
        asm volatile("s_waitcnt lgkmcnt(0)" ::: "memory"); SBAR();
        f32x16 p; qkt32(p, Kl, r32, hi, qr);
        if (tau == 0 || tau == 4) { const int dq = u0 + r32 - ub - 4 * hi; const float NEG = -__builtin_inff();
#pragma unroll
            for (int r = 0; r < 16; ++r) { const int c = (r & 3) + 8 * (r >> 2); if ((unsigned)(dq - c) >= 129u) p[r] = NEG; } }
        float pmax = p[0];
#pragma unroll
        for (int r = 1; r < 16; ++r) pmax = fmaxf(pmax, p[r]);
        pmax = fmaxf(pmax, partner_f(pmax, hi));
        float alpha = 1.f;
        if (!__all((pmax - m_reg) * QK_C2 <= 8.0f * LOG2E)) {
            const float mn = fmaxf(m_reg, pmax); alpha = __builtin_amdgcn_exp2f((m_reg - mn) * QK_C2); m_reg = mn;
            if (hi == 0) al_l[r32] = alpha; asm volatile("s_waitcnt lgkmcnt(0)" ::: "memory");
#pragma unroll
            for (int r = 0; r < 16; ++r) { const float a = al_l[crow(r, hi)];
#pragma unroll
                for (int d0 = 0; d0 < 4; ++d0) o[d0][r] *= a; }
        }
        const float mnL = -m_reg * QK_C2; float ps = 0.f;
#pragma unroll
        for (int r = 0; r < 16; ++r) { p[r] = __builtin_amdgcn_exp2f(fmaf(p[r], QK_C2, mnL)); ps += p[r]; }
        ps += partner_f(ps, hi);
        l_reg = l_reg * alpha + ps;
        bf16x8 pa0, pa1; PK4(p, 0, pa0); PK4(p, 8, pa1);
        pv32(o, Vl, pa0, pa1);
    }
    if (hi == 0) li_l[r32] = l_reg; asm volatile("s_waitcnt lgkmcnt(0)" ::: "memory");
    float rli[16];
#pragma unroll
    for (int r = 0; r < 16; ++r) rli[r] = __builtin_amdgcn_rcpf(li_l[crow(r, hi)]);
    bf16_t* Pg = T.PO + (size_t)g * MTOK * 512 + h * HD;
    store_o_bf16(o, rli, r32, hi, [&](int row) { return Pg + (rowbase + (size_t)(((u0 + row) << dsh) + rho)) * 512; });
    if (hi == 0) T.PL[((size_t)g * MTOK + rowbase + (size_t)(((u0 + r32) << dsh) + rho)) * 4 + h] = m_reg * QK_C2 + __builtin_amdgcn_logf(l_reg);
}
__device__ __forceinline__ void da_unit(const DaTensors& T, bf16_t* OA, int b, int h, int chunk, LAS unsigned char* lds, LAS float* wscr) {
    int tid = threadIdx.x; asm volatile("" : "+v"(tid)); const int wid = __builtin_amdgcn_readfirstlane(tid >> 6);
    for (int jj = 0; jj < 6; ++jj) {
        const int job = wid + 8 * jj, g = job >> 4, idx = job & 15;
        int rho, u0;
        if (g == 0) { rho = 0; u0 = chunk * 512 + 32 * idx; }
        else if (g == 1) { rho = idx >> 2; u0 = chunk * 128 + 32 * (idx & 3); }
        else { rho = idx; u0 = chunk * 32; }
        da_job(T, b, h, g, rho, u0, lds + wid * 16384, wscr + wid * 64);
    }
    asm volatile("s_waitcnt vmcnt(0)" ::: "memory");
    __syncthreads();
    const size_t rowbase = (size_t)b * SEQ + (size_t)chunk * 512;
    for (int it = tid; it < 512 * 16; it += 512) {
        const int tk = it >> 4, ch = it & 15; const size_t row = rowbase + tk;
        const float l0 = T.PL[(0 * (size_t)MTOK + row) * 4 + h], l1 = T.PL[(1 * (size_t)MTOK + row) * 4 + h], l2 = T.PL[(2 * (size_t)MTOK + row) * 4 + h];
        const float mx = fmaxf(l0, fmaxf(l1, l2));
        float w0 = __builtin_amdgcn_exp2f(l0 - mx), w1 = __builtin_amdgcn_exp2f(l1 - mx), w2 = __builtin_amdgcn_exp2f(l2 - mx);
        const float inv = 1.0f / (w0 + w1 + w2); w0 *= inv; w1 *= inv; w2 *= inv;
        const size_t off = row * 512 + h * HD + ch * 8;
        const u32x4 a = *(const u32x4*)(T.PO + off), bq = *(const u32x4*)(T.PO + (size_t)MTOK * 512 + off), c = *(const u32x4*)(T.PO + (size_t)2 * MTOK * 512 + off);
        u32x4 w;
        w.x = cvt_pk_bf16(w0 * bf_lo(a.x) + w1 * bf_lo(bq.x) + w2 * bf_lo(c.x), w0 * bf_hi(a.x) + w1 * bf_hi(bq.x) + w2 * bf_hi(c.x));
        w.y = cvt_pk_bf16(w0 * bf_lo(a.y) + w1 * bf_lo(bq.y) + w2 * bf_lo(c.y), w0 * bf_hi(a.y) + w1 * bf_hi(bq.y) + w2 * bf_hi(c.y));
        w.z = cvt_pk_bf16(w0 * bf_lo(a.z) + w1 * bf_lo(bq.z) + w2 * bf_lo(c.z), w0 * bf_hi(a.z) + w1 * bf_hi(bq.z) + w2 * bf_hi(c.z));
        w.w = cvt_pk_bf16(w0 * bf_lo(a.w) + w1 * bf_lo(bq.w) + w2 * bf_lo(c.w), w0 * bf_hi(a.w) + w1 * bf_hi(bq.w) + w2 * bf_hi(c.w));
        *(u32x4*)(OA + off) = w;
    }
    __syncthreads();
}
#undef SBAR
}
#define MK_ONE_LAUNCH 1
constexpr int NWAVES = 8;
#ifndef MK_ONE_LAUNCH
#define MK_ONE_LAUNCH 1
#endif
constexpr size_t MiB = 1u << 20;
constexpr size_t WS_CTL = 0, CTL_ZERO_BYTES = 1 * MiB;
constexpr size_t WS_ROPE = 2 * MiB;
constexpr size_t WS_WRT = 4 * MiB;
constexpr size_t WS_SA = 4 * MiB + 512 * 1024;
constexpr size_t WS_SB = 4 * MiB + 768 * 1024;
constexpr size_t WS_TOK = 5 * MiB;
constexpr size_t WS_LIST = 6 * MiB;
constexpr size_t WS_PL = 7 * MiB;
constexpr size_t WS_W = 8 * MiB;
constexpr size_t LW_IN = 0, LW_PA = LW_IN + (size_t)NIN * DM * 2, LW_PB = LW_PA + (size_t)DM * 512 * 2, LW_WO = LW_PB + (size_t)DM * 1024 * 2,
                 LW_UP = LW_WO + (size_t)DM * DM * 2, LW_DN = LW_UP + (size_t)NEXP * 1024 * DM * 2, LW_BYTES = LW_DN + (size_t)NEXP * DM * FF * 2;
static_assert(LW_BYTES == 156 * MiB, "weights per layer");
constexpr size_t WS_HB = WS_W + 2 * LW_BYTES;
constexpr size_t WS_OA = WS_HB + 64 * MiB;
constexpr size_t WS_OB = WS_OA + 16 * MiB;
constexpr size_t WS_PO = WS_OB + 32 * MiB;
constexpr size_t WS_GATES = WS_PO + 48 * MiB;
constexpr size_t WS_QKV = WS_GATES + 128 * MiB;
constexpr size_t WS_P1 = WS_QKV;
constexpr size_t WS_Z = WS_P1;
constexpr size_t WS_MRG = WS_QKV + 64 * MiB;
constexpr size_t WS_HID = WS_QKV + 144 * MiB;
constexpr size_t WS_YP = WS_QKV;
constexpr size_t WS_H8 = WS_QKV + 240 * MiB;
constexpr size_t WS_END = WS_H8 + 32 * MiB;
static_assert(WS_HID >= WS_YP + (size_t)36864 * DM * 2 || WS_YP >= WS_HID + (size_t)36864 * FF * 2, "YP / HID overlap");
static_assert(WS_END <= 1024 * MiB, "workspace");
constexpr int CW_TMO = 0, CW_CODE = 1, CW_BAR = 4096, CW_ECNT = 16384;
constexpr int CW_CMAX = 32768;
static_assert((CW_CMAX + DEPTH * NIN) * 4 <= (int)CTL_ZERO_BYTES, "ctl");
#define XB_TMO      128
#define XB_XCNT(j)  (256  + 64 * (j))
#define XB_XSUB(j)  (1280 + 64 * (j))
#define XB_XGEN(j)  (2304 + 64 * (j))
#define XB_TOP      3328
#define XB_TOPGEN   3392
#define XCD_BAR_WORDS 3456
#define XB_SPIN_CAP (1u << 18)
constexpr int RING_BYTES = 131072, LDSCTL_OFF = RING_BYTES, MISC_OFF = LDSCTL_OFF + 320, LT_OFF = LDSCTL_OFF + 1024  , WSCR_OFF = LDSCTL_OFF + 2048  ;
constexpr int LDS_BYTES = 147456;

__device__ __forceinline__ unsigned xb_ld(unsigned* p)              { return __hip_atomic_load(p, __ATOMIC_RELAXED, __HIP_MEMORY_SCOPE_AGENT); }
__device__ __forceinline__ unsigned xb_add(unsigned* p, unsigned v) { return __hip_atomic_fetch_add(p, v, __ATOMIC_RELAXED, __HIP_MEMORY_SCOPE_AGENT); }
__device__ __forceinline__ unsigned xb_xcc_id() { return (unsigned)__builtin_amdgcn_s_getreg((3 << 11) | 20) & 0xFu; }
#define XB_SPIN(cond, bar) do { unsigned _sp = 0; while (cond) { __builtin_amdgcn_s_sleep(1); \
    if ((++_sp & 255u) == 0u) { if (xb_ld(&(bar)[XB_TMO])) break; if (_sp > XB_SPIN_CAP) { atomicAdd(&(bar)[XB_TMO], 1u); break; } } } } while (0)
struct XcdBarrier { unsigned* bar; unsigned x; volatile LAS unsigned* st; };
__device__ __forceinline__ XcdBarrier xcd_barrier_post(unsigned* bar, volatile LAS unsigned* st) {
    XcdBarrier b; b.bar = bar; b.x = xb_xcc_id(); b.st = st;
    if (threadIdx.x == 0) (void)xb_add(&bar[XB_XCNT(b.x)], 1u);
    return b;
}
__device__ __forceinline__ void xcd_barrier_complete(unsigned* bar, unsigned x, unsigned& nloc, unsigned& nx) {
    const unsigned G = gridDim.x * gridDim.y * gridDim.z;
    unsigned sum, cnt, mine, sp = 0u;
    for (;;) {
        sum = 0u; cnt = 0u; mine = 0u;
#pragma unroll
        for (unsigned j = 0; j < 16; ++j) { const unsigned c = xb_ld(&bar[XB_XCNT(j)]); sum += c; cnt += (c > 0u) ? 1u : 0u; mine = (j == x) ? c : mine; }
        if (sum == G) break;
        __builtin_amdgcn_s_sleep(1);
        if ((++sp & 255u) == 0u) { if (xb_ld(&bar[XB_TMO])) break; if (sp > XB_SPIN_CAP) { atomicAdd(&bar[XB_TMO], 1u); break; } }
    }
    nloc = mine > 0u ? mine : 1u; nx = cnt > 0u ? cnt : 1u;
}
__device__ __forceinline__ void xcd_barrier(const XcdBarrier& b) {
    asm volatile("s_waitcnt vmcnt(0)" ::: "memory");
    __syncthreads();
    if (threadIdx.x == 0) {
        unsigned* bar = b.bar;
        __builtin_amdgcn_s_waitcnt(0);
        unsigned nloc = b.st[0], nx = b.st[1];
        if (nloc == 0u) { xcd_barrier_complete(bar, b.x, nloc, nx); b.st[0] = nloc; b.st[1] = nx; }
        const unsigned old = xb_add(&bar[XB_XSUB(b.x)], 1u);
        const unsigned gen = old / nloc;
        if (old + 1u == (gen + 1u) * nloc) {
            __builtin_amdgcn_fence(__ATOMIC_RELEASE, "agent");
            asm volatile("s_waitcnt vmcnt(0)" ::: "memory");
            const unsigned og = xb_add(&bar[XB_TOP], 1u);
            const unsigned tg = og / nx;
            if (og + 1u == (tg + 1u) * nx) xb_add(&bar[XB_TOPGEN], 1u);
            else XB_SPIN(xb_ld(&bar[XB_TOPGEN]) == tg, bar);
            __builtin_amdgcn_fence(__ATOMIC_ACQUIRE, "agent");
            xb_add(&bar[XB_XGEN(b.x)], 1u);
            asm volatile("s_waitcnt vmcnt(0)" ::: "memory");
        } else {
            XB_SPIN(xb_ld(&bar[XB_XGEN(b.x)]) == gen, bar);
            __builtin_amdgcn_fence(__ATOMIC_ACQUIRE, "agent");
            asm volatile("s_waitcnt vmcnt(0)" ::: "memory");
        }
    }
    __syncthreads();
}

struct Args { const float* in[14]; float* out; unsigned char* ws; int ph_lo, ph_hi; };
static_assert(sizeof(Args) == 14 * 8 + 8 + 8 + 8, "Args has no padding");

__device__ __forceinline__ float wave_sum(float v) {
#pragma unroll
    for (int o = 1; o < 64; o <<= 1) v += __shfl_xor(v, o);
    return v;
}
__device__ __forceinline__ unsigned f2bf(float f) { unsigned u = __builtin_bit_cast(unsigned, f); return (u + 0x7fffu + ((u >> 16) & 1u)) >> 16; }
__device__ __forceinline__ unsigned pk2(float lo, float hi) { return f2bf(lo) | (f2bf(hi) << 16); }

template <int MAP> __device__ __forceinline__ int wmap(int n) {
    if (MAP == 1) {
        if (n < 2 * WA) { const int d = n & 127; if (d < 32) { const int dd = (d < 16) ? (((d >> 2) << 3) + (d & 3)) : ((((d - 16) >> 2) << 3) + 4 + (d & 3)); return (n & ~127) + dd; } }
        return n;
    } else if (MAP == 2) {
        if (n < FF) return ((n >> 7) << 8) + (n & 127);
        const int j = n - FF; return ((j >> 7) << 8) + 128 + (j & 127);
    }
    return n;
}
template <int MAP>
__device__ __forceinline__ void xpose_item(const float* W, int K, int N, bf16_t* WT, LAS float* scr, int item, int lane) {
    const int nblk = N / 32, kb = item / nblk, nb = item % nblk, k0 = 64 * kb, n0 = 32 * nb;
#pragma unroll 8
    for (int i = 0; i < 32; ++i) { const int kk = 2 * i + (lane >> 5); scr[kk * 33 + (lane & 31)] = W[(size_t)(k0 + kk) * N + n0 + (lane & 31)]; }
    asm volatile("s_waitcnt lgkmcnt(0)" ::: "memory");
    const int c = lane & 7;
#pragma unroll
    for (int j = 0; j < 4; ++j) { const int n = (lane >> 3) + 8 * j; const LAS float* s = scr + (8 * c) * 33 + n;
        u32x4 o; o.x = pk2(s[0 * 33], s[1 * 33]); o.y = pk2(s[2 * 33], s[3 * 33]); o.z = pk2(s[4 * 33], s[5 * 33]); o.w = pk2(s[6 * 33], s[7 * 33]);
        *(u32x4*)(WT + (size_t)wmap<MAP>(n0 + n) * K + k0 + 8 * c) = o; }
    asm volatile("s_waitcnt lgkmcnt(0)" ::: "memory");
}
__device__ __forceinline__ int opq(int x) { asm volatile("" : "+v"(x)); return x; }
struct Frame {
    LAS unsigned char* lds; volatile LAS unsigned* MISC; unsigned* ctl; unsigned char* ws;
    int tid, lane, wave, vcu, G;
    const Args* A; float* out;
};
constexpr int I_CMX = (DM / 256) * (NIN / 32);
constexpr int I_IN = (DM / 64) * (NIN / 32), I_PA = (512 / 64) * (DM / 32), I_PB = (1024 / 64) * (DM / 32), I_WO = (DM / 64) * (DM / 32),
              I_UP1 = (DM / 64) * (1024 / 32), I_UP = NEXP * I_UP1, I_DN1 = (FF / 64) * (DM / 32), I_DN = NEXP * I_DN1, I_LAYER0 = I_CMX + I_PA + I_PB + I_WO + I_UP + I_DN;

__device__ __forceinline__ float wave_max(float v) {
#pragma unroll
    for (int o = 1; o < 64; o <<= 1) v = fmaxf(v, __shfl_xor(v, o));
    return v;
}
__device__ __forceinline__ unsigned q8(float v, float inv) { const int q = (int)__builtin_rintf(v * inv); return (unsigned)(q < -127 ? -127 : (q > 127 ? 127 : q)) & 0xffu; }
__device__ __forceinline__ unsigned q8x4(float a, float b, float c, float d, float inv) { return q8(a, inv) | (q8(b, inv) << 8) | (q8(c, inv) << 16) | (q8(d, inv) << 24); }

__device__ __forceinline__ void colmax_item(const float* W, int N, unsigned* cmax, int item, int lane) {
    const int nblk = N / 32, kb = item / nblk, nb = item % nblk, k0 = 256 * kb, n0 = 32 * nb;
    float m = 0.f;
#pragma unroll 8
    for (int i = 0; i < 128; ++i) m = fmaxf(m, fabsf(W[(size_t)(k0 + 2 * i + (lane >> 5)) * N + n0 + (lane & 31)]));
    m = fmaxf(m, __shfl_xor(m, 32));
    if (lane < 32) __hip_atomic_fetch_max(cmax + n0 + lane, __float_as_uint(m), __ATOMIC_RELAXED, __HIP_MEMORY_SCOPE_AGENT);
}
template <int MAP>
__device__ __forceinline__ void quant_item(const float* W, int K, int N, unsigned char* WT, float* sb, const unsigned* cmax, LAS float* scr, int item, int lane) {
    const int nblk = N / 32, kb = item / nblk, nb = item % nblk, k0 = 64 * kb, n0 = 32 * nb;
#pragma unroll 8
    for (int i = 0; i < 32; ++i) { const int kk = 2 * i + (lane >> 5); scr[kk * 33 + (lane & 31)] = W[(size_t)(k0 + kk) * N + n0 + (lane & 31)]; }
    asm volatile("s_waitcnt lgkmcnt(0)" ::: "memory");
    const int c = lane & 3;
#pragma unroll
    for (int j = 0; j < 2; ++j) { const int n = (lane >> 2) + 16 * j; const LAS float* s = scr + (16 * c) * 33 + n;
        const float am = __uint_as_float(cmax[n0 + n]); const float inv = am > 0.f ? 127.0f / am : 0.f;
        u32x4 o; o.x = q8x4(s[0 * 33], s[1 * 33], s[2 * 33], s[3 * 33], inv); o.y = q8x4(s[4 * 33], s[5 * 33], s[6 * 33], s[7 * 33], inv);
        o.z = q8x4(s[8 * 33], s[9 * 33], s[10 * 33], s[11 * 33], inv); o.w = q8x4(s[12 * 33], s[13 * 33], s[14 * 33], s[15 * 33], inv);
        const int dr = wmap<MAP>(n0 + n);
        *(u32x4*)(WT + (size_t)dr * K + k0 + 16 * c) = o;
        if (kb == 0 && c == 0) sb[dr] = am * (1.0f / 127.0f); }
    asm volatile("s_waitcnt lgkmcnt(0)" ::: "memory");
}

__device__ __forceinline__ void p0_prologue(Frame& F) {
    LAS float* scr = (LAS float*)(F.lds + F.wave * 16384);
    const int gw = F.vcu * NWAVES + F.wave, NGW = F.G * NWAVES;
    for (int it = gw; it < DEPTH * I_LAYER0; it += NGW) {
        const int l = it / I_LAYER0; int r = it % I_LAYER0;
        bf16_t* LW = (bf16_t*)(F.ws + WS_W + (size_t)l * LW_BYTES);
        if (r < I_CMX) { colmax_item(F.A->in[2] + (size_t)l * DM * NIN, NIN, F.ctl + CW_CMAX + l * NIN, r, F.lane); continue; } r -= I_CMX;
        if (r < I_PA) { xpose_item<0>(F.A->in[3] + (size_t)l * 512 * DM, 512, DM, LW + LW_PA / 2, scr, r, F.lane); continue; } r -= I_PA;
        if (r < I_PB) { xpose_item<0>(F.A->in[4] + (size_t)l * 1024 * DM, 1024, DM, LW + LW_PB / 2, scr, r, F.lane); continue; } r -= I_PB;
        if (r < I_WO) { xpose_item<0>(F.A->in[5] + (size_t)l * DM * DM, DM, DM, LW + LW_WO / 2, scr, r, F.lane); continue; } r -= I_WO;
        if (r < I_UP) { const int e = r / I_UP1; xpose_item<2>(F.A->in[12] + ((size_t)l * NEXP + e) * DM * 1024, DM, 1024, LW + LW_UP / 2 + (size_t)e * 1024 * DM, scr, r % I_UP1, F.lane); continue; } r -= I_UP;
        { const int e = r / I_DN1; xpose_item<0>(F.A->in[13] + ((size_t)l * NEXP + e) * FF * DM, FF, DM, LW + LW_DN / 2 + (size_t)e * DM * FF, scr, r % I_DN1, F.lane); }
    }
    bf16_t* HB = (bf16_t*)(F.ws + WS_HB); unsigned char* H8 = F.ws + WS_H8; float* SA = (float*)(F.ws + WS_SA);
    for (int m = gw; m < MTOK; m += NGW) {
        const f32x4* xr = (const f32x4*)(F.A->in[0] + (size_t)m * DM) + F.lane; unsigned long long* o8 = (unsigned long long*)(HB + (size_t)m * DM) + F.lane;
        f32x4 v[8]; float am = 0.f;
#pragma unroll
        for (int j = 0; j < 8; ++j) { v[j] = xr[64 * j]; am = fmaxf(fmaxf(am, fmaxf(fabsf(v[j].x), fabsf(v[j].y))), fmaxf(fabsf(v[j].z), fabsf(v[j].w))); }
        am = wave_max(am); const float inv = am > 0.f ? 127.0f / am : 0.f;
        unsigned* o4 = (unsigned*)(H8 + (size_t)m * DM) + F.lane;
#pragma unroll
        for (int j = 0; j < 8; ++j) { o8[64 * j] = (unsigned long long)cvt_pk_bf16(v[j].x, v[j].y) | ((unsigned long long)cvt_pk_bf16(v[j].z, v[j].w) << 32); o4[64 * j] = q8x4(v[j].x, v[j].y, v[j].z, v[j].w, inv); }
        if (F.lane == 0) SA[m] = am * (1.0f / 127.0f);
    }
    {
        float* rope = (float*)(F.ws + WS_ROPE); const int* pos = (const int*)F.A->in[1];
        const int f = F.tid & 15;
        const float IF[16] = {1.0f, 0.44036659598350525f, 0.1939227432012558f, 0.08539710193872452f, 0.03760603070259094f, 0.016560440883040428f, 0.007292664609849453f, 0.0032114461064338684f,
                              0.0014142135623842478f, 0.0006227724370546639f, 0.00027424818836152554f, 0.00012076973507646471f, 5.3182957344688475e-05f, 2.34199997066753e-05f, 1.0313385246263351e-05f, 4.541670477919979e-06f};
        float inv = 0.f;
#pragma unroll
        for (int k = 0; k < 16; ++k) inv = (f == k) ? IF[k] : inv;
        for (int i = F.vcu * 512 + F.tid; i < MTOK * 16; i += F.G * 512) {
            const int row = i >> 4; const float ang = (float)pos[row] * inv;
            double rev = (double)ang * 0.15915494309189535; rev -= __builtin_rint(rev); const float rv = (float)rev;
            rope[(size_t)row * 32 + f] = __builtin_amdgcn_cosf(rv); rope[(size_t)row * 32 + 16 + f] = __builtin_amdgcn_sinf(rv);
        }
    }
    {
        float* WrT = (float*)(F.ws + WS_WRT);
        for (int i = F.vcu * 512 + F.tid; i < DEPTH * 20 * DM; i += F.G * 512) {
            const int l = i / (20 * DM), o = (i / DM) % 20, k = i % DM;
            WrT[i] = (o < 4) ? F.A->in[8][((size_t)l * DM + k) * 4 + o] : F.A->in[10][((size_t)l * DM + k) * 16 + (o - 4)];
        }
    }
}
__device__ __forceinline__ void p1_quant(Frame& F) {
    LAS float* scr = (LAS float*)(F.lds + F.wave * 16384);
    const int gw = F.vcu * NWAVES + F.wave, NGW = F.G * NWAVES;
    for (int it = gw; it < DEPTH * I_IN; it += NGW) {
        const int l = it / I_IN, r = it % I_IN;
        quant_item<1>(F.A->in[2] + (size_t)l * DM * NIN, DM, NIN, F.ws + WS_W + (size_t)l * LW_BYTES + LW_IN, (float*)(F.ws + WS_SB) + l * NIN, F.ctl + CW_CMAX + l * NIN, scr, r, F.lane);
    }
}

__device__ __forceinline__ void unpack8(const u32x4 w, float* f) { f[0] = bf_lo(w.x); f[1] = bf_hi(w.x); f[2] = bf_lo(w.y); f[3] = bf_hi(w.y); f[4] = bf_lo(w.z); f[5] = bf_hi(w.z); f[6] = bf_lo(w.w); f[7] = bf_hi(w.w); }
__device__ __forceinline__ u32x4 pack8f(const float* f) { u32x4 w; w.x = cvt_pk_bf16(f[0], f[1]); w.y = cvt_pk_bf16(f[2], f[3]); w.z = cvt_pk_bf16(f[4], f[5]); w.w = cvt_pk_bf16(f[6], f[7]); return w; }

__device__ __forceinline__ void ln1_router(Frame& F0, int l) {
    struct { LAS unsigned char* lds; unsigned* ctl; unsigned char* ws; int tid, lane, wave, vcu; const Args* A; } F;
    F.lds = F0.lds; F.ctl = F0.ctl; F.ws = F0.ws; F.tid = opq(F0.tid); F.lane = F.tid & 63; F.wave = __builtin_amdgcn_readfirstlane(F.tid >> 6); F.vcu = F0.vcu; F.A = F0.A;
    LAS float* Wl = (LAS float*)F.lds;
    LAS float* Pt = (LAS float*)(F.lds + 81920);
    const float* gam = F.A->in[6] + (size_t)(l * 2) * DM; const float* bet = F.A->in[7] + (size_t)(l * 2) * DM;
    const float* WrT = (const float*)(F.ws + WS_WRT) + (size_t)l * 20 * DM;
    bf16_t* HB = (bf16_t*)(F.ws + WS_HB); const bf16_t* Z = (const bf16_t*)(F.ws + WS_Z);
    const int row0 = F.vcu * 64;
    for (int pass = 0; pass < 2; ++pass) {
        for (int i = F.tid; i < 20 * 256; i += 512) { const int o = i >> 8, k4 = i & 255; *(LAS f32x4*)(Wl + o * 1024 + 4 * k4) = *(const f32x4*)(WrT + (size_t)o * DM + pass * 1024 + 4 * k4); }
        __syncthreads();
        for (int i = 0; i < 8; ++i) {
            const int rl = F.wave * 8 + i, row = row0 + rl;
            const u32x4* zr = (const u32x4*)(Z + (size_t)row * DM) + F.lane;
            float v[4][8]; float s = 0.f;
#pragma unroll
            for (int j = 0; j < 4; ++j) { unpack8(zr[64 * j], v[j]);
#pragma unroll
                for (int e = 0; e < 8; ++e) s += v[j][e]; }
            const float mean = wave_sum(s) * (1.f / DM); float s2 = 0.f;
#pragma unroll
            for (int j = 0; j < 4; ++j)
#pragma unroll
                for (int e = 0; e < 8; ++e) { v[j][e] -= mean; s2 += v[j][e] * v[j][e]; }
            const float rstd = 1.f / sqrtf(wave_sum(s2) * (1.f / DM) + LN_EPS);
#pragma unroll
            for (int j = 0; j < 4; ++j) { const f32x4 g0 = ((const f32x4*)gam)[2 * F.lane + 128 * j], g1 = ((const f32x4*)gam)[2 * F.lane + 128 * j + 1], b0 = ((const f32x4*)bet)[2 * F.lane + 128 * j], b1 = ((const f32x4*)bet)[2 * F.lane + 128 * j + 1];
#pragma unroll
                for (int e = 0; e < 4; ++e) { v[j][e] = v[j][e] * rstd * g0[e] + b0[e]; v[j][4 + e] = v[j][4 + e] * rstd * g1[e] + b1[e]; } }
            if (pass == 1) { u32x4* hr = (u32x4*)(HB + (size_t)row * DM) + F.lane;
#pragma unroll
                for (int j = 0; j < 4; ++j) hr[64 * j] = pack8f(v[j]); }
            float acc[20];
#pragma unroll
            for (int o = 0; o < 20; ++o) acc[o] = 0.f;
#pragma unroll
            for (int jj = 0; jj < 2; ++jj) {
#pragma unroll
                for (int o = 0; o < 20; ++o) { const f32x4 w0 = *(const LAS f32x4*)(Wl + o * 1024 + 8 * F.lane + 512 * jj), w1 = *(const LAS f32x4*)(Wl + o * 1024 + 8 * F.lane + 512 * jj + 4);
                    const float* x = pass == 0 ? v[jj] : v[2 + jj];
                    acc[o] += ((x[0] * w0.x + x[1] * w0.y) + (x[2] * w0.z + x[3] * w0.w)) + ((x[4] * w1.x + x[5] * w1.y) + (x[6] * w1.z + x[7] * w1.w)); } }
            float mine = 0.f;
#pragma unroll
            for (int o = 0; o < 20; ++o) { const float t = wave_sum(acc[o]); mine = (F.lane == o) ? t : mine; }
            if (F.lane < 20) { if (pass == 0) Pt[rl * 20 + F.lane] = mine; else Pt[rl * 20 + F.lane] += mine; }
        }
        __syncthreads();
    }
    if (F.wave == 0) {
        const int rl = F.lane, row = row0 + rl;
        const float* cb = F.A->in[9] + l * 4; const float* fb = F.A->in[11] + l * 16;
        float c[4], f[16];
#pragma unroll
        for (int j = 0; j < 4; ++j) c[j] = Pt[rl * 20 + j] + cb[j];
#pragma unroll
        for (int j = 0; j < 16; ++j) f[j] = Pt[rl * 20 + 4 + j] + fb[j];
        float cmax = c[0]; int g = 0;
#pragma unroll
        for (int j = 1; j < 4; ++j) if (c[j] > cmax) { cmax = c[j]; g = j; }
        float se = 0.f;
#pragma unroll
        for (int j = 0; j < 4; ++j) se += __expf(c[j] - cmax);
        const float pgrp = 1.0f / se;
        float sel[4];
#pragma unroll
        for (int i = 0; i < 4; ++i) sel[i] = (g == 0) ? f[i] : (g == 1) ? f[4 + i] : (g == 2) ? f[8 + i] : f[12 + i];
        float v1 = sel[0]; int i1 = 0;
#pragma unroll
        for (int i = 1; i < 4; ++i) if (sel[i] > v1) { v1 = sel[i]; i1 = i; }
        float v2 = -__builtin_inff(); int i2 = 0;
#pragma unroll
        for (int i = 0; i < 4; ++i) if (i != i1 && sel[i] > v2) { v2 = sel[i]; i2 = i; }
        const float w1 = 1.0f / (1.0f + __expf(v2 - v1)), w2 = 1.0f - w1;
        const int e1 = 4 * g + i1, e2 = 4 * g + i2;
        const unsigned long long lt = (1ull << F.lane) - 1ull;
        int r1 = 0, r2 = 0, mycnt = 0;
#pragma unroll
        for (int e = 0; e < NEXP; ++e) { const unsigned long long m1 = __ballot(e1 == e), m2 = __ballot(e2 == e); const int c1 = __popcll(m1);
            if (e1 == e) r1 = __popcll(m1 & lt); if (e2 == e) r2 = c1 + __popcll(m2 & lt); if (F.lane == e) mycnt = c1 + __popcll(m2); }
        int base = 0;
        if (F.lane < NEXP && mycnt > 0) base = (int)__hip_atomic_fetch_add(F.ctl + CW_ECNT + 64 * l + F.lane, (unsigned)mycnt, __ATOMIC_RELAXED, __HIP_MEMORY_SCOPE_AGENT);
        const int pos1 = __shfl(base, e1) + r1, pos2 = __shfl(base, e2) + r2;
        int* list = (int*)(F.ws + WS_LIST);
        list[e1 * ECAP + pos1] = row; list[e2 * ECAP + pos2] = row;
        ((u32x4*)(F.ws + WS_TOK))[row] = (u32x4){(unsigned)(e1 << 16 | pos1), __float_as_uint(pgrp * w1), (unsigned)(e2 << 16 | pos2), __float_as_uint(pgrp * w2)};
    }
    __syncthreads();
}
__device__ __forceinline__ void moe_tables(Frame& F, int l) {
    LAS int* LT = (LAS int*)(F.lds + LT_OFF);
    if (F.tid == 0) { int t = 0;
        for (int e = 0; e < NEXP; ++e) { const int c = (int)__hip_atomic_load(F.ctl + CW_ECNT + 64 * l + e, __ATOMIC_RELAXED, __HIP_MEMORY_SCOPE_AGENT); LT[e] = t; LT[32 + e] = c; t += (c + 255) >> 8; }
        LT[16] = t; }
    __syncthreads();
    if (F.tid < 160) { const int rt = F.tid; int e = 0;
#pragma unroll
        for (int j = 1; j < NEXP; ++j) e += (LT[j] <= rt) ? 1 : 0;
        LT[64 + rt] = e; }
    __syncthreads();
}
__device__ __forceinline__ void ln2_phase(Frame& F0, int l) {
    struct { LAS unsigned char* lds; unsigned char* ws; int lane, wave, vcu, G; const Args* A; float* out; } F;
    F.lds = F0.lds; F.ws = F0.ws; { const int t = opq(F0.tid); F.lane = t & 63; F.wave = __builtin_amdgcn_readfirstlane(t >> 6); } F.vcu = F0.vcu; F.G = F0.G; F.A = F0.A; F.out = F0.out;
    const LAS int* LT = (const LAS int*)(F.lds + LT_OFF);
    const float* gam = F.A->in[6] + (size_t)(l * 2 + 1) * DM; const float* bet = F.A->in[7] + (size_t)(l * 2 + 1) * DM;
    bf16_t* HB = (bf16_t*)(F.ws + WS_HB); const bf16_t* YP = (const bf16_t*)(F.ws + WS_YP); unsigned char* H8 = F.ws + WS_H8; float* SA = (float*)(F.ws + WS_SA);
    const int gw = F.vcu * NWAVES + F.wave, NGW = F.G * NWAVES;
    for (int row = gw; row < MTOK; row += NGW) {
        const u32x4 ti = ((const u32x4*)(F.ws + WS_TOK))[row];
        const int e1 = ti.x >> 16, p1 = ti.x & 0xffff, e2 = ti.z >> 16, p2 = ti.z & 0xffff; const float g1 = __uint_as_float(ti.y), g2 = __uint_as_float(ti.w);
        const size_t s1 = (size_t)LT[e1] * 256 + p1, s2 = (size_t)LT[e2] * 256 + p2;
        u32x4* hr = (u32x4*)(HB + (size_t)row * DM) + F.lane;
        const u32x4* y1 = (const u32x4*)(YP + s1 * DM) + F.lane; const u32x4* y2 = (const u32x4*)(YP + s2 * DM) + F.lane;
        float v[4][8]; float s = 0.f;
#pragma unroll
        for (int j = 0; j < 4; ++j) { float h[8], a[8], b[8]; unpack8(hr[64 * j], h); unpack8(y1[64 * j], a); unpack8(y2[64 * j], b);
#pragma unroll
            for (int e = 0; e < 8; ++e) { v[j][e] = ALPHA * h[e] + g1 * a[e] + g2 * b[e]; s += v[j][e]; } }
        const float mean = wave_sum(s) * (1.f / DM); float s2v = 0.f;
#pragma unroll
        for (int j = 0; j < 4; ++j)
#pragma unroll
            for (int e = 0; e < 8; ++e) { v[j][e] -= mean; s2v += v[j][e] * v[j][e]; }
        const float rstd = 1.f / sqrtf(wave_sum(s2v) * (1.f / DM) + LN_EPS);
        float am = 0.f;
#pragma unroll
        for (int j = 0; j < 4; ++j) { const f32x4 g0 = ((const f32x4*)gam)[2 * F.lane + 128 * j], g1v = ((const f32x4*)gam)[2 * F.lane + 128 * j + 1], b0 = ((const f32x4*)bet)[2 * F.lane + 128 * j], b1 = ((const f32x4*)bet)[2 * F.lane + 128 * j + 1];
#pragma unroll
            for (int e = 0; e < 4; ++e) { v[j][e] = v[j][e] * rstd * g0[e] + b0[e]; v[j][4 + e] = v[j][4 + e] * rstd * g1v[e] + b1[e]; am = fmaxf(am, fmaxf(fabsf(v[j][e]), fabsf(v[j][4 + e]))); } }
        if (l + 1 < DEPTH) {
            am = wave_max(am); const float inv = am > 0.f ? 127.0f / am : 0.f;
            u32x2* q = (u32x2*)(H8 + (size_t)row * DM) + F.lane;
#pragma unroll
            for (int j = 0; j < 4; ++j) { hr[64 * j] = pack8f(v[j]); q[64 * j] = (u32x2){q8x4(v[j][0], v[j][1], v[j][2], v[j][3], inv), q8x4(v[j][4], v[j][5], v[j][6], v[j][7], inv)}; }
            if (F.lane == 0) SA[row] = am * (1.0f / 127.0f);
        } else {
            f32x4* o = (f32x4*)(F.out + (size_t)row * DM) + 2 * F.lane;
#pragma unroll
            for (int j = 0; j < 4; ++j) { o[128 * j] = (f32x4){v[j][0], v[j][1], v[j][2], v[j][3]}; o[128 * j + 1] = (f32x4){v[j][4], v[j][5], v[j][6], v[j][7]}; }
        }
    }
}

constexpr int N_PHASES = 2 + 8 * DEPTH;
#ifndef PHMASK
#define PHMASK 0x3ff
#endif
#ifndef DUPMASK
#define DUPMASK 0
#endif
__global__ void __launch_bounds__(NWAVES * 64, 2) mk_fwd(Args args) {
    extern __shared__ __attribute__((aligned(16))) unsigned char lds_raw[];
    Frame F;
    F.lds = (LAS unsigned char*)lds_raw; F.MISC = (volatile LAS unsigned*)(F.lds + MISC_OFF);
    F.tid = threadIdx.x; F.lane = F.tid & 63; F.wave = __builtin_amdgcn_readfirstlane(F.tid >> 6);
    F.G = gridDim.x; { const int bx = blockIdx.x; F.vcu = (F.G % 8 == 0) ? (bx % 8) * (F.G / 8) + bx / 8 : bx; }
    F.ws = args.ws; F.ctl = (unsigned*)(args.ws + WS_CTL); F.out = args.out;
    F.A = &args;
    for (int u = F.tid; u < (LDS_BYTES - LDSCTL_OFF) / 4; u += NWAVES * 64) ((LAS unsigned*)(F.lds + LDSCTL_OFF))[u] = 0u;
    __syncthreads();
    const int lo = args.ph_lo, hi = args.ph_hi;
    XcdBarrier bar; bar.bar = F.ctl + CW_BAR; bar.x = 0; bar.st = nullptr;
    if (hi - lo > 1) bar = xcd_barrier_post(F.ctl + CW_BAR, F.MISC + 8);
#define IN(k) (lo <= (k) && (k) < hi)
#define PH(s) ((PHMASK >> (s)) & 1)
#define REP(s) for (int rep_ = 0; rep_ < (((DUPMASK >> (s)) & 1) ? 2 : 1); ++rep_)
#define SEAM(k) do { if (IN(k) && IN((k) + 1)) xcd_barrier(bar); } while (0)
    if (PH(0) && IN(0)) { REP(0) p0_prologue(F); SEAM(0); }
    if (PH(0) && IN(1)) { REP(0) p1_quant(F); SEAM(1); }
    bf16_t* HB = (bf16_t*)(F.ws + WS_HB);
    bf16_t* QKV = (bf16_t*)(F.ws + WS_QKV); bf16_t* GATES = (bf16_t*)(F.ws + WS_GATES);
    bf16_t* OA = (bf16_t*)(F.ws + WS_OA); bf16_t* OB = (bf16_t*)(F.ws + WS_OB);
    for (int l = 0; l < DEPTH; ++l) {
        const int pb = 2 + 8 * l;
        const bf16_t* LW = (const bf16_t*)(F.ws + WS_W + (size_t)l * LW_BYTES);
        if (PH(1) && IN(pb + 0)) {
            pg8::Gemm g{(const bf16_t*)(F.ws + WS_H8), LW + LW_IN / 2, DM / 2}; pg8::StaticOrder S; S.init(MTOK, NIN, F.G, (int)blockIdx.x);
            pg8::EpiProj E{QKV, GATES, (const float*)(F.ws + WS_ROPE), (const float*)(F.ws + WS_SA), (const float*)(F.ws + WS_SB) + l * NIN};
            REP(1) pg8::gemm_phase<pg8::EpiProj, pg8::StaticOrder, true, false, true>(F.lds, g, S, E);
            SEAM(pb + 0);
        }
        if (PH(2) && IN(pb + 1)) {
            att::SbTensors TB{QKV + (size_t)3 * MTOK * WA, QKV + (size_t)3 * MTOK * WA + (size_t)MTOK * WB, QKV + (size_t)3 * MTOK * WA + (size_t)2 * MTOK * WB, OB};
            REP(2) for (int c = F.vcu; c < 256; c += F.G) { const int bh = c >> 2, pr = c & 3;
                att::sb_unit(TB, bh >> 3, bh & 7, 7 - pr, F.lds); att::sb_unit(TB, bh >> 3, bh & 7, pr, F.lds); }
            att::DaTensors TA{QKV, QKV + (size_t)MTOK * WA, QKV + (size_t)2 * MTOK * WA, (bf16_t*)(F.ws + WS_PO), (float*)(F.ws + WS_PL)};
            REP(3) for (int a = F.vcu; a < 128; a += F.G) att::da_unit(TA, OA, a >> 4, (a >> 2) & 3, a & 3, F.lds, (LAS float*)(F.lds + WSCR_OFF));
            SEAM(pb + 1);
        }
        if (PH(3) && IN(pb + 2)) {
            bf16_t* P1 = (bf16_t*)(F.ws + WS_P1); bf16_t* MRG = (bf16_t*)(F.ws + WS_MRG);
            pg8::StaticOrder S; S.init(MTOK, DM, F.G, (int)blockIdx.x);
            REP(4) {
            { pg8::Gemm g{OA, LW + LW_PA / 2, 512}; pg8::EpiGate<false> E{GATES, P1, MRG}; pg8::gemm_phase<pg8::EpiGate<false>, pg8::StaticOrder, true, false>(F.lds, g, S, E); }
            { pg8::Gemm g{OB, LW + LW_PB / 2, 1024}; pg8::EpiGate<true> E{GATES + (size_t)MTOK * DM, P1, MRG}; pg8::gemm_phase<pg8::EpiGate<true>, pg8::StaticOrder, true, false>(F.lds, g, S, E); }
            }
            SEAM(pb + 2);
        }
        if (PH(4) && IN(pb + 3)) {
            pg8::Gemm g{(const bf16_t*)(F.ws + WS_MRG), LW + LW_WO / 2, DM}; pg8::StaticOrder S; S.init(MTOK, DM, F.G, (int)blockIdx.x);
            pg8::EpiResid E{HB, (bf16_t*)(F.ws + WS_Z)};
            REP(5) pg8::gemm_phase<pg8::EpiResid, pg8::StaticOrder, true, false>(F.lds, g, S, E);
            SEAM(pb + 3);
        }
        if (PH(5) && IN(pb + 4)) { ln1_router(F, l); SEAM(pb + 4); }
        if (PH(6) && IN(pb + 5)) {
            moe_tables(F, l);
            const LAS int* LT = (const LAS int*)(F.lds + LT_OFF);
            pg8::MoeOrder S{4, F.G, F.vcu, LT[16] * 4, LT, LT + 32, (const int*)(F.ws + WS_LIST)};
            pg8::Gemm g{HB, LW + LW_UP / 2, DM}; pg8::EpiSwiglu E{(bf16_t*)(F.ws + WS_HID)};
            REP(6) pg8::gemm_phase<pg8::EpiSwiglu, pg8::MoeOrder, true, true>(F.lds, g, S, E);
            SEAM(pb + 5);
        }
        if (PH(7) && IN(pb + 6)) {
            moe_tables(F, l);
            const LAS int* LT = (const LAS int*)(F.lds + LT_OFF);
            pg8::MoeOrder S{8, F.G, F.vcu, LT[16] * 8, LT, LT + 32, (const int*)(F.ws + WS_LIST)};
            pg8::Gemm g{(const bf16_t*)(F.ws + WS_HID), LW + LW_DN / 2, FF}; pg8::EpiBf16 E{(bf16_t*)(F.ws + WS_YP), DM};
            REP(7) pg8::gemm_phase<pg8::EpiBf16, pg8::MoeOrder, true, false>(F.lds, g, S, E);
            SEAM(pb + 6);
        }
        if (PH(8) && IN(pb + 7)) { moe_tables(F, l); ln2_phase(F, l); SEAM(pb + 7); }
    }
#undef IN
#undef SEAM
}

extern "C" void kernel_launch(void* const* d_in, const int* in_sizes, int n_in, void* d_out, int out_size, void* d_ws, size_t ws_size, hipStream_t stream) {
    static int grid = 0;
    if (grid == 0) {
        if (n_in != 14 || in_sizes[0] != MTOK * DM || out_size != MTOK * DM || ws_size < WS_END) { fprintf(stderr, "kernel_launch: unexpected shapes (n_in %d, in0 %d, out %d, ws %zu)\n", n_in, n_in > 0 ? in_sizes[0] : -1, out_size, ws_size); grid = -1; return; }
        int dev = 0, cus = 0;
        if (hipGetDevice(&dev) != hipSuccess || hipDeviceGetAttribute(&cus, hipDeviceAttributeMultiprocessorCount, dev) != hipSuccess) { grid = -1; return; }
        if (hipFuncSetAttribute((const void*)mk_fwd, hipFuncAttributeMaxDynamicSharedMemorySize, LDS_BYTES) != hipSuccess) { fprintf(stderr, "kernel_launch: hipFuncSetAttribute failed\n"); grid = -1; return; }
        int per_cu = 0;
        if (hipOccupancyMaxActiveBlocksPerMultiprocessor(&per_cu, (const void*)mk_fwd, NWAVES * 64, LDS_BYTES) != hipSuccess || per_cu < 1) fprintf(stderr, "kernel_launch: occupancy query reports %d\n", per_cu);
        (void)hipGetLastError();
        if (cus < 256) { fprintf(stderr, "kernel_launch: needs 256 CUs, device has %d\n", cus); grid = -1; return; }
        grid = 256;
    }
    if (grid < 0) return;
    if (hipMemsetAsync((char*)d_ws + WS_CTL, 0, CTL_ZERO_BYTES, stream) != hipSuccess) return;
    Args a{};
    for (int i = 0; i < 14; ++i) a.in[i] = (const float*)d_in[i];
    a.out = (float*)d_out; a.ws = (unsigned char*)d_ws;
#if MK_ONE_LAUNCH
    a.ph_lo = 0; a.ph_hi = N_PHASES;
    hipLaunchKernelGGL(mk_fwd, dim3(grid), dim3(NWAVES * 64), LDS_BYTES, stream, a);
#else
    for (int p = 0; p < N_PHASES; ++p) { a.ph_lo = p; a.ph_hi = p + 1; hipLaunchKernelGGL(mk_fwd, dim3(grid), dim3(NWAVES * 64), LDS_BYTES, stream, a); }
#endif
}
```

```cpp
#include <hip/hip_runtime.h>
#include <cstdio>
#include <cstdint>

#define LAS __attribute__((address_space(3)))
#define GAS __attribute__((address_space(1)))
typedef unsigned short bf16_t;
typedef short bf16x8 __attribute__((ext_vector_type(8)));
typedef short s16x4 __attribute__((ext_vector_type(4)));
typedef float f32x4 __attribute__((ext_vector_type(4)));
typedef float f32x2 __attribute__((ext_vector_type(2)));
typedef float f32x16 __attribute__((ext_vector_type(16)));
typedef unsigned u32x4 __attribute__((ext_vector_type(4)));
typedef unsigned u32x2 __attribute__((ext_vector_type(2)));
typedef int i32x4 __attribute__((ext_vector_type(4)));

constexpr int BATCH = 8, SEQ = 2048, DM = 2048, DEPTH = 2, MTOK = BATCH * SEQ;
constexpr int HD = 128, WA = 1536, WB = 1024, NIN = 11776;
constexpr int NEXP = 16, FF = 512, ECAP = 16384;
constexpr float LN_EPS = 1e-5f;
constexpr float ALPHA = 1.4142135623730951f;
constexpr float LOG2E = 1.4426950408889634f;
constexpr float QK_C2 = 0.08838834764831845f * LOG2E;

__device__ __forceinline__ unsigned cvt_pk_bf16(float lo, float hi) { unsigned r; asm volatile("v_cvt_pk_bf16_f32 %0, %1, %2" : "=v"(r) : "v"(lo), "v"(hi)); return r; }
__device__ __forceinline__ float bf_lo(unsigned w) { return __uint_as_float(w << 16); }
__device__ __forceinline__ float bf_hi(unsigned w) { return __uint_as_float(w & 0xffff0000u); }
__device__ __forceinline__ float sigmoidf_fast(float x) { return __builtin_amdgcn_rcpf(1.0f + __builtin_amdgcn_exp2f(-x * LOG2E)); }

namespace pg8 {
constexpr int BM = 256, BK = 64, HALF = 128, HTB = HALF * BK * 2, STAGE_BYTES = 8 * HTB, NXCD = 8, WGM = 8;
__host__ __device__ __forceinline__ int lds_byte(int r, int c) { const int st = (r >> 4) * 2 + (c >> 5), rr = r & 15, cc = c & 31, ob = rr * 64 + cc * 2; return st * 1024 + (ob ^ (((ob >> 9) & 1) << 5)); }
__host__ __device__ __forceinline__ void stage_rc(int b, int& R, int& C) { const int st = b / 1024, sb = b % 1024, swz = sb ^ (((sb >> 9) & 1) << 5); R = (st >> 1) * 16 + swz / 64; C = (st & 1) * 32 + (swz % 64) / 2; }
__host__ __device__ __forceinline__ int perm32(int rho) { const int n = rho >> 4, i = rho & 15; return 8 * (i >> 2) + 4 * n + (i & 3); }

struct Unit { int pm, pn, pb, e, r0; };
struct Gemm { const bf16_t* A; const bf16_t* Bt; int K; };

struct StaticOrder {
    int nM, nN, nwg, G, c;
    __device__ void init(int M, int N, int G_, int c_) { nM = M / BM; nN = N / BM; nwg = nM * nN; G = G_; c = c_; }
    __device__ bool next(int i, Unit& u) const {
        const long L = (long)i * G + c; if (L >= nwg) return false;
        int wgid = (int)L; { const int q = nwg / NXCD, r = nwg % NXCD, xcd = wgid % NXCD, off = wgid / NXCD; wgid = (xcd < r ? xcd * (q + 1) : r * (q + 1) + (xcd - r) * q) + off; }
        const int nig = WGM * nN, gid = wgid / nig, fm = gid * WGM, gsz = (nM - fm) < WGM ? (nM - fm) : WGM;
        u.pm = fm + ((wgid % nig) % gsz); u.pn = (wgid % nig) / gsz; u.pb = u.pn; u.e = 0; u.r0 = 0; return true;
    }
    __device__ __forceinline__ int tok(const Unit&, int) const { return 0; }
};
struct MoeOrder {
    int nct, G, c, total; const LAS int* tb; const LAS int* cnt; const int* list;
    __device__ bool next(int i, Unit& u) const {
        const long L = (long)i * G + c; if (L >= total) return false;
        const int rt = (int)L / nct, ct = (int)L % nct; const int e = __builtin_amdgcn_readfirstlane(tb[64 + rt]);
        u.pm = rt; u.pn = ct; u.pb = e * nct + ct; u.e = e; u.r0 = (rt - __builtin_amdgcn_readfirstlane(tb[e])) * BM; return true;
    }
    __device__ __forceinline__ int tok(const Unit& u, int row) const { const int cn = cnt[u.e]; int pos = u.r0 + row; pos = pos < cn ? pos : cn - 1; return list[u.e * ECAP + pos]; }
};

template <class Epi, class Sched, bool ALIGN_EPI, bool GATHER, bool I8 = false>
__device__ __forceinline__ void gemm_phase(LAS unsigned char* lds, const Gemm g, const Sched& S, const Epi& E) {
    int tid = threadIdx.x; asm volatile("" : "+v"(tid));
    const int wid = __builtin_amdgcn_readfirstlane(tid >> 6), lane = tid & 63, wr = wid >> 2, wc = wid & 3, fr = lane & 15, fq = lane >> 4;
    const int K = g.K, nt = K / BK;
    const size_t kstep = (size_t)(BK * 2);
    const size_t hstep = (size_t)HALF * K * 2;
    const size_t tstep = 2 * hstep;
    int RA[2], CA[2]; unsigned voffB[2];
#pragma unroll
    for (int i = 0; i < 2; ++i) { int R, C; stage_rc(tid * 16 + i * 8192, R, C); const int Rb = Epi::PERM ? ((R & ~31) + perm32(R & 31)) : R; RA[i] = R; CA[i] = C; voffB[i] = (unsigned)(Rb * K + C) * 2u; }
    const unsigned ldsw = (unsigned)wid * 1024u;
    const int aoff = lds_byte(wr * 64 + fr, fq * 8), boff = lds_byte(wc * 32 + fr, fq * 8);
#define PG8_SA(b, h) (((b) * 2 + (h)) * HTB)
#define PG8_SB(b, h) ((4 + (b) * 2 + (h)) * HTB)
#define PG8_STAGE(bufoff, gbase, v0, v1) do { \
        __builtin_amdgcn_global_load_lds((const unsigned*)((const char*)(gbase) + (v0)), (LAS unsigned*)(lds + (bufoff) + ldsw), 16, 0, 0); \
        __builtin_amdgcn_global_load_lds((const unsigned*)((const char*)(gbase) + (v1)), (LAS unsigned*)(lds + (bufoff) + ldsw + 8192), 16, 0, 0); } while (0)
#define PG8_LDA(dst, b, h) do { _Pragma("unroll") for (int m = 0; m < 4; ++m) _Pragma("unroll") for (int k = 0; k < 2; ++k) dst[m][k] = *(const LAS bf16x8*)(lds + PG8_SA(b, h) + aoff + m * 2048 + k * 1024); } while (0)
#define PG8_LDB(dst, b, h) do { _Pragma("unroll") for (int n = 0; n < 2; ++n) _Pragma("unroll") for (int k = 0; k < 2; ++k) dst[n][k] = *(const LAS bf16x8*)(lds + PG8_SB(b, h) + boff + n * 2048 + k * 1024); } while (0)
#define PG8_MMA(ai, bj, At, Bt) do { __builtin_amdgcn_s_setprio(1); _Pragma("unroll") for (int m = 0; m < 4; ++m) _Pragma("unroll") for (int n = 0; n < 2; ++n) _Pragma("unroll") for (int k = 0; k < 2; ++k) { \
        if constexpr (I8) acc[ai][bj][m][n] = __builtin_bit_cast(AccT, __builtin_amdgcn_mfma_i32_16x16x64_i8(__builtin_bit_cast(i32x4, Bt[n][k]), __builtin_bit_cast(i32x4, At[m][k]), __builtin_bit_cast(i32x4, acc[ai][bj][m][n]), 0, 0, 0)); \
        else acc[ai][bj][m][n] = __builtin_bit_cast(AccT, __builtin_amdgcn_mfma_f32_16x16x32_bf16(Bt[n][k], At[m][k], __builtin_bit_cast(f32x4, acc[ai][bj][m][n]), 0, 0, 0)); } __builtin_amdgcn_s_setprio(0); } while (0)
#define PG8_WAIT_V(n) asm volatile("s_waitcnt vmcnt(" #n ")" ::: "memory")
#define PG8_WAIT_L(n) asm volatile("s_waitcnt lgkmcnt(" #n ")" ::: "memory")
#define PG8_BAR __builtin_amdgcn_s_barrier()
#define PG8_SCHED __builtin_amdgcn_sched_barrier(0)
    Unit cur, nxt; int ui = 0;
    if (!S.next(0, cur)) return;
    typedef typename Epi::AccT AccT;
    AccT acc[2][2][4][2];
#pragma unroll
    for (int a = 0; a < 2; ++a)
#pragma unroll
        for (int b = 0; b < 2; ++b)
#pragma unroll
            for (int m = 0; m < 4; ++m)
#pragma unroll
                for (int n = 0; n < 2; ++n) acc[a][b][m][n] = AccT{};
    bf16x8 At[4][2], B0[2][2], B1[2][2];
    unsigned c00, c01, c10, c11, n00, n01, n10, n11;
    if constexpr (GATHER) {
        c00 = (unsigned)(S.tok(cur, RA[0]) * K + CA[0]) * 2u; c01 = (unsigned)(S.tok(cur, RA[1]) * K + CA[1]) * 2u;
        c10 = (unsigned)(S.tok(cur, HALF + RA[0]) * K + CA[0]) * 2u; c11 = (unsigned)(S.tok(cur, HALF + RA[1]) * K + CA[1]) * 2u;
    } else {
        c00 = (unsigned)(RA[0] * K + CA[0]) * 2u; c01 = (unsigned)(RA[1] * K + CA[1]) * 2u; c10 = c00 + (unsigned)hstep; c11 = c01 + (unsigned)hstep;
    }
    n00 = c00; n01 = c01; n10 = c10; n11 = c11;
    const char* cA = GATHER ? (const char*)g.A : (const char*)g.A + (size_t)cur.pm * tstep; const char* cB = (const char*)g.Bt + (size_t)cur.pb * tstep;
    PG8_STAGE(PG8_SB(0, 0), cB, voffB[0], voffB[1]); PG8_STAGE(PG8_SB(0, 1), cB + hstep, voffB[0], voffB[1]); PG8_STAGE(PG8_SA(0, 0), cA, c00, c01); PG8_STAGE(PG8_SA(0, 1), cA, c10, c11);
    if (wr == 1) PG8_BAR;
    PG8_WAIT_V(2); PG8_BAR;
    PG8_STAGE(PG8_SB(1, 0), cB + kstep, voffB[0], voffB[1]); PG8_STAGE(PG8_SA(1, 0), cA + kstep, c00, c01); PG8_STAGE(PG8_SB(1, 1), cB + hstep + kstep, voffB[0], voffB[1]);
    PG8_WAIT_V(6); PG8_BAR;
    for (;;) {
        const bool has_next = S.next(ui + 1, nxt);
        const char* nA = has_next ? (GATHER ? (const char*)g.A : (const char*)g.A + (size_t)nxt.pm * tstep) : cA; const char* nB = has_next ? (const char*)g.Bt + (size_t)nxt.pb * tstep : cB;
        if constexpr (GATHER) {
            if (has_next) {
                n00 = (unsigned)(S.tok(nxt, RA[0]) * K + CA[0]) * 2u; n01 = (unsigned)(S.tok(nxt, RA[1]) * K + CA[1]) * 2u;
                n10 = (unsigned)(S.tok(nxt, HALF + RA[0]) * K + CA[0]) * 2u; n11 = (unsigned)(S.tok(nxt, HALF + RA[1]) * K + CA[1]) * 2u;
            } else { n00 = c00; n01 = c01; n10 = c10; n11 = c11; }
        }
        for (int t = 0; t < nt; t += 2) {
            const bool last = (t == nt - 2);
            const char* a1 = cA + (size_t)(t + 1) * kstep;
            const char* a2 = last ? nA : cA + (size_t)(t + 2) * kstep; const char* b2 = last ? nB : cB + (size_t)(t + 2) * kstep;
            const char* a3 = a2 + kstep; const char* b3 = b2 + kstep;
            const unsigned o00 = last ? n00 : c00, o01 = last ? n01 : c01, o10 = last ? n10 : c10, o11 = last ? n11 : c11;
            PG8_LDB(B0, 0, 0); PG8_LDB(B1, 0, 1); PG8_SCHED; PG8_LDA(At, 0, 0); PG8_STAGE(PG8_SA(1, 1), a1, c10, c11);
            PG8_WAIT_V(8); PG8_WAIT_L(0); PG8_BAR; PG8_MMA(0, 0, At, B0); PG8_MMA(0, 1, At, B1); PG8_BAR; PG8_SCHED;
            PG8_LDA(At, 0, 1); PG8_STAGE(PG8_SB(0, 0), b2, voffB[0], voffB[1]); PG8_STAGE(PG8_SB(0, 1), b2 + hstep, voffB[0], voffB[1]); PG8_STAGE(PG8_SA(0, 0), a2, o00, o01);
            PG8_WAIT_V(8); PG8_WAIT_L(0); PG8_BAR; PG8_MMA(1, 0, At, B0); PG8_MMA(1, 1, At, B1); PG8_BAR; PG8_SCHED;
            PG8_LDB(B0, 1, 0); PG8_LDB(B1, 1, 1); PG8_SCHED; PG8_LDA(At, 1, 0); PG8_STAGE(PG8_SA(0, 1), a2, o10, o11);
            PG8_WAIT_V(8); PG8_WAIT_L(0); PG8_BAR; PG8_MMA(0, 0, At, B0); PG8_MMA(0, 1, At, B1); PG8_BAR; PG8_SCHED;
            PG8_LDA(At, 1, 1); PG8_STAGE(PG8_SB(1, 0), b3, voffB[0], voffB[1]); PG8_STAGE(PG8_SB(1, 1), b3 + hstep, voffB[0], voffB[1]); PG8_STAGE(PG8_SA(1, 0), a3, o00, o01);
            PG8_WAIT_V(8); PG8_WAIT_L(0); PG8_BAR; PG8_MMA(1, 0, At, B0); PG8_MMA(1, 1, At, B1); PG8_BAR; PG8_SCHED;
        }
        if constexpr (ALIGN_EPI) { if (wr == 0) PG8_BAR; }
        E(acc, cur, wr, wc, fr, fq);
        if (!has_next) break;
#pragma unroll
        for (int a = 0; a < 2; ++a)
#pragma unroll
            for (int b = 0; b < 2; ++b)
#pragma unroll
                for (int m = 0; m < 4; ++m)
#pragma unroll
                    for (int n = 0; n < 2; ++n) acc[a][b][m][n] = AccT{};
        cur = nxt; cA = nA; cB = nB; ++ui; c00 = n00; c01 = n01; c10 = n10; c11 = n11;
        if constexpr (ALIGN_EPI) { if (wr == 1) PG8_BAR; }
    }
    PG8_WAIT_V(0);
    if constexpr (!ALIGN_EPI) { if (wr == 0) PG8_BAR; }
    PG8_BAR;
#undef PG8_SA
#undef PG8_SB
#undef PG8_STAGE
#undef PG8_LDA
#undef PG8_LDB
#undef PG8_MMA
#undef PG8_WAIT_V
#undef PG8_WAIT_L
#undef PG8_BAR
#undef PG8_SCHED
}
}
namespace pg8 {
struct EpiProj {
    static constexpr bool PERM = true; typedef i32x4 AccT;
    bf16_t* qkv;
    bf16_t* gates;
    const float* rope;
    const float* sa;
    const float* sb;
    __device__ __forceinline__ void operator()(const i32x4 (&acc)[2][2][4][2], const Unit& u, int wr, int wc, int fr, int fq) const {
        const int pn = u.pn; bf16_t* base; int ldc, ct0;
        if (pn < 18) { const int t = pn / 6; base = qkv + (size_t)t * MTOK * WA; ldc = WA; ct0 = t * 6; }
        else if (pn < 30) { const int t = (pn - 18) / 4; base = qkv + (size_t)3 * MTOK * WA + (size_t)t * MTOK * WB; ldc = WB; ct0 = 18 + t * 4; }
        else { const int t = (pn - 30) / 8; base = gates + (size_t)t * MTOK * DM; ldc = DM; ct0 = 30 + t * 8; }
        const int row0 = u.pm * BM + wr * 64 + fr, col0 = (pn - ct0) * BM + wc * 32 + 8 * fq, bcol0 = pn * BM + wc * 32 + 8 * fq;
        const bool do_rope = (pn < 12) && (wc == 0);
        f32x4 sbv[2][2];
#pragma unroll
        for (int bj = 0; bj < 2; ++bj)
#pragma unroll
            for (int n = 0; n < 2; ++n) sbv[bj][n] = *(const f32x4*)(sb + bcol0 + bj * HALF + 4 * n);
#pragma unroll
        for (int ai = 0; ai < 2; ++ai)
#pragma unroll
            for (int m = 0; m < 4; ++m) { const int row = row0 + ai * HALF + m * 16; bf16_t* rowp = base + (size_t)row * ldc + col0;
                const float sar = sa[row];
                f32x4 cs = (f32x4){1.f, 1.f, 1.f, 1.f}, sn = (f32x4){0.f, 0.f, 0.f, 0.f};
                if (do_rope) { cs = *(const f32x4*)(rope + (size_t)row * 32 + 4 * fq); sn = *(const f32x4*)(rope + (size_t)row * 32 + 16 + 4 * fq); }
#pragma unroll
                for (int bj = 0; bj < 2; ++bj) { f32x4 v0 = __builtin_convertvector(acc[ai][bj][m][0], f32x4) * (sbv[bj][0] * sar), v1 = __builtin_convertvector(acc[ai][bj][m][1], f32x4) * (sbv[bj][1] * sar);
                    if (do_rope) { const f32x4 y0 = v0 * cs - v1 * sn, y1 = v1 * cs + v0 * sn; v0 = y0; v1 = y1; }
                    u32x4 w; w.x = cvt_pk_bf16(v0[0], v0[1]); w.y = cvt_pk_bf16(v0[2], v0[3]); w.z = cvt_pk_bf16(v1[0], v1[1]); w.w = cvt_pk_bf16(v1[2], v1[3]);
                    *(u32x4*)(rowp + bj * HALF) = w; }
                asm volatile("" ::: "memory"); }
    }
};
struct EpiBf16 {
    static constexpr bool PERM = true; typedef f32x4 AccT;
    bf16_t* O; int ldc;
    __device__ __forceinline__ void operator()(const f32x4 (&acc)[2][2][4][2], const Unit& u, int wr, int wc, int fr, int fq) const {
        const int row0 = u.pm * BM + wr * 64 + fr, col0 = u.pn * BM + wc * 32 + 8 * fq;
#pragma unroll
        for (int ai = 0; ai < 2; ++ai)
#pragma unroll
            for (int m = 0; m < 4; ++m) { bf16_t* rowp = O + (size_t)(row0 + ai * HALF + m * 16) * ldc + col0;
#pragma unroll
                for (int bj = 0; bj < 2; ++bj) { const f32x4 v0 = acc[ai][bj][m][0], v1 = acc[ai][bj][m][1];
                    u32x4 w; w.x = cvt_pk_bf16(v0[0], v0[1]); w.y = cvt_pk_bf16(v0[2], v0[3]); w.z = cvt_pk_bf16(v1[0], v1[1]); w.w = cvt_pk_bf16(v1[2], v1[3]);
                    *(u32x4*)(rowp + bj * HALF) = w; } }
    }
};
template <bool SECOND> struct EpiGate {
    static constexpr bool PERM = true; typedef f32x4 AccT;
    const bf16_t* gate; bf16_t* P1; bf16_t* out;
    __device__ __forceinline__ void operator()(const f32x4 (&acc)[2][2][4][2], const Unit& u, int wr, int wc, int fr, int fq) const {
        const int row0 = u.pm * BM + wr * 64 + fr, col0 = u.pn * BM + wc * 32 + 8 * fq;
#pragma unroll
        for (int ai = 0; ai < 2; ++ai)
#pragma unroll
            for (int m = 0; m < 4; ++m) { const size_t off = (size_t)(row0 + ai * HALF + m * 16) * DM + col0;
#pragma unroll
                for (int bj = 0; bj < 2; ++bj) { const f32x4 v0 = acc[ai][bj][m][0], v1 = acc[ai][bj][m][1];
                    const u32x4 gw = *(const u32x4*)(gate + off + bj * HALF);
                    float r[8];
                    r[0] = sigmoidf_fast(bf_lo(gw.x)) * v0[0]; r[1] = sigmoidf_fast(bf_hi(gw.x)) * v0[1]; r[2] = sigmoidf_fast(bf_lo(gw.y)) * v0[2]; r[3] = sigmoidf_fast(bf_hi(gw.y)) * v0[3];
                    r[4] = sigmoidf_fast(bf_lo(gw.z)) * v1[0]; r[5] = sigmoidf_fast(bf_hi(gw.z)) * v1[1]; r[6] = sigmoidf_fast(bf_lo(gw.w)) * v1[2]; r[7] = sigmoidf_fast(bf_hi(gw.w)) * v1[3];
                    if (SECOND) { const u32x4 pw = *(const u32x4*)(P1 + off + bj * HALF);
                        r[0] += bf_lo(pw.x); r[1] += bf_hi(pw.x); r[2] += bf_lo(pw.y); r[3] += bf_hi(pw.y); r[4] += bf_lo(pw.z); r[5] += bf_hi(pw.z); r[6] += bf_lo(pw.w); r[7] += bf_hi(pw.w); }
                    u32x4 w; w.x = cvt_pk_bf16(r[0], r[1]); w.y = cvt_pk_bf16(r[2], r[3]); w.z = cvt_pk_bf16(r[4], r[5]); w.w = cvt_pk_bf16(r[6], r[7]);
                    *(u32x4*)((SECOND ? out : P1) + off + bj * HALF) = w; }
                asm volatile("" ::: "memory"); }
    }
};
struct EpiResid {
    static constexpr bool PERM = true; typedef f32x4 AccT;
    const bf16_t* h; bf16_t* z;
    __device__ __forceinline__ void operator()(const f32x4 (&acc)[2][2][4][2], const Unit& u, int wr, int wc, int fr, int fq) const {
        const int row0 = u.pm * BM + wr * 64 + fr, col0 = u.pn * BM + wc * 32 + 8 * fq;
#pragma unroll
        for (int ai = 0; ai < 2; ++ai)
#pragma unroll
            for (int m = 0; m < 4; ++m) { const size_t off = (size_t)(row0 + ai * HALF + m * 16) * DM + col0;
#pragma unroll
                for (int bj = 0; bj < 2; ++bj) { const f32x4 v0 = acc[ai][bj][m][0], v1 = acc[ai][bj][m][1];
                    const u32x4 hw = *(const u32x4*)(h + off + bj * HALF);
                    u32x4 w; w.x = cvt_pk_bf16(ALPHA * bf_lo(hw.x) + v0[0], ALPHA * bf_hi(hw.x) + v0[1]); w.y = cvt_pk_bf16(ALPHA * bf_lo(hw.y) + v0[2], ALPHA * bf_hi(hw.y) + v0[3]);
                    w.z = cvt_pk_bf16(ALPHA * bf_lo(hw.z) + v1[0], ALPHA * bf_hi(hw.z) + v1[1]); w.w = cvt_pk_bf16(ALPHA * bf_lo(hw.w) + v1[2], ALPHA * bf_hi(hw.w) + v1[3]);
                    *(u32x4*)(z + off + bj * HALF) = w; }
                asm volatile("" ::: "memory"); }
    }
};
struct EpiSwiglu {
    static constexpr bool PERM = true; typedef f32x4 AccT;
    bf16_t* Hd;
    __device__ __forceinline__ void operator()(const f32x4 (&acc)[2][2][4][2], const Unit& u, int wr, int wc, int fr, int fq) const {
        const int row0 = u.pm * BM + wr * 64 + fr, col0 = u.pn * HALF + wc * 32 + 8 * fq;
#pragma unroll
        for (int ai = 0; ai < 2; ++ai)
#pragma unroll
            for (int m = 0; m < 4; ++m) { bf16_t* rowp = Hd + (size_t)(row0 + ai * HALF + m * 16) * FF + col0;
                float r[8];
#pragma unroll
                for (int n = 0; n < 2; ++n)
#pragma unroll
                    for (int j = 0; j < 4; ++j) { const float a = acc[ai][0][m][n][j], b = acc[ai][1][m][n][j]; r[4 * n + j] = a * sigmoidf_fast(a) * b; }
                u32x4 w; w.x = cvt_pk_bf16(r[0], r[1]); w.y = cvt_pk_bf16(r[2], r[3]); w.z = cvt_pk_bf16(r[4], r[5]); w.w = cvt_pk_bf16(r[6], r[7]);
                *(u32x4*)rowp = w; }
    }
};
}
namespace att {
#define SBAR() __builtin_amdgcn_sched_barrier(0)
#define KSWZ(row, colB) ((row) * 256 + ((colB) ^ (((row) & 7) << 4)))
__device__ __forceinline__ int v_st(int k, int c) { const int kk = (k & ~0xC) | ((k & 4) << 1) | ((k & 8) >> 1); return ((kk >> 3) * 4 + (c >> 5)) * 512 + ((kk & 7) * 32 + (c & 31)) * 2; }
__device__ __forceinline__ int v_rd_base(int lane) { return ((lane & 3) << 3) | (((lane >> 2) & 3) << 6) | (((lane >> 4) & 1) << 5) | (((lane >> 5) & 1) << 8); }
__device__ __forceinline__ int crow(int r, int hi) { return (r & 3) + 8 * (r >> 2) + 4 * hi; }
__device__ __forceinline__ float partner_f(float x, int hi) { auto rr = __builtin_amdgcn_permlane32_swap(__float_as_uint(x), __float_as_uint(x), false, false); return __uint_as_float(hi ? rr[0] : rr[1]); }
#define PK4(P, B_, OUT) do { unsigned a0 = cvt_pk_bf16(P[B_+0], P[B_+1]), a1 = cvt_pk_bf16(P[B_+2], P[B_+3]);                          \
        unsigned b0 = cvt_pk_bf16(P[B_+4], P[B_+5]), b1 = cvt_pk_bf16(P[B_+6], P[B_+7]);                                             \
        auto r0 = __builtin_amdgcn_permlane32_swap(a0, b0, false, false); auto r1 = __builtin_amdgcn_permlane32_swap(a1, b1, false, false); \
        u32x4 w = {r0[0], r1[0], r0[1], r1[1]}; OUT = *reinterpret_cast<bf16x8*>(&w); } while (0)
#define TRRD(dst, addr, off) asm volatile("ds_read_b64_tr_b16 %0, %1 offset:%2" : "=&v"(dst) : "v"(addr), "i"(off) : "memory")

__device__ __forceinline__ void qkt32(f32x16& p, unsigned kaddr, int r32, int hi, const bf16x8* qr) {
    p = f32x16{};
    unsigned kb[4];
#pragma unroll
    for (int dd = 0; dd < 4; ++dd) kb[dd] = kaddr + KSWZ(r32, (dd * 16 + hi * 8) * 2);
#pragma unroll
    for (int d0 = 0; d0 < 8; ++d0) { const bf16x8 b0 = *(const LAS bf16x8*)(uintptr_t)(kb[d0 & 3] + (d0 >> 2) * 128);
        p = __builtin_amdgcn_mfma_f32_32x32x16_bf16(b0, qr[d0], p, 0, 0, 0); }
}
__device__ __forceinline__ void pv32(f32x16* o, unsigned vaddr, bf16x8 pa0, bf16x8 pa1) {
#define PV_D2(d0) do { s16x4 l0, l1, h0, h1, m0, m1, n0, n1; constexpr int b_ = (d0) * 512; \
        TRRD(l0, vaddr, b_); TRRD(h0, vaddr, b_ + 2048); TRRD(l1, vaddr, b_ + 4096); TRRD(h1, vaddr, b_ + 6144); \
        TRRD(m0, vaddr, b_ + 512); TRRD(n0, vaddr, b_ + 512 + 2048); TRRD(m1, vaddr, b_ + 512 + 4096); TRRD(n1, vaddr, b_ + 512 + 6144); \
        asm volatile("s_waitcnt lgkmcnt(0)" ::: "memory"); SBAR(); \
        o[d0] = __builtin_amdgcn_mfma_f32_32x32x16_bf16(pa0, (bf16x8){l0[0], l0[1], l0[2], l0[3], h0[0], h0[1], h0[2], h0[3]}, o[d0], 0, 0, 0); \
        o[d0 + 1] = __builtin_amdgcn_mfma_f32_32x32x16_bf16(pa0, (bf16x8){m0[0], m0[1], m0[2], m0[3], n0[0], n0[1], n0[2], n0[3]}, o[d0 + 1], 0, 0, 0); \
        o[d0] = __builtin_amdgcn_mfma_f32_32x32x16_bf16(pa1, (bf16x8){l1[0], l1[1], l1[2], l1[3], h1[0], h1[1], h1[2], h1[3]}, o[d0], 0, 0, 0); \
        o[d0 + 1] = __builtin_amdgcn_mfma_f32_32x32x16_bf16(pa1, (bf16x8){m1[0], m1[1], m1[2], m1[3], n1[0], n1[1], n1[2], n1[3]}, o[d0 + 1], 0, 0, 0); } while (0)
    PV_D2(0); PV_D2(2);
#undef PV_D2
}
template <class RowPtr>
__device__ __forceinline__ void store_o_bf16(const f32x16* o, const float* rscale, int r32, int hi, const RowPtr& rowp) {
#pragma unroll
    for (int r = 0; r < 16; ++r) { bf16_t* rp = rowp(crow(r, hi));
#pragma unroll
        for (int d0 = 0; d0 < 4; ++d0) { const float v = o[d0][r] * rscale[r]; const float vn = __shfl_xor(v, 1);
            if ((r32 & 1) == 0) *(unsigned*)(rp + d0 * 32 + r32) = cvt_pk_bf16(v, vn); } }
}

template <bool MASK>
__device__ __forceinline__ void sb_half(f32x16& p, float& C, int dq, int hi) {
    float om[16];
#pragma unroll
    for (int r = 0; r < 16; ++r) {
        const float e = __builtin_amdgcn_exp2f(p[r] * -QK_C2); float b = __builtin_amdgcn_rcpf(1.0f + e); float o = 1.0f - b;
        if (MASK) { const bool v = ((r & 3) + 8 * (r >> 2)) < dq; b = v ? b : 0.f; o = v ? o : 1.f; }
        p[r] = b; om[r] = o; }
    float g[4], pg[4], eh[4];
#pragma unroll
    for (int c = 0; c < 4; ++c) { g[c] = (om[4 * c] * om[4 * c + 1]) * (om[4 * c + 2] * om[4 * c + 3]); pg[c] = partner_f(g[c], hi); }
    eh[3] = C; eh[2] = eh[3] * (g[3] * pg[3]); eh[1] = eh[2] * (g[2] * pg[2]); eh[0] = eh[1] * (g[1] * pg[1]); C = eh[0] * (g[0] * pg[0]);
#pragma unroll
    for (int c = 3; c >= 0; --c) { float E = hi ? eh[c] : eh[c] * pg[c];
#pragma unroll
        for (int r = 4 * c + 3; r >= 4 * c; --r) { p[r] *= E; E *= om[r]; } }
}

struct SbTensors { const bf16_t* Q; const bf16_t* K; const bf16_t* V; bf16_t* O; };
__device__ __forceinline__ void sb_unit(const SbTensors& T, int b, int head, int qb, LAS unsigned char* lds) {
    int tid = threadIdx.x; asm volatile("" : "+v"(tid));
    const int wid = __builtin_amdgcn_readfirstlane(tid >> 6), lane = tid & 63, r32 = lane & 31, hi = lane >> 5;
    const size_t rowbase = (size_t)b * SEQ;
    const int q0 = qb * 256 + wid * 32;
    const int tq = q0 + r32;
    bf16x8 qr[8];
    { const bf16_t* qp = T.Q + (rowbase + tq) * WB + head * HD + hi * 8;
#pragma unroll
      for (int d0 = 0; d0 < 8; ++d0) qr[d0] = *(const bf16x8*)(qp + d0 * 16); }
    const bf16_t* Kh = T.K + rowbase * WB + head * HD; const bf16_t* Vh = T.V + rowbase * WB + head * HD;
    const int sr = tid >> 4, sc = (tid & 15) * 8;
    const int kws = KSWZ(sr, sc * 2), vst0 = v_st(sr, sc), vst1 = v_st(32 + sr, sc);
    const unsigned Kl = (unsigned)(uintptr_t)lds, Vl = Kl + 32768u, vrb = (unsigned)v_rd_base(lane);
    f32x16 o[4] = {}; float C = 1.0f;
    const int NT = 4 * qb + 4;
    bf16x8 sk0, sk1, sv0, sv1;
#define SB_LOAD(jt) do { const bf16_t* kp = Kh + (size_t)((jt) * 64 + sr) * WB + sc; const bf16_t* vp = Vh + (size_t)((jt) * 64 + sr) * WB + sc; \
        sk0 = *(const bf16x8*)kp; sk1 = *(const bf16x8*)(kp + 32 * WB); sv0 = *(const bf16x8*)vp; sv1 = *(const bf16x8*)(vp + 32 * WB); } while (0)
#define SB_WRITE(bf) do { *(LAS bf16x8*)(lds + (bf) * 16384 + kws) = sk0; *(LAS bf16x8*)(lds + (bf) * 16384 + kws + 32 * 256) = sk1; \
        *(LAS bf16x8*)(lds + 32768 + (bf) * 16384 + vst0) = sv0; *(LAS bf16x8*)(lds + 32768 + (bf) * 16384 + vst1) = sv1; } while (0)
    SB_LOAD(NT - 1); SB_WRITE(0);
    __syncthreads();
    for (int it = 0; it < NT; ++it) {
        const int jt = NT - 1 - it, bf = it & 1, kb = jt * 64;
        if (it + 1 < NT) SB_LOAD(jt - 1);
        if (kb <= q0 + 30) {
            const unsigned ka = Kl + bf * 16384u, va = Vl + bf * 16384u + vrb;
            f32x16 p0, p1; bf16x8 pa0, pa1, pa2, pa3;
            qkt32(p0, ka, r32, hi, qr); qkt32(p1, ka + 32 * 256, r32, hi, qr);
            if (kb + 63 >= q0) { sb_half<true>(p1, C, tq - kb - 32 - 4 * hi, hi); sb_half<true>(p0, C, tq - kb - 4 * hi, hi); }
            else { sb_half<false>(p1, C, 0, hi); sb_half<false>(p0, C, 0, hi); }
            PK4(p0, 0, pa0); PK4(p0, 8, pa1); PK4(p1, 0, pa2); PK4(p1, 8, pa3);
            pv32(o, va, pa0, pa1); pv32(o, va + 8192, pa2, pa3);
        }
        if (it + 1 < NT) SB_WRITE(bf ^ 1);
        __syncthreads();
    }
#undef SB_LOAD
#undef SB_WRITE
    float ones[16];
#pragma unroll
    for (int r = 0; r < 16; ++r) ones[r] = 1.0f;
    bf16_t* Ob = T.O + (rowbase + q0) * WB + head * HD;
    store_o_bf16(o, ones, r32, hi, [&](int row) { return Ob + (size_t)row * WB; });
}

struct DaTensors { const bf16_t* Q; const bf16_t* K; const bf16_t* V; bf16_t* PO; float* PL; };
__device__ __forceinline__ void da_job(const DaTensors& T, int b, int h, int g, int rho, int u0, LAS unsigned char* wl, LAS float* ws) {
    int lane = threadIdx.x & 63; asm volatile("" : "+v"(lane));
    const int r32 = lane & 31, hi = lane >> 5;
    const int dsh = 2 * g, dil = 1 << dsh;
    const size_t rowbase = (size_t)b * SEQ; const int colh = g * 512 + h * HD;
    bf16x8 qr[8];
    { const bf16_t* qp = T.Q + (rowbase + (size_t)(((u0 + r32) << dsh) + rho)) * WA + colh + hi * 8;
#pragma unroll
      for (int d0 = 0; d0 < 8; ++d0) qr[d0] = *(const bf16x8*)(qp + d0 * 16); }
    const unsigned Kl = (unsigned)(uintptr_t)wl, Vl = Kl + 8192u + (unsigned)v_rd_base(lane);
    LAS float* al_l = ws; LAS float* li_l = ws + 32;
    f32x16 o[4] = {}; float m_reg = -1e30f, l_reg = 0.f;
    const int srow = lane >> 4, sc = (lane & 15) * 8;
    int tau0 = (128 - u0 + 31) >> 5; if (tau0 < 0) tau0 = 0;
    bf16x8 kk[8], vv[8];
#define DA_LOAD(tau_) do { const int ub_ = u0 - 128 + 32 * (tau_); _Pragma("unroll") for (int c = 0; c < 8; ++c) { const int ki = srow + 4 * c; \
        const size_t ro = (rowbase + (size_t)(((ub_ + ki) << dsh) + rho)) * WA + colh + sc; kk[c] = *(const bf16x8*)(T.K + ro); vv[c] = *(const bf16x8*)(T.V + ro); } } while (0)
    DA_LOAD(tau0);
    for (int tau = tau0; tau < 5; ++tau) {
        const int ub = u0 - 128 + 32 * tau;
#pragma unroll
        for (int c = 0; c < 8; ++c) { const int ki = srow + 4 * c; *(LAS bf16x8*)(wl + KSWZ(ki, sc * 2)) = kk[c]; *(LAS bf16x8*)(wl + 8192 + v_st(ki, sc)) = vv[c]; }
        if (tau + 1 < 5) DA_LOAD(tau + 1);
        asm volatile("s_waitcnt lgkmcnt(0)" ::: "memory"); SBAR();
        f32x16 p; qkt32(p, Kl, r32, hi, qr);
        if (tau == 0 || tau == 4) { const int dq = u0 + r32 - ub - 4 * hi; const float NEG = -__builtin_inff();
#pragma unroll
            for (int r = 0; r < 16; ++r) { const int c = (r & 3) + 8 * (r >> 2); if ((unsigned)(dq - c) >= 129u) p[r] = NEG; } }
        float pmax = p[0];
#pragma unroll
        for (int r = 1; r < 16; ++r) pmax = fmaxf(pmax, p[r]);
        pmax = fmaxf(pmax, partner_f(pmax, hi));
        float alpha = 1.f;
        if (!__all((pmax - m_reg) * QK_C2 <= 8.0f * LOG2E)) {
            const float mn = fmaxf(m_reg, pmax); alpha = __builtin_amdgcn_exp2f((m_reg - mn) * QK_C2); m_reg = mn;
            if (hi == 0) al_l[r32] = alpha; asm volatile("s_waitcnt lgkmcnt(0)" ::: "memory");
#pragma unroll
            for (int r = 0; r < 16; ++r) { const float a = al_l[crow(r, hi)];
#pragma unroll
                for (int d0 = 0; d0 < 4; ++d0) o[d0][r] *= a; }
        }
        const float mnL = -m_reg * QK_C2; float ps = 0.f;
#pragma unroll
        for (int r = 0; r < 16; ++r) { p[r] = __builtin_amdgcn_exp2f(fmaf(p[r], QK_C2, mnL)); ps += p[r]; }
        ps += partner_f(ps, hi);
        l_reg = l_reg * alpha + ps;
        bf16x8 pa0, pa1; PK4(p, 0, pa0); PK4(p, 8, pa1);
        pv32(o, Vl, pa0, pa1);
    }
#undef DA_LOAD
    if (hi == 0) li_l[r32] = l_reg; asm volatile("s_waitcnt lgkmcnt(0)" ::: "memory");
    float rli[16];
#pragma unroll
    for (int r = 0; r < 16; ++r) rli[r] = __builtin_amdgcn_rcpf(li_l[crow(r, hi)]);
    bf16_t* Pg = T.PO + (size_t)g * MTOK * 512 + h * HD;
    store_o_bf16(o, rli, r32, hi, [&](int row) { return Pg + (rowbase + (size_t)(((u0 + row) << dsh) + rho)) * 512; });
    if (hi == 0) T.PL[((size_t)g * MTOK + rowbase + (size_t)(((u0 + r32) << dsh) + rho)) * 4 + h] = m_reg * QK_C2 + __builtin_amdgcn_logf(l_reg);
}
__device__ __forceinline__ void da_unit(const DaTensors& T, bf16_t* OA, int b, int h, int chunk, LAS unsigned char* lds, LAS float* wscr) {
    int tid = threadIdx.x; asm volatile("" : "+v"(tid)); const int wid = __builtin_amdgcn_readfirstlane(tid >> 6);
    for (int jj = 0; jj < 6; ++jj) {
        const int job = wid + 8 * jj, g = job >> 4, idx = job & 15;
        int rho, u0;
        if (g == 0) { rho = 0; u0 = chunk * 512 + 32 * idx; }
        else if (g == 1) { rho = idx >> 2; u0 = chunk * 128 + 32 * (idx & 3); }
        else { rho = idx; u0 = chunk * 32; }
        da_job(T, b, h, g, rho, u0, lds + wid * 16384, wscr + wid * 64);
    }
    asm volatile("s_waitcnt vmcnt(0)" ::: "memory");
    __syncthreads();
    const size_t rowbase = (size_t)b * SEQ + (size_t)chunk * 512;
    for (int it = tid; it < 512 * 16; it += 512) {
        const int tk = it >> 4, ch = it & 15; const size_t row = rowbase + tk;
        const float l0 = T.PL[(0 * (size_t)MTOK + row) * 4 + h], l1 = T.PL[(1 * (size_t)MTOK + row) * 4 + h], l2 = T.PL[(2 * (size_t)MTOK + row) * 4 + h];
        const float mx = fmaxf(l0, fmaxf(l1, l2));
        float w0 = __builtin_amdgcn_exp2f(l0 - mx), w1 = __builtin_amdgcn_exp2f(l1 - mx), w2 = __builtin_amdgcn_exp2f(l2 - mx);
        const float inv = 1.0f / (w0 + w1 + w2); w0 *= inv; w1 *= inv; w2 *= inv;
        const size_t off = row * 512 + h * HD + ch * 8;
        const u32x4 a = *(const u32x4*)(T.PO + off), bq = *(const u32x4*)(T.PO + (size_t)MTOK * 512 + off), c = *(const u32x4*)(T.PO + (size_t)2 * MTOK * 512 + off);
        u32x4 w;
        w.x = cvt_pk_bf16(w0 * bf_lo(a.x) + w1 * bf_lo(bq.x) + w2 * bf_lo(c.x), w0 * bf_hi(a.x) + w1 * bf_hi(bq.x) + w2 * bf_hi(c.x));
        w.y = cvt_pk_bf16(w0 * bf_lo(a.y) + w1 * bf_lo(bq.y) + w2 * bf_lo(c.y), w0 * bf_hi(a.y) + w1 * bf_hi(bq.y) + w2 * bf_hi(c.y));
        w.z = cvt_pk_bf16(w0 * bf_lo(a.z) + w1 * bf_lo(bq.z) + w2 * bf_lo(c.z), w0 * bf_hi(a.z) + w1 * bf_hi(bq.z) + w2 * bf_hi(c.z));
        w.w = cvt_pk_bf16(w0 * bf_lo(a.w) + w1 * bf_lo(bq.w) + w2 * bf_lo(c.w), w0 * bf_hi(a.w) + w1 * bf_hi(bq.w) + w2 * bf_hi(c.w));
        *(u32x4*)(OA + off) = w;
    }
    __syncthreads();
}
#undef SBAR
}
#define MK_ONE_LAUNCH 1
constexpr int NWAVES = 8;
#ifndef MK_ONE_LAUNCH
#define MK_ONE_LAUNCH 1
#endif
constexpr size_t MiB = 1u << 20;
constexpr size_t WS_CTL = 0, CTL_ZERO_BYTES = 1 * MiB;
constexpr size_t WS_ROPE = 2 * MiB;
constexpr size_t WS_WRT = 4 * MiB;
constexpr size_t WS_SA = 4 * MiB + 512 * 1024;
constexpr size_t WS_SB = 4 * MiB + 768 * 1024;
constexpr size_t WS_TOK = 5 * MiB;
constexpr size_t WS_LIST = 6 * MiB;
constexpr size_t WS_PL = 7 * MiB;
constexpr size_t WS_W = 8 * MiB;
constexpr size_t LW_IN = 0, LW_PA = LW_IN + (size_t)NIN * DM * 2, LW_PB = LW_PA + (size_t)DM * 512 * 2, LW_WO = LW_PB + (size_t)DM * 1024 * 2,
                 LW_UP = LW_WO + (size_t)DM * DM * 2, LW_DN = LW_UP + (size_t)NEXP * 1024 * DM * 2, LW_BYTES = LW_DN + (size_t)NEXP * DM * FF * 2;
static_assert(LW_BYTES == 156 * MiB, "weights per layer");
constexpr size_t WS_HB = WS_W + 2 * LW_BYTES;
constexpr size_t WS_OA = WS_HB + 64 * MiB;
constexpr size_t WS_OB = WS_OA + 16 * MiB;
constexpr size_t WS_PO = WS_OB + 32 * MiB;
constexpr size_t WS_GATES = WS_PO + 48 * MiB;
constexpr size_t WS_QKV = WS_GATES + 128 * MiB;
constexpr size_t WS_P1 = WS_QKV;
constexpr size_t WS_Z = WS_P1;
constexpr size_t WS_MRG = WS_QKV + 64 * MiB;
constexpr size_t WS_HID = WS_QKV + 144 * MiB;
constexpr size_t WS_YP = WS_QKV;
constexpr size_t WS_H8 = WS_QKV + 240 * MiB;
constexpr size_t WS_END = WS_H8 + 32 * MiB;
static_assert(WS_HID >= WS_YP + (size_t)36864 * DM * 2 || WS_YP >= WS_HID + (size_t)36864 * FF * 2, "YP / HID overlap");
static_assert(WS_END <= 1024 * MiB, "workspace");
constexpr int CW_TMO = 0, CW_CODE = 1, CW_BAR = 4096, CW_ECNT = 16384;
constexpr int CW_CMAX = 32768;
static_assert((CW_CMAX + DEPTH * NIN) * 4 <= (int)CTL_ZERO_BYTES, "ctl");
#define XB_TMO      128
#define XB_XCNT(j)  (256  + 64 * (j))
#define XB_XSUB(j)  (1280 + 64 * (j))
#define XB_XGEN(j)  (2304 + 64 * (j))
#define XB_TOP      3328
#define XB_TOPGEN   3392
#define XCD_BAR_WORDS 3456
#define XB_SPIN_CAP (1u << 18)
constexpr int RING_BYTES = 131072, LDSCTL_OFF = RING_BYTES, MISC_OFF = LDSCTL_OFF + 320, LT_OFF = LDSCTL_OFF + 1024  , WSCR_OFF = LDSCTL_OFF + 2048  ;
constexpr int LDS_BYTES = 147456;

__device__ __forceinline__ unsigned xb_ld(unsigned* p)              { return __hip_atomic_load(p, __ATOMIC_RELAXED, __HIP_MEMORY_SCOPE_AGENT); }
__device__ __forceinline__ unsigned xb_add(unsigned* p, unsigned v) { return __hip_atomic_fetch_add(p, v, __ATOMIC_RELAXED, __HIP_MEMORY_SCOPE_AGENT); }
__device__ __forceinline__ unsigned xb_xcc_id() { return (unsigned)__builtin_amdgcn_s_getreg((3 << 11) | 20) & 0xFu; }
#define XB_SPIN(cond, bar) do { unsigned _sp = 0; while (cond) { __builtin_amdgcn_s_sleep(1); \
    if ((++_sp & 255u) == 0u) { if (xb_ld(&(bar)[XB_TMO])) break; if (_sp > XB_SPIN_CAP) { atomicAdd(&(bar)[XB_TMO], 1u); break; } } } } while (0)
struct XcdBarrier { unsigned* bar; unsigned x; volatile LAS unsigned* st; };
__device__ __forceinline__ XcdBarrier xcd_barrier_post(unsigned* bar, volatile LAS unsigned* st) {
    XcdBarrier b; b.bar = bar; b.x = xb_xcc_id(); b.st = st;
    if (threadIdx.x == 0) (void)xb_add(&bar[XB_XCNT(b.x)], 1u);
    return b;
}
__device__ __forceinline__ void xcd_barrier_complete(unsigned* bar, unsigned x, unsigned& nloc, unsigned& nx) {
    const unsigned G = gridDim.x * gridDim.y * gridDim.z;
    unsigned sum, cnt, mine, sp = 0u;
    for (;;) {
        sum = 0u; cnt = 0u; mine = 0u;
#pragma unroll
        for (unsigned j = 0; j < 16; ++j) { const unsigned c = xb_ld(&bar[XB_XCNT(j)]); sum += c; cnt += (c > 0u) ? 1u : 0u; mine = (j == x) ? c : mine; }
        if (sum == G) break;
        __builtin_amdgcn_s_sleep(1);
        if ((++sp & 255u) == 0u) { if (xb_ld(&bar[XB_TMO])) break; if (sp > XB_SPIN_CAP) { atomicAdd(&bar[XB_TMO], 1u); break; } }
    }
    nloc = mine > 0u ? mine : 1u; nx = cnt > 0u ? cnt : 1u;
}
__device__ __forceinline__ void xcd_barrier(const XcdBarrier& b) {
    asm volatile("s_waitcnt vmcnt(0)" ::: "memory");
    __syncthreads();
    if (threadIdx.x == 0) {
        unsigned* bar = b.bar;
        __builtin_amdgcn_s_waitcnt(0);
        unsigned nloc = b.st[0], nx = b.st[1];
        if (nloc == 0u) { xcd_barrier_complete(bar, b.x, nloc, nx); b.st[0] = nloc; b.st[1] = nx; }
        const unsigned old = xb_add(&bar[XB_XSUB(b.x)], 1u);
        const unsigned gen = old / nloc;
        if (old + 1u == (gen + 1u) * nloc) {
            __builtin_amdgcn_fence(__ATOMIC_RELEASE, "agent");
            asm volatile("s_waitcnt vmcnt(0)" ::: "memory");
            const unsigned og = xb_add(&bar[XB_TOP], 1u);
            const unsigned tg = og / nx;
            if (og + 1u == (tg + 1u) * nx) xb_add(&bar[XB_TOPGEN], 1u);
            else XB_SPIN(xb_ld(&bar[XB_TOPGEN]) == tg, bar);
            __builtin_amdgcn_fence(__ATOMIC_ACQUIRE, "agent");
            xb_add(&bar[XB_XGEN(b.x)], 1u);
            asm volatile("s_waitcnt vmcnt(0)" ::: "memory");
        } else {
            XB_SPIN(xb_ld(&bar[XB_XGEN(b.x)]) == gen, bar);
            __builtin_amdgcn_fence(__ATOMIC_ACQUIRE, "agent");
            asm volatile("s_waitcnt vmcnt(0)" ::: "memory");
        }
    }
    __syncthreads();
}

struct Args { const float* in[14]; float* out; unsigned char* ws; int ph_lo, ph_hi; };
static_assert(sizeof(Args) == 14 * 8 + 8 + 8 + 8, "Args has no padding");

__device__ __forceinline__ float wave_sum(float v) {
#pragma unroll
    for (int o = 1; o < 64; o <<= 1) v += __shfl_xor(v, o);
    return v;
}
__device__ __forceinline__ unsigned f2bf(float f) { unsigned u = __builtin_bit_cast(unsigned, f); return (u + 0x7fffu + ((u >> 16) & 1u)) >> 16; }
__device__ __forceinline__ unsigned pk2(float lo, float hi) { return f2bf(lo) | (f2bf(hi) << 16); }

template <int MAP> __device__ __forceinline__ int wmap(int n) {
    if (MAP == 1) {
        if (n < 2 * WA) { const int d = n & 127; if (d < 32) { const int dd = (d < 16) ? (((d >> 2) << 3) + (d & 3)) : ((((d - 16) >> 2) << 3) + 4 + (d & 3)); return (n & ~127) + dd; } }
        return n;
    } else if (MAP == 2) {
        if (n < FF) return ((n >> 7) << 8) + (n & 127);
        const int j = n - FF; return ((j >> 7) << 8) + 128 + (j & 127);
    }
    return n;
}
template <int MAP>
__device__ __forceinline__ void xpose_item(const float* W, int K, int N, bf16_t* WT, LAS float* scr, int item, int lane) {
    const int nblk = N / 32, kb = item / nblk, nb = item % nblk, k0 = 64 * kb, n0 = 32 * nb;
#pragma unroll 8
    for (int i = 0; i < 32; ++i) { const int kk = 2 * i + (lane >> 5); scr[kk * 33 + (lane & 31)] = W[(size_t)(k0 + kk) * N + n0 + (lane & 31)]; }
    asm volatile("s_waitcnt lgkmcnt(0)" ::: "memory");
    const int c = lane & 7;
#pragma unroll
    for (int j = 0; j < 4; ++j) { const int n = (lane >> 3) + 8 * j; const LAS float* s = scr + (8 * c) * 33 + n;
        u32x4 o; o.x = pk2(s[0 * 33], s[1 * 33]); o.y = pk2(s[2 * 33], s[3 * 33]); o.z = pk2(s[4 * 33], s[5 * 33]); o.w = pk2(s[6 * 33], s[7 * 33]);
        *(u32x4*)(WT + (size_t)wmap<MAP>(n0 + n) * K + k0 + 8 * c) = o; }
    asm volatile("s_waitcnt lgkmcnt(0)" ::: "memory");
}
__device__ __forceinline__ int opq(int x) { asm volatile("" : "+v"(x)); return x; }
struct Frame {
    LAS unsigned char* lds; volatile LAS unsigned* MISC; unsigned* ctl; unsigned char* ws;
    int tid, lane, wave, vcu, G;
    const Args* A; float* out;
};
constexpr int I_CMX = (DM / 256) * (NIN / 32);
constexpr int I_IN = (DM / 64) * (NIN / 32), I_PA = (512 / 64) * (DM / 32), I_PB = (1024 / 64) * (DM / 32), I_WO = (DM / 64) * (DM / 32),
              I_UP1 = (DM / 64) * (1024 / 32), I_UP = NEXP * I_UP1, I_DN1 = (FF / 64) * (DM / 32), I_DN = NEXP * I_DN1, I_LAYER0 = I_CMX + I_PA + I_PB + I_WO + I_UP + I_DN;

__device__ __forceinline__ float wave_max(float v) {
#pragma unroll
    for (int o = 1; o < 64; o <<= 1) v = fmaxf(v, __shfl_xor(v, o));
    return v;
}
__device__ __forceinline__ unsigned q8(float v, float inv) { const int q = (int)__builtin_rintf(v * inv); return (unsigned)(q < -127 ? -127 : (q > 127 ? 127 : q)) & 0xffu; }
__device__ __forceinline__ unsigned q8x4(float a, float b, float c, float d, float inv) { return q8(a, inv) | (q8(b, inv) << 8) | (q8(c, inv) << 16) | (q8(d, inv) << 24); }

__device__ __forceinline__ void colmax_item(const float* W, int N, unsigned* cmax, int item, int lane) {
    const int nblk = N / 32, kb = item / nblk, nb = item % nblk, k0 = 256 * kb, n0 = 32 * nb;
    float m = 0.f;
#pragma unroll 8
    for (int i = 0; i < 128; ++i) m = fmaxf(m, fabsf(W[(size_t)(k0 + 2 * i + (lane >> 5)) * N + n0 + (lane & 31)]));
    m = fmaxf(m, __shfl_xor(m, 32));
    if (lane < 32) __hip_atomic_fetch_max(cmax + n0 + lane, __float_as_uint(m), __ATOMIC_RELAXED, __HIP_MEMORY_SCOPE_AGENT);
}
template <int MAP>
__device__ __forceinline__ void quant_item(const float* W, int K, int N, unsigned char* WT, float* sb, const unsigned* cmax, LAS float* scr, int item, int lane) {
    const int nblk = N / 32, kb = item / nblk, nb = item % nblk, k0 = 64 * kb, n0 = 32 * nb;
#pragma unroll 8
    for (int i = 0; i < 32; ++i) { const int kk = 2 * i + (lane >> 5); scr[kk * 33 + (lane & 31)] = W[(size_t)(k0 + kk) * N + n0 + (lane & 31)]; }
    asm volatile("s_waitcnt lgkmcnt(0)" ::: "memory");
    const int c = lane & 3;
#pragma unroll
    for (int j = 0; j < 2; ++j) { const int n = (lane >> 2) + 16 * j; const LAS float* s = scr + (16 * c) * 33 + n;
        const float am = __uint_as_float(cmax[n0 + n]); const float inv = am > 0.f ? 127.0f / am : 0.f;
        u32x4 o; o.x = q8x4(s[0 * 33], s[1 * 33], s[2 * 33], s[3 * 33], inv); o.y = q8x4(s[4 * 33], s[5 * 33], s[6 * 33], s[7 * 33], inv);
        o.z = q8x4(s[8 * 33], s[9 * 33], s[10 * 33], s[11 * 33], inv); o.w = q8x4(s[12 * 33], s[13 * 33], s[14 * 33], s[15 * 33], inv);
        const int dr = wmap<MAP>(n0 + n);
        *(u32x4*)(WT + (size_t)dr * K + k0 + 16 * c) = o;
        if (kb == 0 && c == 0) sb[dr] = am * (1.0f / 127.0f); }
    asm volatile("s_waitcnt lgkmcnt(0)" ::: "memory");
}

__device__ __forceinline__ void p0_prologue(Frame& F) {
    LAS float* scr = (LAS float*)(F.lds + F.wave * 16384);
    const int gw = F.vcu * NWAVES + F.wave, NGW = F.G * NWAVES;
    for (int it = gw; it < DEPTH * I_LAYER0; it += NGW) {
        const int l = it / I_LAYER0; int r = it % I_LAYER0;
        bf16_t* LW = (bf16_t*)(F.ws + WS_W + (size_t)l * LW_BYTES);
        if (r < I_CMX) { colmax_item(F.A->in[2] + (size_t)l * DM * NIN, NIN, F.ctl + CW_CMAX + l * NIN, r, F.lane); continue; } r -= I_CMX;
        if (r < I_PA) { xpose_item<0>(F.A->in[3] + (size_t)l * 512 * DM, 512, DM, LW + LW_PA / 2, scr, r, F.lane); continue; } r -= I_PA;
        if (r < I_PB) { xpose_item<0>(F.A->in[4] + (size_t)l * 1024 * DM, 1024, DM, LW + LW_PB / 2, scr, r, F.lane); continue; } r -= I_PB;
        if (r < I_WO) { xpose_item<0>(F.A->in[5] + (size_t)l * DM * DM, DM, DM, LW + LW_WO / 2, scr, r, F.lane); continue; } r -= I_WO;
        if (r < I_UP) { const int e = r / I_UP1; xpose_item<2>(F.A->in[12] + ((size_t)l * NEXP + e) * DM * 1024, DM, 1024, LW + LW_UP / 2 + (size_t)e * 1024 * DM, scr, r % I_UP1, F.lane); continue; } r -= I_UP;
        { const int e = r / I_DN1; xpose_item<0>(F.A->in[13] + ((size_t)l * NEXP + e) * FF * DM, FF, DM, LW + LW_DN / 2 + (size_t)e * DM * FF, scr, r % I_DN1, F.lane); }
    }
    bf16_t* HB = (bf16_t*)(F.ws + WS_HB); unsigned char* H8 = F.ws + WS_H8; float* SA = (float*)(F.ws + WS_SA);
    for (int m = gw; m < MTOK; m += NGW) {
        const f32x4* xr = (const f32x4*)(F.A->in[0] + (size_t)m * DM) + F.lane; unsigned long long* o8 = (unsigned long long*)(HB + (size_t)m * DM) + F.lane;
        f32x4 v[8]; float am = 0.f;
#pragma unroll
        for (int j = 0; j < 8; ++j) { v[j] = xr[64 * j]; am = fmaxf(fmaxf(am, fmaxf(fabsf(v[j].x), fabsf(v[j].y))), fmaxf(fabsf(v[j].z), fabsf(v[j].w))); }
        am = wave_max(am); const float inv = am > 0.f ? 127.0f / am : 0.f;
        unsigned* o4 = (unsigned*)(H8 + (size_t)m * DM) + F.lane;
#pragma unroll
        for (int j = 0; j < 8; ++j) { o8[64 * j] = (unsigned long long)cvt_pk_bf16(v[j].x, v[j].y) | ((unsigned long long)cvt_pk_bf16(v[j].z, v[j].w) << 32); o4[64 * j] = q8x4(v[j].x, v[j].y, v[j].z, v[j].w, inv); }
        if (F.lane == 0) SA[m] = am * (1.0f / 127.0f);
    }
    {
        float* rope = (float*)(F.ws + WS_ROPE); const int* pos = (const int*)F.A->in[1];
        const int f = F.tid & 15;
        const float IF[16] = {1.0f, 0.44036659598350525f, 0.1939227432012558f, 0.08539710193872452f, 0.03760603070259094f, 0.016560440883040428f, 0.007292664609849453f, 0.0032114461064338684f,
                              0.0014142135623842478f, 0.0006227724370546639f, 0.00027424818836152554f, 0.00012076973507646471f, 5.3182957344688475e-05f, 2.34199997066753e-05f, 1.0313385246263351e-05f, 4.541670477919979e-06f};
        float inv = 0.f;
#pragma unroll
        for (int k = 0; k < 16; ++k) inv = (f == k) ? IF[k] : inv;
        for (int i = F.vcu * 512 + F.tid; i < MTOK * 16; i += F.G * 512) {
            const int row = i >> 4; const float ang = (float)pos[row] * inv;
            double rev = (double)ang * 0.15915494309189535; rev -= __builtin_rint(rev); const float rv = (float)rev;
            rope[(size_t)row * 32 + f] = __builtin_amdgcn_cosf(rv); rope[(size_t)row * 32 + 16 + f] = __builtin_amdgcn_sinf(rv);
        }
    }
    {
        float* WrT = (float*)(F.ws + WS_WRT);
        for (int i = F.vcu * 512 + F.tid; i < DEPTH * 20 * DM; i += F.G * 512) {
            const int l = i / (20 * DM), o = (i / DM) % 20, k = i % DM;
            WrT[i] = (o < 4) ? F.A->in[8][((size_t)l * DM + k) * 4 + o] : F.A->in[10][((size_t)l * DM + k) * 16 + (o - 4)];
        }
    }
}
__device__ __forceinline__ void p1_quant(Frame& F) {
    LAS float* scr = (LAS float*)(F.lds + F.wave * 16384);
    const int gw = F.vcu * NWAVES + F.wave, NGW = F.G * NWAVES;
    for (int it = gw; it < DEPTH * I_IN; it += NGW) {
        const int l = it / I_IN, r = it % I_IN;
        quant_item<1>(F.A->in[2] + (size_t)l * DM * NIN, DM, NIN, F.ws + WS_W + (size_t)l * LW_BYTES + LW_IN, (float*)(F.ws + WS_SB) + l * NIN, F.ctl + CW_CMAX + l * NIN, scr, r, F.lane);
    }
}

__device__ __forceinline__ void unpack8(const u32x4 w, float* f) { f[0] = bf_lo(w.x); f[1] = bf_hi(w.x); f[2] = bf_lo(w.y); f[3] = bf_hi(w.y); f[4] = bf_lo(w.z); f[5] = bf_hi(w.z); f[6] = bf_lo(w.w); f[7] = bf_hi(w.w); }
__device__ __forceinline__ u32x4 pack8f(const float* f) { u32x4 w; w.x = cvt_pk_bf16(f[0], f[1]); w.y = cvt_pk_bf16(f[2], f[3]); w.z = cvt_pk_bf16(f[4], f[5]); w.w = cvt_pk_bf16(f[6], f[7]); return w; }

__device__ __forceinline__ void ln1_router(Frame& F0, int l) {
    struct { LAS unsigned char* lds; unsigned* ctl; unsigned char* ws; int tid, lane, wave, vcu; const Args* A; } F;
    F.lds = F0.lds; F.ctl = F0.ctl; F.ws = F0.ws; F.tid = opq(F0.tid); F.lane = F.tid & 63; F.wave = __builtin_amdgcn_readfirstlane(F.tid >> 6); F.vcu = F0.vcu; F.A = F0.A;
    LAS float* Wl = (LAS float*)F.lds;
    LAS float* Pt = (LAS float*)(F.lds + 81920);
    const float* gam = F.A->in[6] + (size_t)(l * 2) * DM; const float* bet = F.A->in[7] + (size_t)(l * 2) * DM;
    const float* WrT = (const float*)(F.ws + WS_WRT) + (size_t)l * 20 * DM;
    bf16_t* HB = (bf16_t*)(F.ws + WS_HB); const bf16_t* Z = (const bf16_t*)(F.ws + WS_Z);
    const int row0 = F.vcu * 64;
    for (int pass = 0; pass < 2; ++pass) {
        for (int i = F.tid; i < 20 * 256; i += 512) { const int o = i >> 8, k4 = i & 255; *(LAS f32x4*)(Wl + o * 1024 + 4 * k4) = *(const f32x4*)(WrT + (size_t)o * DM + pass * 1024 + 4 * k4); }
        __syncthreads();
        for (int i = 0; i < 8; ++i) {
            const int rl = F.wave * 8 + i, row = row0 + rl;
            const u32x4* zr = (const u32x4*)(Z + (size_t)row * DM) + F.lane;
            float v[4][8]; float s = 0.f;
#pragma unroll
            for (int j = 0; j < 4; ++j) { unpack8(zr[64 * j], v[j]);
#pragma unroll
                for (int e = 0; e < 8; ++e) s += v[j][e]; }
            const float mean = wave_sum(s) * (1.f / DM); float s2 = 0.f;
#pragma unroll
            for (int j = 0; j < 4; ++j)
#pragma unroll
                for (int e = 0; e < 8; ++e) { v[j][e] -= mean; s2 += v[j][e] * v[j][e]; }
            const float rstd = 1.f / sqrtf(wave_sum(s2) * (1.f / DM) + LN_EPS);
#pragma unroll
            for (int j = 0; j < 4; ++j) { const f32x4 g0 = ((const f32x4*)gam)[2 * F.lane + 128 * j], g1 = ((const f32x4*)gam)[2 * F.lane + 128 * j + 1], b0 = ((const f32x4*)bet)[2 * F.lane + 128 * j], b1 = ((const f32x4*)bet)[2 * F.lane + 128 * j + 1];
#pragma unroll
                for (int e = 0; e < 4; ++e) { v[j][e] = v[j][e] * rstd * g0[e] + b0[e]; v[j][4 + e] = v[j][4 + e] * rstd * g1[e] + b1[e]; } }
            if (pass == 1) { u32x4* hr = (u32x4*)(HB + (size_t)row * DM) + F.lane;
#pragma unroll
                for (int j = 0; j < 4; ++j) hr[64 * j] = pack8f(v[j]); }
            float acc[20];
#pragma unroll
            for (int o = 0; o < 20; ++o) acc[o] = 0.f;
#pragma unroll
            for (int jj = 0; jj < 2; ++jj) {
#pragma unroll
                for (int o = 0; o < 20; ++o) { const f32x4 w0 = *(const LAS f32x4*)(Wl + o * 1024 + 8 * F.lane + 512 * jj), w1 = *(const LAS f32x4*)(Wl + o * 1024 + 8 * F.lane + 512 * jj + 4);
                    const float* x = pass == 0 ? v[jj] : v[2 + jj];
                    acc[o] += ((x[0] * w0.x + x[1] * w0.y) + (x[2] * w0.z + x[3] * w0.w)) + ((x[4] * w1.x + x[5] * w1.y) + (x[6] * w1.z + x[7] * w1.w)); } }
            float mine = 0.f;
#pragma unroll
            for (int o = 0; o < 20; ++o) { const float t = wave_sum(acc[o]); mine = (F.lane == o) ? t : mine; }
            if (F.lane < 20) { if (pass == 0) Pt[rl * 20 + F.lane] = mine; else Pt[rl * 20 + F.lane] += mine; }
        }
        __syncthreads();
    }
    if (F.wave == 0) {
        const int rl = F.lane, row = row0 + rl;
        const float* cb = F.A->in[9] + l * 4; const float* fb = F.A->in[11] + l * 16;
        float c[4], f[16];
#pragma unroll
        for (int j = 0; j < 4; ++j) c[j] = Pt[rl * 20 + j] + cb[j];
#pragma unroll
        for (int j = 0; j < 16; ++j) f[j] = Pt[rl * 20 + 4 + j] + fb[j];
        float cmax = c[0]; int g = 0;
#pragma unroll
        for (int j = 1; j < 4; ++j) if (c[j] > cmax) { cmax = c[j]; g = j; }
        float se = 0.f;
#pragma unroll
        for (int j = 0; j < 4; ++j) se += __expf(c[j] - cmax);
        const float pgrp = 1.0f / se;
        float sel[4];
#pragma unroll
        for (int i = 0; i < 4; ++i) sel[i] = (g == 0) ? f[i] : (g == 1) ? f[4 + i] : (g == 2) ? f[8 + i] : f[12 + i];
        float v1 = sel[0]; int i1 = 0;
#pragma unroll
        for (int i = 1; i < 4; ++i) if (sel[i] > v1) { v1 = sel[i]; i1 = i; }
        float v2 = -__builtin_inff(); int i2 = 0;
#pragma unroll
        for (int i = 0; i < 4; ++i) if (i != i1 && sel[i] > v2) { v2 = sel[i]; i2 = i; }
        const float w1 = 1.0f / (1.0f + __expf(v2 - v1)), w2 = 1.0f - w1;
        const int e1 = 4 * g + i1, e2 = 4 * g + i2;
        const unsigned long long lt = (1ull << F.lane) - 1ull;
        int r1 = 0, r2 = 0, mycnt = 0;
#pragma unroll
        for (int e = 0; e < NEXP; ++e) { const unsigned long long m1 = __ballot(e1 == e), m2 = __ballot(e2 == e); const int c1 = __popcll(m1);
            if (e1 == e) r1 = __popcll(m1 & lt); if (e2 == e) r2 = c1 + __popcll(m2 & lt); if (F.lane == e) mycnt = c1 + __popcll(m2); }
        int base = 0;
        if (F.lane < NEXP && mycnt > 0) base = (int)__hip_atomic_fetch_add(F.ctl + CW_ECNT + 64 * l + F.lane, (unsigned)mycnt, __ATOMIC_RELAXED, __HIP_MEMORY_SCOPE_AGENT);
        const int pos1 = __shfl(base, e1) + r1, pos2 = __shfl(base, e2) + r2;
        int* list = (int*)(F.ws + WS_LIST);
        list[e1 * ECAP + pos1] = row; list[e2 * ECAP + pos2] = row;
        ((u32x4*)(F.ws + WS_TOK))[row] = (u32x4){(unsigned)(e1 << 16 | pos1), __float_as_uint(pgrp * w1), (unsigned)(e2 << 16 | pos2), __float_as_uint(pgrp * w2)};
    }
    __syncthreads();
}
__device__ __forceinline__ void moe_tables(Frame& F, int l) {
    LAS int* LT = (LAS int*)(F.lds + LT_OFF);
    if (F.tid == 0) { int t = 0;
        for (int e = 0; e < NEXP; ++e) { const int c = (int)__hip_atomic_load(F.ctl + CW_ECNT + 64 * l + e, __ATOMIC_RELAXED, __HIP_MEMORY_SCOPE_AGENT); LT[e] = t; LT[32 + e] = c; t += (c + 255) >> 8; }
        LT[16] = t; }
    __syncthreads();
    if (F.tid < 160) { const int rt = F.tid; int e = 0;
#pragma unroll
        for (int j = 1; j < NEXP; ++j) e += (LT[j] <= rt) ? 1 : 0;
        LT[64 + rt] = e; }
    __syncthreads();
}
__device__ __forceinline__ void ln2_phase(Frame& F0, int l) {
    struct { LAS unsigned char* lds; unsigned char* ws; int lane, wave, vcu, G; const Args* A; float* out; } F;
    F.lds = F0.lds; F.ws = F0.ws; { const int t = opq(F0.tid); F.lane = t & 63; F.wave = __builtin_amdgcn_readfirstlane(t >> 6); } F.vcu = F0.vcu; F.G = F0.G; F.A = F0.A; F.out = F0.out;
    const LAS int* LT = (const LAS int*)(F.lds + LT_OFF);
    const float* gam = F.A->in[6] + (size_t)(l * 2 + 1) * DM; const float* bet = F.A->in[7] + (size_t)(l * 2 + 1) * DM;
    bf16_t* HB = (bf16_t*)(F.ws + WS_HB); const bf16_t* YP = (const bf16_t*)(F.ws + WS_YP); unsigned char* H8 = F.ws + WS_H8; float* SA = (float*)(F.ws + WS_SA);
    const int gw = F.vcu * NWAVES + F.wave, NGW = F.G * NWAVES;
    for (int row = gw; row < MTOK; row += NGW) {
        const u32x4 ti = ((const u32x4*)(F.ws + WS_TOK))[row];
        const int e1 = ti.x >> 16, p1 = ti.x & 0xffff, e2 = ti.z >> 16, p2 = ti.z & 0xffff; const float g1 = __uint_as_float(ti.y), g2 = __uint_as_float(ti.w);
        const size_t s1 = (size_t)LT[e1] * 256 + p1, s2 = (size_t)LT[e2] * 256 + p2;
        u32x4* hr = (u32x4*)(HB + (size_t)row * DM) + F.lane;
        const u32x4* y1 = (const u32x4*)(YP + s1 * DM) + F.lane; const u32x4* y2 = (const u32x4*)(YP + s2 * DM) + F.lane;
        float v[4][8]; float s = 0.f;
#pragma unroll
        for (int j = 0; j < 4; ++j) { float h[8], a[8], b[8]; unpack8(hr[64 * j], h); unpack8(y1[64 * j], a); unpack8(y2[64 * j], b);
#pragma unroll
            for (int e = 0; e < 8; ++e) { v[j][e] = ALPHA * h[e] + g1 * a[e] + g2 * b[e]; s += v[j][e]; } }
        const float mean = wave_sum(s) * (1.f / DM); float s2v = 0.f;
#pragma unroll
        for (int j = 0; j < 4; ++j)
#pragma unroll
            for (int e = 0; e < 8; ++e) { v[j][e] -= mean; s2v += v[j][e] * v[j][e]; }
        const float rstd = 1.f / sqrtf(wave_sum(s2v) * (1.f / DM) + LN_EPS);
        float am = 0.f;
#pragma unroll
        for (int j = 0; j < 4; ++j) { const f32x4 g0 = ((const f32x4*)gam)[2 * F.lane + 128 * j], g1v = ((const f32x4*)gam)[2 * F.lane + 128 * j + 1], b0 = ((const f32x4*)bet)[2 * F.lane + 128 * j], b1 = ((const f32x4*)bet)[2 * F.lane + 128 * j + 1];
#pragma unroll
            for (int e = 0; e < 4; ++e) { v[j][e] = v[j][e] * rstd * g0[e] + b0[e]; v[j][4 + e] = v[j][4 + e] * rstd * g1v[e] + b1[e]; am = fmaxf(am, fmaxf(fabsf(v[j][e]), fabsf(v[j][4 + e]))); } }
        if (l + 1 < DEPTH) {
            am = wave_max(am); const float inv = am > 0.f ? 127.0f / am : 0.f;
            u32x2* q = (u32x2*)(H8 + (size_t)row * DM) + F.lane;
#pragma unroll
            for (int j = 0; j < 4; ++j) { hr[64 * j] = pack8f(v[j]); q[64 * j] = (u32x2){q8x4(v[j][0], v[j][1], v[j][2], v[j][3], inv), q8x4(v[j][4], v[j][5], v[j][6], v[j][7], inv)}; }
            if (F.lane == 0) SA[row] = am * (1.0f / 127.0f);
        } else {
            f32x4* o = (f32x4*)(F.out + (size_t)row * DM) + 2 * F.lane;
#pragma unroll
            for (int j = 0; j < 4; ++j) { o[128 * j] = (f32x4){v[j][0], v[j][1], v[j][2], v[j][3]}; o[128 * j + 1] = (f32x4){v[j][4], v[j][5], v[j][6], v[j][7]}; }
        }
    }
}

constexpr int N_PHASES = 2 + 8 * DEPTH;
#ifndef PHMASK
#define PHMASK 0x3ff
#endif
#ifndef DUPMASK
#define DUPMASK 0
#endif
__global__ void __launch_bounds__(NWAVES * 64, 2) mk_fwd(Args args) {
    extern __shared__ __attribute__((aligned(16))) unsigned char lds_raw[];
    Frame F;
    F.lds = (LAS unsigned char*)lds_raw; F.MISC = (volatile LAS unsigned*)(F.lds + MISC_OFF);
    F.tid = threadIdx.x; F.lane = F.tid & 63; F.wave = __builtin_amdgcn_readfirstlane(F.tid >> 6);
    F.G = gridDim.x; { const int bx = blockIdx.x; F.vcu = (F.G % 8 == 0) ? (bx % 8) * (F.G / 8) + bx / 8 : bx; }
    F.ws = args.ws; F.ctl = (unsigned*)(args.ws + WS_CTL); F.out = args.out;
    F.A = &args;
    for (int u = F.tid; u < (LDS_BYTES - LDSCTL_OFF) / 4; u += NWAVES * 64) ((LAS unsigned*)(F.lds + LDSCTL_OFF))[u] = 0u;
    __syncthreads();
    const int lo = args.ph_lo, hi = args.ph_hi;
    XcdBarrier bar; bar.bar = F.ctl + CW_BAR; bar.x = 0; bar.st = nullptr;
    if (hi - lo > 1) bar = xcd_barrier_post(F.ctl + CW_BAR, F.MISC + 8);
#define IN(k) (lo <= (k) && (k) < hi)
#define PH(s) ((PHMASK >> (s)) & 1)
#define REP(s) for (int rep_ = 0; rep_ < (((DUPMASK >> (s)) & 1) ? 2 : 1); ++rep_)
#define SEAM(k) do { if (IN(k) && IN((k) + 1)) xcd_barrier(bar); } while (0)
    if (PH(0) && IN(0)) { REP(0) p0_prologue(F); SEAM(0); }
    if (PH(0) && IN(1)) { REP(0) p1_quant(F); SEAM(1); }
    bf16_t* HB = (bf16_t*)(F.ws + WS_HB);
    bf16_t* QKV = (bf16_t*)(F.ws + WS_QKV); bf16_t* GATES = (bf16_t*)(F.ws + WS_GATES);
    bf16_t* OA = (bf16_t*)(F.ws + WS_OA); bf16_t* OB = (bf16_t*)(F.ws + WS_OB);
    for (int l = 0; l < DEPTH; ++l) {
        const int pb = 2 + 8 * l;
        const bf16_t* LW = (const bf16_t*)(F.ws + WS_W + (size_t)l * LW_BYTES);
        if (PH(1) && IN(pb + 0)) {
            pg8::Gemm g{(const bf16_t*)(F.ws + WS_H8), LW + LW_IN / 2, DM / 2}; pg8::StaticOrder S; S.init(MTOK, NIN, F.G, (int)blockIdx.x);
            pg8::EpiProj E{QKV, GATES, (const float*)(F.ws + WS_ROPE), (const float*)(F.ws + WS_SA), (const float*)(F.ws + WS_SB) + l * NIN};
            REP(1) pg8::gemm_phase<pg8::EpiProj, pg8::StaticOrder, true, false, true>(F.lds, g, S, E);
            SEAM(pb + 0);
        }
        if (PH(2) && IN(pb + 1)) {
            att::SbTensors TB{QKV + (size_t)3 * MTOK * WA, QKV + (size_t)3 * MTOK * WA + (size_t)MTOK * WB, QKV + (size_t)3 * MTOK * WA + (size_t)2 * MTOK * WB, OB};
            att::DaTensors TA{QKV, QKV + (size_t)MTOK * WA, QKV + (size_t)2 * MTOK * WA, (bf16_t*)(F.ws + WS_PO), (float*)(F.ws + WS_PL)};
            for (int c = F.vcu; c < 256; c += F.G) { const int x = c >> 5, j = c & 31, bh = 8 * x + (j >> 2), role = j & 3;
                const int qbA = role == 0 ? 3 : role == 1 ? 2 : role == 2 ? 7 : 6, qbB = role == 0 ? 0 : role == 1 ? 1 : role == 2 ? 4 : 5;
                REP(2) { att::sb_unit(TB, bh >> 3, bh & 7, qbA, F.lds); att::sb_unit(TB, bh >> 3, bh & 7, qbB, F.lds); }
                if (role < 2) { const int a = x * 16 + (j >> 2) * 2 + role; REP(3) att::da_unit(TA, OA, a >> 4, (a >> 2) & 3, a & 3, F.lds, (LAS float*)(F.lds + WSCR_OFF)); } }
            SEAM(pb + 1);
        }
        if (PH(3) && IN(pb + 2)) {
            bf16_t* P1 = (bf16_t*)(F.ws + WS_P1); bf16_t* MRG = (bf16_t*)(F.ws + WS_MRG);
            pg8::StaticOrder S; S.init(MTOK, DM, F.G, (int)blockIdx.x);
            REP(4) {
            { pg8::Gemm g{OA, LW + LW_PA / 2, 512}; pg8::EpiGate<false> E{GATES, P1, MRG}; pg8::gemm_phase<pg8::EpiGate<false>, pg8::StaticOrder, true, false>(F.lds, g, S, E); }
            { pg8::Gemm g{OB, LW + LW_PB / 2, 1024}; pg8::EpiGate<true> E{GATES + (size_t)MTOK * DM, P1, MRG}; pg8::gemm_phase<pg8::EpiGate<true>, pg8::StaticOrder, true, false>(F.lds, g, S, E); }
            }
            SEAM(pb + 2);
        }
        if (PH(4) && IN(pb + 3)) {
            pg8::Gemm g{(const bf16_t*)(F.ws + WS_MRG), LW + LW_WO / 2, DM}; pg8::StaticOrder S; S.init(MTOK, DM, F.G, (int)blockIdx.x);
            pg8::EpiResid E{HB, (bf16_t*)(F.ws + WS_Z)};
            REP(5) pg8::gemm_phase<pg8::EpiResid, pg8::StaticOrder, true, false>(F.lds, g, S, E);
            SEAM(pb + 3);
        }
        if (PH(5) && IN(pb + 4)) { ln1_router(F, l); SEAM(pb + 4); }
        if (PH(6) && IN(pb + 5)) {
            moe_tables(F, l);
            const LAS int* LT = (const LAS int*)(F.lds + LT_OFF);
            pg8::MoeOrder S{4, F.G, F.vcu, LT[16] * 4, LT, LT + 32, (const int*)(F.ws + WS_LIST)};
            pg8::Gemm g{HB, LW + LW_UP / 2, DM}; pg8::EpiSwiglu E{(bf16_t*)(F.ws + WS_HID)};
            REP(6) pg8::gemm_phase<pg8::EpiSwiglu, pg8::MoeOrder, true, true>(F.lds, g, S, E);
            SEAM(pb + 5);
        }
        if (PH(7) && IN(pb + 6)) {
            moe_tables(F, l);
            const LAS int* LT = (const LAS int*)(F.lds + LT_OFF);
            pg8::MoeOrder S{8, F.G, F.vcu, LT[16] * 8, LT, LT + 32, (const int*)(F.ws + WS_LIST)};
            pg8::Gemm g{(const bf16_t*)(F.ws + WS_HID), LW + LW_DN / 2, FF}; pg8::EpiBf16 E{(bf16_t*)(F.ws + WS_YP), DM};
            REP(7) pg8::gemm_phase<pg8::EpiBf16, pg8::MoeOrder, true, false>(F.lds, g, S, E);
            SEAM(pb + 6);
        }
        if (PH(8) && IN(pb + 7)) { moe_tables(F, l); ln2_phase(F, l); SEAM(pb + 7); }
    }
#undef IN
#undef SEAM
}

extern "C" void kernel_launch(void* const* d_in, const int* in_sizes, int n_in, void* d_out, int out_size, void* d_ws, size_t ws_size, hipStream_t stream) {
    static int grid = 0;
    if (grid == 0) {
        if (n_in != 14 || in_sizes[0] != MTOK * DM || out_size != MTOK * DM || ws_size < WS_END) { fprintf(stderr, "kernel_launch: unexpected shapes (n_in %d, in0 %d, out %d, ws %zu)\n", n_in, n_in > 0 ? in_sizes[0] : -1, out_size, ws_size); grid = -1; return; }
        int dev = 0, cus = 0;
        if (hipGetDevice(&dev) != hipSuccess || hipDeviceGetAttribute(&cus, hipDeviceAttributeMultiprocessorCount, dev) != hipSuccess) { grid = -1; return; }
        if (hipFuncSetAttribute((const void*)mk_fwd, hipFuncAttributeMaxDynamicSharedMemorySize, LDS_BYTES) != hipSuccess) { fprintf(stderr, "kernel_launch: hipFuncSetAttribute failed\n"); grid = -1; return; }
        int per_cu = 0;
        if (hipOccupancyMaxActiveBlocksPerMultiprocessor(&per_cu, (const void*)mk_fwd, NWAVES * 64, LDS_BYTES) != hipSuccess || per_cu < 1) fprintf(stderr, "kernel_launch: occupancy query reports %d\n", per_cu);
        (void)hipGetLastError();
        if (cus < 256) { fprintf(stderr, "kernel_launch: needs 256 CUs, device has %d\n", cus); grid = -1; return; }
        grid = 256;
    }
    if (grid < 0) return;
    if (hipMemsetAsync((char*)d_ws + WS_CTL, 0, CTL_ZERO_BYTES, stream) != hipSuccess) return;
    Args a{};
    for (int i = 0; i < 14; ++i) a.in[i] = (const float*)d_in[i];
    a.out = (float*)d_out; a.ws = (unsigned char*)d_ws;
#if MK_ONE_LAUNCH
    a.ph_lo = 0; a.ph_hi = N_PHASES;
    hipLaunchKernelGGL(mk_fwd, dim3(grid), dim3(NWAVES * 64), LDS_BYTES, stream, a);
#else
    for (int p = 0; p < N_PHASES; ++p) { a.ph_lo = p; a.ph_hi = p + 1; hipLaunchKernelGGL(mk_fwd, dim3(grid), dim3(NWAVES * 64), LDS_BYTES, stream, a); }
#endif
}
```

```cpp
#include <hip/hip_runtime.h>
#include <cstdio>
#include <cstdint>

#define LAS __attribute__((address_space(3)))
#define GAS __attribute__((address_space(1)))
typedef unsigned short bf16_t;
typedef short bf16x8 __attribute__((ext_vector_type(8)));
typedef short s16x4 __attribute__((ext_vector_type(4)));
typedef float f32x4 __attribute__((ext_vector_type(4)));
typedef float f32x2 __attribute__((ext_vector_type(2)));
typedef float f32x16 __attribute__((ext_vector_type(16)));
typedef unsigned u32x4 __attribute__((ext_vector_type(4)));
typedef unsigned u32x2 __attribute__((ext_vector_type(2)));
typedef int i32x4 __attribute__((ext_vector_type(4)));

constexpr int BATCH = 8, SEQ = 2048, DM = 2048, DEPTH = 2, MTOK = BATCH * SEQ;
constexpr int HD = 128, WA = 1536, WB = 1024, NIN = 11776;
constexpr int NEXP = 16, FF = 512, ECAP = 16384;
constexpr float LN_EPS = 1e-5f;
constexpr float ALPHA = 1.4142135623730951f;
constexpr float LOG2E = 1.4426950408889634f;
constexpr float QK_C2 = 0.08838834764831845f * LOG2E;

__device__ __forceinline__ unsigned cvt_pk_bf16(float lo, float hi) { unsigned r; asm volatile("v_cvt_pk_bf16_f32 %0, %1, %2" : "=v"(r) : "v"(lo), "v"(hi)); return r; }
__device__ __forceinline__ float bf_lo(unsigned w) { return __uint_as_float(w << 16); }
__device__ __forceinline__ float bf_hi(unsigned w) { return __uint_as_float(w & 0xffff0000u); }
__device__ __forceinline__ float sigmoidf_fast(float x) { return __builtin_amdgcn_rcpf(1.0f + __builtin_amdgcn_exp2f(-x * LOG2E)); }

namespace pg8 {
constexpr int BM = 256, BK = 64, HALF = 128, HTB = HALF * BK * 2, STAGE_BYTES = 8 * HTB, NXCD = 8, WGM = 8;
__host__ __device__ __forceinline__ int lds_byte(int r, int c) { const int st = (r >> 4) * 2 + (c >> 5), rr = r & 15, cc = c & 31, ob = rr * 64 + cc * 2; return st * 1024 + (ob ^ (((ob >> 9) & 1) << 5)); }
__host__ __device__ __forceinline__ void stage_rc(int b, int& R, int& C) { const int st = b / 1024, sb = b % 1024, swz = sb ^ (((sb >> 9) & 1) << 5); R = (st >> 1) * 16 + swz / 64; C = (st & 1) * 32 + (swz % 64) / 2; }
__host__ __device__ __forceinline__ int perm32(int rho) { const int n = rho >> 4, i = rho & 15; return 8 * (i >> 2) + 4 * n + (i & 3); }

struct Unit { int pm, pn, pb, e, r0; };
struct Gemm { const bf16_t* A; const bf16_t* Bt; int K; };

struct StaticOrder {
    int nM, nN, nwg, G, c;
    __device__ void init(int M, int N, int G_, int c_) { nM = M / BM; nN = N / BM; nwg = nM * nN; G = G_; c = c_; }
    __device__ bool next(int i, Unit& u) const {
        const long L = (long)i * G + c; if (L >= nwg) return false;
        int wgid = (int)L; { const int q = nwg / NXCD, r = nwg % NXCD, xcd = wgid % NXCD, off = wgid / NXCD; wgid = (xcd < r ? xcd * (q + 1) : r * (q + 1) + (xcd - r) * q) + off; }
        const int nig = WGM * nN, gid = wgid / nig, fm = gid * WGM, gsz = (nM - fm) < WGM ? (nM - fm) : WGM;
        u.pm = fm + ((wgid % nig) % gsz); u.pn = (wgid % nig) / gsz; u.pb = u.pn; u.e = 0; u.r0 = 0; return true;
    }
    __device__ __forceinline__ int tok(const Unit&, int) const { return 0; }
};
struct MoeOrder {
    int nct, G, c, total; const LAS int* tb; const LAS int* cnt; const int* list;
    __device__ bool next(int i, Unit& u) const {
        const long L = (long)i * G + c; if (L >= total) return false;
        const int rt = (int)L / nct, ct = (int)L % nct; const int e = __builtin_amdgcn_readfirstlane(tb[64 + rt]);
        u.pm = rt; u.pn = ct; u.pb = e * nct + ct; u.e = e; u.r0 = (rt - __builtin_amdgcn_readfirstlane(tb[e])) * BM; return true;
    }
    __device__ __forceinline__ int tok(const Unit& u, int row) const { const int cn = cnt[u.e]; int pos = u.r0 + row; pos = pos < cn ? pos : cn - 1; return list[u.e * ECAP + pos]; }
};

template <class Epi, class Sched, bool ALIGN_EPI, bool GATHER, bool I8 = false>
__device__ __forceinline__ void gemm_phase(LAS unsigned char* lds, const Gemm g, const Sched& S, const Epi& E) {
    int tid = threadIdx.x; asm volatile("" : "+v"(tid));
    const int wid = __builtin_amdgcn_readfirstlane(tid >> 6), lane = tid & 63, wr = wid >> 2, wc = wid & 3, fr = lane & 15, fq = lane >> 4;
    const int K = g.K, nt = K / BK;
    const size_t kstep = (size_t)(BK * 2);
    const size_t hstep = (size_t)HALF * K * 2;
    const size_t tstep = 2 * hstep;
    int RA[2], CA[2]; unsigned voffB[2];
#pragma unroll
    for (int i = 0; i < 2; ++i) { int R, C; stage_rc(tid * 16 + i * 8192, R, C); const int Rb = Epi::PERM ? ((R & ~31) + perm32(R & 31)) : R; RA[i] = R; CA[i] = C; voffB[i] = (unsigned)(Rb * K + C) * 2u; }
    const unsigned ldsw = (unsigned)wid * 1024u;
    const int aoff = lds_byte(wr * 64 + fr, fq * 8), boff = lds_byte(wc * 32 + fr, fq * 8);
#define PG8_SA(b, h) (((b) * 2 + (h)) * HTB)
#define PG8_SB(b, h) ((4 + (b) * 2 + (h)) * HTB)
#define PG8_STAGE(bufoff, gbase, v0, v1) do { \
        __builtin_amdgcn_global_load_lds((const unsigned*)((const char*)(gbase) + (v0)), (LAS unsigned*)(lds + (bufoff) + ldsw), 16, 0, 0); \
        __builtin_amdgcn_global_load_lds((const unsigned*)((const char*)(gbase) + (v1)), (LAS unsigned*)(lds + (bufoff) + ldsw + 8192), 16, 0, 0); } while (0)
#define PG8_LDA(dst, b, h) do { _Pragma("unroll") for (int m = 0; m < 4; ++m) _Pragma("unroll") for (int k = 0; k < 2; ++k) dst[m][k] = *(const LAS bf16x8*)(lds + PG8_SA(b, h) + aoff + m * 2048 + k * 1024); } while (0)
#define PG8_LDB(dst, b, h) do { _Pragma("unroll") for (int n = 0; n < 2; ++n) _Pragma("unroll") for (int k = 0; k < 2; ++k) dst[n][k] = *(const LAS bf16x8*)(lds + PG8_SB(b, h) + boff + n * 2048 + k * 1024); } while (0)
#define PG8_MMA(ai, bj, At, Bt) do { __builtin_amdgcn_s_setprio(1); _Pragma("unroll") for (int m = 0; m < 4; ++m) _Pragma("unroll") for (int n = 0; n < 2; ++n) _Pragma("unroll") for (int k = 0; k < 2; ++k) { \
        if constexpr (I8) acc[ai][bj][m][n] = __builtin_bit_cast(AccT, __builtin_amdgcn_mfma_i32_16x16x64_i8(__builtin_bit_cast(i32x4, Bt[n][k]), __builtin_bit_cast(i32x4, At[m][k]), __builtin_bit_cast(i32x4, acc[ai][bj][m][n]), 0, 0, 0)); \
        else acc[ai][bj][m][n] = __builtin_bit_cast(AccT, __builtin_amdgcn_mfma_f32_16x16x32_bf16(Bt[n][k], At[m][k], __builtin_bit_cast(f32x4, acc[ai][bj][m][n]), 0, 0, 0)); } __builtin_amdgcn_s_setprio(0); } while (0)
#define PG8_WAIT_V(n) asm volatile("s_waitcnt vmcnt(" #n ")" ::: "memory")
#define PG8_WAIT_L(n) asm volatile("s_waitcnt lgkmcnt(" #n ")" ::: "memory")
#define PG8_BAR __builtin_amdgcn_s_barrier()
#define PG8_SCHED __builtin_amdgcn_sched_barrier(0)
    Unit cur, nxt; int ui = 0;
    if (!S.next(0, cur)) return;
    typedef typename Epi::AccT AccT;
    AccT acc[2][2][4][2];
#pragma unroll
    for (int a = 0; a < 2; ++a)
#pragma unroll
        for (int b = 0; b < 2; ++b)
#pragma unroll
            for (int m = 0; m < 4; ++m)
#pragma unroll
                for (int n = 0; n < 2; ++n) acc[a][b][m][n] = AccT{};
    bf16x8 At[4][2], B0[2][2], B1[2][2];
    unsigned c00, c01, c10, c11, n00, n01, n10, n11;
    if constexpr (GATHER) {
        c00 = (unsigned)(S.tok(cur, RA[0]) * K + CA[0]) * 2u; c01 = (unsigned)(S.tok(cur, RA[1]) * K + CA[1]) * 2u;
        c10 = (unsigned)(S.tok(cur, HALF + RA[0]) * K + CA[0]) * 2u; c11 = (unsigned)(S.tok(cur, HALF + RA[1]) * K + CA[1]) * 2u;
    } else {
        c00 = (unsigned)(RA[0] * K + CA[0]) * 2u; c01 = (unsigned)(RA[1] * K + CA[1]) * 2u; c10 = c00 + (unsigned)hstep; c11 = c01 + (unsigned)hstep;
    }
    n00 = c00; n01 = c01; n10 = c10; n11 = c11;
    const char* cA = GATHER ? (const char*)g.A : (const char*)g.A + (size_t)cur.pm * tstep; const char* cB = (const char*)g.Bt + (size_t)cur.pb * tstep;
    PG8_STAGE(PG8_SB(0, 0), cB, voffB[0], voffB[1]); PG8_STAGE(PG8_SB(0, 1), cB + hstep, voffB[0], voffB[1]); PG8_STAGE(PG8_SA(0, 0), cA, c00, c01); PG8_STAGE(PG8_SA(0, 1), cA, c10, c11);
    if (wr == 1) PG8_BAR;
    PG8_WAIT_V(2); PG8_BAR;
    PG8_STAGE(PG8_SB(1, 0), cB + kstep, voffB[0], voffB[1]); PG8_STAGE(PG8_SA(1, 0), cA + kstep, c00, c01); PG8_STAGE(PG8_SB(1, 1), cB + hstep + kstep, voffB[0], voffB[1]);
    PG8_WAIT_V(6); PG8_BAR;
    for (;;) {
        const bool has_next = S.next(ui + 1, nxt);
        const char* nA = has_next ? (GATHER ? (const char*)g.A : (const char*)g.A + (size_t)nxt.pm * tstep) : cA; const char* nB = has_next ? (const char*)g.Bt + (size_t)nxt.pb * tstep : cB;
        if constexpr (GATHER) {
            if (has_next) {
                n00 = (unsigned)(S.tok(nxt, RA[0]) * K + CA[0]) * 2u; n01 = (unsigned)(S.tok(nxt, RA[1]) * K + CA[1]) * 2u;
                n10 = (unsigned)(S.tok(nxt, HALF + RA[0]) * K + CA[0]) * 2u; n11 = (unsigned)(S.tok(nxt, HALF + RA[1]) * K + CA[1]) * 2u;
            } else { n00 = c00; n01 = c01; n10 = c10; n11 = c11; }
        }
        for (int t = 0; t < nt; t += 2) {
            const bool last = (t == nt - 2);
            const char* a1 = cA + (size_t)(t + 1) * kstep;
            const char* a2 = last ? nA : cA + (size_t)(t + 2) * kstep; const char* b2 = last ? nB : cB + (size_t)(t + 2) * kstep;
            const char* a3 = a2 + kstep; const char* b3 = b2 + kstep;
            const unsigned o00 = last ? n00 : c00, o01 = last ? n01 : c01, o10 = last ? n10 : c10, o11 = last ? n11 : c11;
            PG8_LDB(B0, 0, 0); PG8_LDB(B1, 0, 1); PG8_SCHED; PG8_LDA(At, 0, 0); PG8_STAGE(PG8_SA(1, 1), a1, c10, c11);
            PG8_WAIT_V(8); PG8_WAIT_L(0); PG8_BAR; PG8_MMA(0, 0, At, B0); PG8_MMA(0, 1, At, B1); PG8_BAR; PG8_SCHED;
            PG8_LDA(At, 0, 1); PG8_STAGE(PG8_SB(0, 0), b2, voffB[0], voffB[1]); PG8_STAGE(PG8_SB(0, 1), b2 + hstep, voffB[0], voffB[1]); PG8_STAGE(PG8_SA(0, 0), a2, o00, o01);
            PG8_WAIT_V(8); PG8_WAIT_L(0); PG8_BAR; PG8_MMA(1, 0, At, B0); PG8_MMA(1, 1, At, B1); PG8_BAR; PG8_SCHED;
            PG8_LDB(B0, 1, 0); PG8_LDB(B1, 1, 1); PG8_SCHED; PG8_LDA(At, 1, 0); PG8_STAGE(PG8_SA(0, 1), a2, o10, o11);
            PG8_WAIT_V(8); PG8_WAIT_L(0); PG8_BAR; PG8_MMA(0, 0, At, B0); PG8_MMA(0, 1, At, B1); PG8_BAR; PG8_SCHED;
            PG8_LDA(At, 1, 1); PG8_STAGE(PG8_SB(1, 0), b3, voffB[0], voffB[1]); PG8_STAGE(PG8_SB(1, 1), b3 + hstep, voffB[0], voffB[1]); PG8_STAGE(PG8_SA(1, 0), a3, o00, o01);
            PG8_WAIT_V(8); PG8_WAIT_L(0); PG8_BAR; PG8_MMA(1, 0, At, B0); PG8_MMA(1, 1, At, B1); PG8_BAR; PG8_SCHED;
        }
        if constexpr (ALIGN_EPI) { if (wr == 0) PG8_BAR; }
        E(acc, cur, wr, wc, fr, fq);
        if (!has_next) break;
#pragma unroll
        for (int a = 0; a < 2; ++a)
#pragma unroll
            for (int b = 0; b < 2; ++b)
#pragma unroll
                for (int m = 0; m < 4; ++m)
#pragma unroll
                    for (int n = 0; n < 2; ++n) acc[a][b][m][n] = AccT{};
        cur = nxt; cA = nA; cB = nB; ++ui; c00 = n00; c01 = n01; c10 = n10; c11 = n11;
        if constexpr (ALIGN_EPI) { if (wr == 1) PG8_BAR; }
    }
    PG8_WAIT_V(0);
    if constexpr (!ALIGN_EPI) { if (wr == 0) PG8_BAR; }
    PG8_BAR;
#undef PG8_SA
#undef PG8_SB
#undef PG8_STAGE
#undef PG8_LDA
#undef PG8_LDB
#undef PG8_MMA
#undef PG8_WAIT_V
#undef PG8_WAIT_L
#undef PG8_BAR
#undef PG8_SCHED
}
}
namespace pg8 {
struct EpiProj {
    static constexpr bool PERM = true; typedef i32x4 AccT;
    bf16_t* qkv;
    bf16_t* gates;
    const float* rope;
    const float* sa;
    const float* sb;
    __device__ __forceinline__ void operator()(const i32x4 (&acc)[2][2][4][2], const Unit& u, int wr, int wc, int fr, int fq) const {
        const int pn = u.pn; bf16_t* base; int ldc, ct0;
        if (pn < 18) { const int t = pn / 6; base = qkv + (size_t)t * MTOK * WA; ldc = WA; ct0 = t * 6; }
        else if (pn < 30) { const int t = (pn - 18) / 4; base = qkv + (size_t)3 * MTOK * WA + (size_t)t * MTOK * WB; ldc = WB; ct0 = 18 + t * 4; }
        else { const int t = (pn - 30) / 8; base = gates + (size_t)t * MTOK * DM; ldc = DM; ct0 = 30 + t * 8; }
        const int row0 = u.pm * BM + wr * 64 + fr, col0 = (pn - ct0) * BM + wc * 32 + 8 * fq, bcol0 = pn * BM + wc * 32 + 8 * fq;
        const bool do_rope = (pn < 12) && (wc == 0);
        f32x4 sbv[2][2];
#pragma unroll
        for (int bj = 0; bj < 2; ++bj)
#pragma unroll
            for (int n = 0; n < 2; ++n) sbv[bj][n] = *(const f32x4*)(sb + bcol0 + bj * HALF + 4 * n);
#pragma unroll
        for (int ai = 0; ai < 2; ++ai)
#pragma unroll
            for (int m = 0; m < 4; ++m) { const int row = row0 + ai * HALF + m * 16; bf16_t* rowp = base + (size_t)row * ldc + col0;
                const float sar = sa[row];
                f32x4 cs = (f32x4){1.f, 1.f, 1.f, 1.f}, sn = (f32x4){0.f, 0.f, 0.f, 0.f};
                if (do_rope) { cs = *(const f32x4*)(rope + (size_t)row * 32 + 4 * fq); sn = *(const f32x4*)(rope + (size_t)row * 32 + 16 + 4 * fq); }
#pragma unroll
                for (int bj = 0; bj < 2; ++bj) { f32x4 v0 = __builtin_convertvector(acc[ai][bj][m][0], f32x4) * (sbv[bj][0] * sar), v1 = __builtin_convertvector(acc[ai][bj][m][1], f32x4) * (sbv[bj][1] * sar);
                    if (do_rope) { const f32x4 y0 = v0 * cs - v1 * sn, y1 = v1 * cs + v0 * sn; v0 = y0; v1 = y1; }
                    u32x4 w; w.x = cvt_pk_bf16(v0[0], v0[1]); w.y = cvt_pk_bf16(v0[2], v0[3]); w.z = cvt_pk_bf16(v1[0], v1[1]); w.w = cvt_pk_bf16(v1[2], v1[3]);
                    *(u32x4*)(rowp + bj * HALF) = w; }
                asm volatile("" ::: "memory"); }
    }
};
struct EpiBf16 {
    static constexpr bool PERM = true; typedef f32x4 AccT;
    bf16_t* O; int ldc;
    __device__ __forceinline__ void operator()(const f32x4 (&acc)[2][2][4][2], const Unit& u, int wr, int wc, int fr, int fq) const {
        const int row0 = u.pm * BM + wr * 64 + fr, col0 = u.pn * BM + wc * 32 + 8 * fq;
#pragma unroll
        for (int ai = 0; ai < 2; ++ai)
#pragma unroll
            for (int m = 0; m < 4; ++m) { bf16_t* rowp = O + (size_t)(row0 + ai * HALF + m * 16) * ldc + col0;
#pragma unroll
                for (int bj = 0; bj < 2; ++bj) { const f32x4 v0 = acc[ai][bj][m][0], v1 = acc[ai][bj][m][1];
                    u32x4 w; w.x = cvt_pk_bf16(v0[0], v0[1]); w.y = cvt_pk_bf16(v0[2], v0[3]); w.z = cvt_pk_bf16(v1[0], v1[1]); w.w = cvt_pk_bf16(v1[2], v1[3]);
                    *(u32x4*)(rowp + bj * HALF) = w; } }
    }
};
template <bool SECOND> struct EpiGate {
    static constexpr bool PERM = true; typedef f32x4 AccT;
    const bf16_t* gate; bf16_t* P1; bf16_t* out;
    __device__ __forceinline__ void operator()(const f32x4 (&acc)[2][2][4][2], const Unit& u, int wr, int wc, int fr, int fq) const {
        const int row0 = u.pm * BM + wr * 64 + fr, col0 = u.pn * BM + wc * 32 + 8 * fq;
#pragma unroll
        for (int ai = 0; ai < 2; ++ai)
#pragma unroll
            for (int m = 0; m < 4; ++m) { const size_t off = (size_t)(row0 + ai * HALF + m * 16) * DM + col0;
#pragma unroll
                for (int bj = 0; bj < 2; ++bj) { const f32x4 v0 = acc[ai][bj][m][0], v1 = acc[ai][bj][m][1];
                    const u32x4 gw = *(const u32x4*)(gate + off + bj * HALF);
                    float r[8];
                    r[0] = sigmoidf_fast(bf_lo(gw.x)) * v0[0]; r[1] = sigmoidf_fast(bf_hi(gw.x)) * v0[1]; r[2] = sigmoidf_fast(bf_lo(gw.y)) * v0[2]; r[3] = sigmoidf_fast(bf_hi(gw.y)) * v0[3];
                    r[4] = sigmoidf_fast(bf_lo(gw.z)) * v1[0]; r[5] = sigmoidf_fast(bf_hi(gw.z)) * v1[1]; r[6] = sigmoidf_fast(bf_lo(gw.w)) * v1[2]; r[7] = sigmoidf_fast(bf_hi(gw.w)) * v1[3];
                    if (SECOND) { const u32x4 pw = *(const u32x4*)(P1 + off + bj * HALF);
                        r[0] += bf_lo(pw.x); r[1] += bf_hi(pw.x); r[2] += bf_lo(pw.y); r[3] += bf_hi(pw.y); r[4] += bf_lo(pw.z); r[5] += bf_hi(pw.z); r[6] += bf_lo(pw.w); r[7] += bf_hi(pw.w); }
                    u32x4 w; w.x = cvt_pk_bf16(r[0], r[1]); w.y = cvt_pk_bf16(r[2], r[3]); w.z = cvt_pk_bf16(r[4], r[5]); w.w = cvt_pk_bf16(r[6], r[7]);
                    *(u32x4*)((SECOND ? out : P1) + off + bj * HALF) = w; }
                asm volatile("" ::: "memory"); }
    }
};
struct EpiResid {
    static constexpr bool PERM = true; typedef f32x4 AccT;
    const bf16_t* h; bf16_t* z;
    __device__ __forceinline__ void operator()(const f32x4 (&acc)[2][2][4][2], const Unit& u, int wr, int wc, int fr, int fq) const {
        const int row0 = u.pm * BM + wr * 64 + fr, col0 = u.pn * BM + wc * 32 + 8 * fq;
#pragma unroll
        for (int ai = 0; ai < 2; ++ai)
#pragma unroll
            for (int m = 0; m < 4; ++m) { const size_t off = (size_t)(row0 + ai * HALF + m * 16) * DM + col0;
#pragma unroll
                for (int bj = 0; bj < 2; ++bj) { const f32x4 v0 = acc[ai][bj][m][0], v1 = acc[ai][bj][m][1];
                    const u32x4 hw = *(const u32x4*)(h + off + bj * HALF);
                    u32x4 w; w.x = cvt_pk_bf16(ALPHA * bf_lo(hw.x) + v0[0], ALPHA * bf_hi(hw.x) + v0[1]); w.y = cvt_pk_bf16(ALPHA * bf_lo(hw.y) + v0[2], ALPHA * bf_hi(hw.y) + v0[3]);
                    w.z = cvt_pk_bf16(ALPHA * bf_lo(hw.z) + v1[0], ALPHA * bf_hi(hw.z) + v1[1]); w.w = cvt_pk_bf16(ALPHA * bf_lo(hw.w) + v1[2], ALPHA * bf_hi(hw.w) + v1[3]);
                    *(u32x4*)(z + off + bj * HALF) = w; }
                asm volatile("" ::: "memory"); }
    }
};
struct EpiSwiglu {
    static constexpr bool PERM = true; typedef f32x4 AccT;
    bf16_t* Hd;
    __device__ __forceinline__ void operator()(const f32x4 (&acc)[2][2][4][2], const Unit& u, int wr, int wc, int fr, int fq) const {
        const int row0 = u.pm * BM + wr * 64 + fr, col0 = u.pn * HALF + wc * 32 + 8 * fq;
#pragma unroll
        for (int ai = 0; ai < 2; ++ai)
#pragma unroll
            for (int m = 0; m < 4; ++m) { bf16_t* rowp = Hd + (size_t)(row0 + ai * HALF + m * 16) * FF + col0;
                float r[8];
#pragma unroll
                for (int n = 0; n < 2; ++n)
#pragma unroll
                    for (int j = 0; j < 4; ++j) { const float a = acc[ai][0][m][n][j], b = acc[ai][1][m][n][j]; r[4 * n + j] = a * sigmoidf_fast(a) * b; }
                u32x4 w; w.x = cvt_pk_bf16(r[0], r[1]); w.y = cvt_pk_bf16(r[2], r[3]); w.z = cvt_pk_bf16(r[4], r[5]); w.w = cvt_pk_bf16(r[6], r[7]);
                *(u32x4*)rowp = w; }
    }
};
}
namespace att {
#define SBAR() __builtin_amdgcn_sched_barrier(0)
#define KSWZ(row, colB) ((row) * 256 + ((colB) ^ (((row) & 7) << 4)))
__device__ __forceinline__ int v_st(int k, int c) { const int kk = (k & ~0xC) | ((k & 4) << 1) | ((k & 8) >> 1); return ((kk >> 3) * 4 + (c >> 5)) * 512 + ((kk & 7) * 32 + (c & 31)) * 2; }
__device__ __forceinline__ int v_rd_base(int lane) { return ((lane & 3) << 3) | (((lane >> 2) & 3) << 6) | (((lane >> 4) & 1) << 5) | (((lane >> 5) & 1) << 8); }
__device__ __forceinline__ int crow(int r, int hi) { return (r & 3) + 8 * (r >> 2) + 4 * hi; }
__device__ __forceinline__ float partner_f(float x, int hi) { auto rr = __builtin_amdgcn_permlane32_swap(__float_as_uint(x), __float_as_uint(x), false, false); return __uint_as_float(hi ? rr[0] : rr[1]); }
#define PK4(P, B_, OUT) do { unsigned a0 = cvt_pk_bf16(P[B_+0], P[B_+1]), a1 = cvt_pk_bf16(P[B_+2], P[B_+3]);                          \
        unsigned b0 = cvt_pk_bf16(P[B_+4], P[B_+5]), b1 = cvt_pk_bf16(P[B_+6], P[B_+7]);                                             \
        auto r0 = __builtin_amdgcn_permlane32_swap(a0, b0, false, false); auto r1 = __builtin_amdgcn_permlane32_swap(a1, b1, false, false); \
        u32x4 w = {r0[0], r1[0], r0[1], r1[1]}; OUT = *reinterpret_cast<bf16x8*>(&w); } while (0)
#define TRRD(dst, addr, off) asm volatile("ds_read_b64_tr_b16 %0, %1 offset:%2" : "=&v"(dst) : "v"(addr), "i"(off) : "memory")

__device__ __forceinline__ void qkt32(f32x16& p, unsigned kaddr, int r32, int hi, const bf16x8* qr) {
    p = f32x16{};
    unsigned kb[4];
#pragma unroll
    for (int dd = 0; dd < 4; ++dd) kb[dd] = kaddr + KSWZ(r32, (dd * 16 + hi * 8) * 2);
#pragma unroll
    for (int d0 = 0; d0 < 8; ++d0) { const bf16x8 b0 = *(const LAS bf16x8*)(uintptr_t)(kb[d0 & 3] + (d0 >> 2) * 128);
        p = __builtin_amdgcn_mfma_f32_32x32x16_bf16(b0, qr[d0], p, 0, 0, 0); }
}
__device__ __forceinline__ void pv32(f32x16* o, unsigned vaddr, bf16x8 pa0, bf16x8 pa1) {
#define PV_D2(d0) do { s16x4 l0, l1, h0, h1, m0, m1, n0, n1; constexpr int b_ = (d0) * 512; \
        TRRD(l0, vaddr, b_); TRRD(h0, vaddr, b_ + 2048); TRRD(l1, vaddr, b_ + 4096); TRRD(h1, vaddr, b_ + 6144); \
        TRRD(m0, vaddr, b_ + 512); TRRD(n0, vaddr, b_ + 512 + 2048); TRRD(m1, vaddr, b_ + 512 + 4096); TRRD(n1, vaddr, b_ + 512 + 6144); \
        asm volatile("s_waitcnt lgkmcnt(0)" ::: "memory"); SBAR(); \
        o[d0] = __builtin_amdgcn_mfma_f32_32x32x16_bf16(pa0, (bf16x8){l0[0], l0[1], l0[2], l0[3], h0[0], h0[1], h0[2], h0[3]}, o[d0], 0, 0, 0); \
        o[d0 + 1] = __builtin_amdgcn_mfma_f32_32x32x16_bf16(pa0, (bf16x8){m0[0], m0[1], m0[2], m0[3], n0[0], n0[1], n0[2], n0[3]}, o[d0 + 1], 0, 0, 0); \
        o[d0] = __builtin_amdgcn_mfma_f32_32x32x16_bf16(pa1, (bf16x8){l1[0], l1[1], l1[2], l1[3], h1[0], h1[1], h1[2], h1[3]}, o[d0], 0, 0, 0); \
        o[d0 + 1] = __builtin_amdgcn_mfma_f32_32x32x16_bf16(pa1, (bf16x8){m1[0], m1[1], m1[2], m1[3], n1[0], n1[1], n1[2], n1[3]}, o[d0 + 1], 0, 0, 0); } while (0)
    PV_D2(0); PV_D2(2);
#undef PV_D2
}
template <class RowPtr>
__device__ __forceinline__ void store_o_bf16(const f32x16* o, const float* rscale, int r32, int hi, const RowPtr& rowp) {
#pragma unroll
    for (int r = 0; r < 16; ++r) { bf16_t* rp = rowp(crow(r, hi));
#pragma unroll
        for (int d0 = 0; d0 < 4; ++d0) { const float v = o[d0][r] * rscale[r]; const float vn = __shfl_xor(v, 1);
            if ((r32 & 1) == 0) *(unsigned*)(rp + d0 * 32 + r32) = cvt_pk_bf16(v, vn); } }
}

template <bool MASK>
__device__ __forceinline__ void sb_half(f32x16& p, float& C, int dq, int hi) {
    float om[16];
#pragma unroll
    for (int r = 0; r < 16; ++r) {
        const float e = __builtin_amdgcn_exp2f(p[r] * -QK_C2); float b = __builtin_amdgcn_rcpf(1.0f + e); float o = 1.0f - b;
        if (MASK) { const bool v = ((r & 3) + 8 * (r >> 2)) < dq; b = v ? b : 0.f; o = v ? o : 1.f; }
        p[r] = b; om[r] = o; }
    float g[4], pg[4], eh[4];
#pragma unroll
    for (int c = 0; c < 4; ++c) { g[c] = (om[4 * c] * om[4 * c + 1]) * (om[4 * c + 2] * om[4 * c + 3]); pg[c] = partner_f(g[c], hi); }
    eh[3] = C; eh[2] = eh[3] * (g[3] * pg[3]); eh[1] = eh[2] * (g[2] * pg[2]); eh[0] = eh[1] * (g[1] * pg[1]); C = eh[0] * (g[0] * pg[0]);
#pragma unroll
    for (int c = 3; c >= 0; --c) { float E = hi ? eh[c] : eh[c] * pg[c];
#pragma unroll
        for (int r = 4 * c + 3; r >= 4 * c; --r) { p[r] *= E; E *= om[r]; } }
}

struct SbTensors { const bf16_t* Q; const bf16_t* K; const bf16_t* V; bf16_t* O; };
__device__ __forceinline__ void sb_unit(const SbTensors& T, int b, int head, int qb, LAS unsigned char* lds) {
    int tid = threadIdx.x; asm volatile("" : "+v"(tid));
    const int wid = __builtin_amdgcn_readfirstlane(tid >> 6), lane = tid & 63, r32 = lane & 31, hi = lane >> 5;
    const size_t rowbase = (size_t)b * SEQ;
    const int q0 = qb * 256 + wid * 32;
    const int tq = q0 + r32;
    bf16x8 qr[8];
    { const bf16_t* qp = T.Q + (rowbase + tq) * WB + head * HD + hi * 8;
#pragma unroll
      for (int d0 = 0; d0 < 8; ++d0) qr[d0] = *(const bf16x8*)(qp + d0 * 16); }
    const bf16_t* Kh = T.K + rowbase * WB + head * HD; const bf16_t* Vh = T.V + rowbase * WB + head * HD;
    const int sr = tid >> 4, sc = (tid & 15) * 8;
    const int kws = KSWZ(sr, sc * 2), vst0 = v_st(sr, sc), vst1 = v_st(32 + sr, sc);
    const unsigned Kl = (unsigned)(uintptr_t)lds, Vl = Kl + 32768u, vrb = (unsigned)v_rd_base(lane);
    f32x16 o[4] = {}; float C = 1.0f;
    const int NT = 4 * qb + 4;
    bf16x8 sk0, sk1, sv0, sv1;
#define SB_LOAD(jt) do { const bf16_t* kp = Kh + (size_t)((jt) * 64 + sr) * WB + sc; const bf16_t* vp = Vh + (size_t)((jt) * 64 + sr) * WB + sc; \
        sk0 = *(const bf16x8*)kp; sk1 = *(const bf16x8*)(kp + 32 * WB); sv0 = *(const bf16x8*)vp; sv1 = *(const bf16x8*)(vp + 32 * WB); } while (0)
#define SB_WRITE(bf) do { *(LAS bf16x8*)(lds + (bf) * 16384 + kws) = sk0; *(LAS bf16x8*)(lds + (bf) * 16384 + kws + 32 * 256) = sk1; \
        *(LAS bf16x8*)(lds + 32768 + (bf) * 16384 + vst0) = sv0; *(LAS bf16x8*)(lds + 32768 + (bf) * 16384 + vst1) = sv1; } while (0)
    SB_LOAD(NT - 1); SB_WRITE(0);
    __syncthreads();
    for (int it = 0; it < NT; ++it) {
        const int jt = NT - 1 - it, bf = it & 1, kb = jt * 64;
        if (it + 1 < NT) SB_LOAD(jt - 1);
        if (kb <= q0 + 30) {
            const unsigned ka = Kl + bf * 16384u, va = Vl + bf * 16384u + vrb;
            f32x16 p0, p1; bf16x8 pa0, pa1, pa2, pa3;
            qkt32(p0, ka, r32, hi, qr); qkt32(p1, ka + 32 * 256, r32, hi, qr);
            if (kb + 63 >= q0) { sb_half<true>(p1, C, tq - kb - 32 - 4 * hi, hi); sb_half<true>(p0, C, tq - kb - 4 * hi, hi); }
            else { sb_half<false>(p1, C, 0, hi); sb_half<false>(p0, C, 0, hi); }
            PK4(p0, 0, pa0); PK4(p0, 8, pa1); PK4(p1, 0, pa2); PK4(p1, 8, pa3);
            pv32(o, va, pa0, pa1); pv32(o, va + 8192, pa2, pa3);
        }
        if (it + 1 < NT) SB_WRITE(bf ^ 1);
        __syncthreads();
    }
#undef SB_LOAD
#undef SB_WRITE
    float ones[16];
#pragma unroll
    for (int r = 0; r < 16; ++r) ones[r] = 1.0f;
    bf16_t* Ob = T.O + (rowbase + q0) * WB + head * HD;
    store_o_bf16(o, ones, r32, hi, [&](int row) { return Ob + (size_t)row * WB; });
}

struct DaTensors { const bf16_t* Q; const bf16_t* K; const bf16_t* V; bf16_t* PO; float* PL; };
__device__ __forceinline__ void da_job(const DaTensors& T, int b, int h, int g, int rho, int u0, LAS unsigned char* wl, LAS float* ws) {
    int lane = threadIdx.x & 63; asm volatile("" : "+v"(lane));
    const int r32 = lane & 31, hi = lane >> 5;
    const int dsh = 2 * g, dil = 1 << dsh;
    const size_t rowbase = (size_t)b * SEQ; const int colh = g * 512 + h * HD;
    bf16x8 qr[8];
    { const bf16_t* qp = T.Q + (rowbase + (size_t)(((u0 + r32) << dsh) + rho)) * WA + colh + hi * 8;
#pragma unroll
      for (int d0 = 0; d0 < 8; ++d0) qr[d0] = *(const bf16x8*)(qp + d0 * 16); }
    const unsigned Kl = (unsigned)(uintptr_t)wl, Vl = Kl + 8192u + (unsigned)v_rd_base(lane);
    LAS float* al_l = ws; LAS float* li_l = ws + 32;
    f32x16 o[4] = {}; float m_reg = -1e30f, l_reg = 0.f;
    const int srow = lane >> 4, sc = (lane & 15) * 8;
    int tau0 = (128 - u0 + 31) >> 5; if (tau0 < 0) tau0 = 0;
    bf16x8 kk[8], vv[8];
#define DA_LOAD(tau_) do { const int ub_ = u0 - 128 + 32 * (tau_); _Pragma("unroll") for (int c = 0; c < 8; ++c) { const int ki = srow + 4 * c; \
        const size_t ro = (rowbase + (size_t)(((ub_ + ki) << dsh) + rho)) * WA + colh + sc; kk[c] = *(const bf16x8*)(T.K + ro); vv[c] = *(const bf16x8*)(T.V + ro); } } while (0)
    DA_LOAD(tau0);
    for (int tau = tau0; tau < 5; ++tau) {
        const int ub = u0 - 128 + 32 * tau;
#pragma unroll
        for (int c = 0; c < 8; ++c) { const int ki = srow + 4 * c; *(LAS bf16x8*)(wl + KSWZ(ki, sc * 2)) = kk[c]; *(LAS bf16x8*)(wl + 8192 + v_st(ki, sc)) = vv[c]; }
        if (tau + 1 < 5) DA_LOAD(tau + 1);
        asm volatile("s_waitcnt lgkmcnt(0)" ::: "memory"); SBAR();
        f32x16 p; qkt32(p, Kl, r32, hi, qr);
        if (tau == 0 || tau == 4) { const int dq = u0 + r32 - ub - 4 * hi; const float NEG = -__builtin_inff();
#pragma unroll
            for (int r = 0; r < 16; ++r) { const int c = (r & 3) + 8 * (r >> 2); if ((unsigned)(dq - c) >= 129u) p[r] = NEG; } }
        float pmax = p[0];
#pragma unroll
        for (int r = 1; r < 16; ++r) pmax = fmaxf(pmax, p[r]);
        pmax = fmaxf(pmax, partner_f(pmax, hi));
        float alpha = 1.f;
        if (!__all((pmax - m_reg) * QK_C2 <= 8.0f * LOG2E)) {
            const float mn = fmaxf(m_reg, pmax); alpha = __builtin_amdgcn_exp2f((m_reg - mn) * QK_C2); m_reg = mn;
            if (hi == 0) al_l[r32] = alpha; asm volatile("s_waitcnt lgkmcnt(0)" ::: "memory");
#pragma unroll
            for (int r = 0; r < 16; ++r) { const float a = al_l[crow(r, hi)];
#pragma unroll
                for (int d0 = 0; d0 < 4; ++d0) o[d0][r] *= a; }
        }
        const float mnL = -m_reg * QK_C2; float ps = 0.f;
#pragma unroll
        for (int r = 0; r < 16; ++r) { p[r] = __builtin_amdgcn_exp2f(fmaf(p[r], QK_C2, mnL)); ps += p[r]; }
        ps += partner_f(ps, hi);
        l_reg = l_reg * alpha + ps;
        bf16x8 pa0, pa1; PK4(p, 0, pa0); PK4(p, 8, pa1);
        pv32(o, Vl, pa0, pa1);
    }
#undef DA_LOAD
    if (hi == 0) li_l[r32] = l_reg; asm volatile("s_waitcnt lgkmcnt(0)" ::: "memory");
    float rli[16];
#pragma unroll
    for (int r = 0; r < 16; ++r) rli[r] = __builtin_amdgcn_rcpf(li_l[crow(r, hi)]);
    bf16_t* Pg = T.PO + (size_t)g * MTOK * 512 + h * HD;
    store_o_bf16(o, rli, r32, hi, [&](int row) { return Pg + (rowbase + (size_t)(((u0 + row) << dsh) + rho)) * 512; });
    if (hi == 0) T.PL[((size_t)g * MTOK + rowbase + (size_t)(((u0 + r32) << dsh) + rho)) * 4 + h] = m_reg * QK_C2 + __builtin_amdgcn_logf(l_reg);
}
__device__ __forceinline__ void da_unit(const DaTensors& T, bf16_t* OA, int b, int h, int chunk, LAS unsigned char* lds, LAS float* wscr) {
    int tid = threadIdx.x; asm volatile("" : "+v"(tid)); const int wid = __builtin_amdgcn_readfirstlane(tid >> 6);
    for (int jj = 0; jj < 6; ++jj) {
        const int job = wid + 8 * jj, g = job >> 4, idx = job & 15;
        int rho, u0;
        if (g == 0) { rho = 0; u0 = chunk * 512 + 32 * idx; }
        else if (g == 1) { rho = idx >> 2; u0 = chunk * 128 + 32 * (idx & 3); }
        else { rho = idx; u0 = chunk * 32; }
        da_job(T, b, h, g, rho, u0, lds + wid * 16384, wscr + wid * 64);
    }
    asm volatile("s_waitcnt vmcnt(0)" ::: "memory");
    __syncthreads();
    const size_t rowbase = (size_t)b * SEQ + (size_t)chunk * 512;
    for (int it = tid; it < 512 * 16; it += 512) {
        const int tk = it >> 4, ch = it & 15; const size_t row = rowbase + tk;
        const float l0 = T.PL[(0 * (size_t)MTOK + row) * 4 + h], l1 = T.PL[(1 * (size_t)MTOK + row) * 4 + h], l2 = T.PL[(2 * (size_t)MTOK + row) * 4 + h];
        const float mx = fmaxf(l0, fmaxf(l1, l2));
        float w0 = __builtin_amdgcn_exp2f(l0 - mx), w1 = __builtin_amdgcn_exp2f(l1 - mx), w2 = __builtin_amdgcn_exp2f(l2 - mx);
        const float inv = 1.0f / (w0 + w1 + w2); w0 *= inv; w1 *= inv; w2 *= inv;
        const size_t off = row * 512 + h * HD + ch * 8;
        const u32x4 a = *(const u32x4*)(T.PO + off), bq = *(const u32x4*)(T.PO + (size_t)MTOK * 512 + off), c = *(const u32x4*)(T.PO + (size_t)2 * MTOK * 512 + off);
        u32x4 w;
        w.x = cvt_pk_bf16(w0 * bf_lo(a.x) + w1 * bf_lo(bq.x) + w2 * bf_lo(c.x), w0 * bf_hi(a.x) + w1 * bf_hi(bq.x) + w2 * bf_hi(c.x));
        w.y = cvt_pk_bf16(w0 * bf_lo(a.y) + w1 * bf_lo(bq.y) + w2 * bf_lo(c.y), w0 * bf_hi(a.y) + w1 * bf_hi(bq.y) + w2 * bf_hi(c.y));
        w.z = cvt_pk_bf16(w0 * bf_lo(a.z) + w1 * bf_lo(bq.z) + w2 * bf_lo(c.z), w0 * bf_hi(a.z) + w1 * bf_hi(bq.z) + w2 * bf_hi(c.z));
        w.w = cvt_pk_bf16(w0 * bf_lo(a.w) + w1 * bf_lo(bq.w) + w2 * bf_lo(c.w), w0 * bf_hi(a.w) + w1 * bf_hi(bq.w) + w2 * bf_hi(c.w));
        *(u32x4*)(OA + off) = w;
    }
    __syncthreads();
}
#undef SBAR
}
#define MK_ONE_LAUNCH 1
constexpr int NWAVES = 8;
#ifndef MK_ONE_LAUNCH
#define MK_ONE_LAUNCH 1
#endif
constexpr size_t MiB = 1u << 20;
constexpr size_t WS_CTL = 0, CTL_ZERO_BYTES = 1 * MiB;
constexpr size_t WS_ROPE = 2 * MiB;
constexpr size_t WS_WRT = 4 * MiB;
constexpr size_t WS_SA = 4 * MiB + 512 * 1024;
constexpr size_t WS_SB = 4 * MiB + 768 * 1024;
constexpr size_t WS_TOK = 5 * MiB;
constexpr size_t WS_LIST = 6 * MiB;
constexpr size_t WS_PL = 7 * MiB;
constexpr size_t WS_W = 8 * MiB;
constexpr size_t LW_IN = 0, LW_PA = LW_IN + (size_t)NIN * DM * 2, LW_PB = LW_PA + (size_t)DM * 512 * 2, LW_WO = LW_PB + (size_t)DM * 1024 * 2,
                 LW_UP = LW_WO + (size_t)DM * DM * 2, LW_DN = LW_UP + (size_t)NEXP * 1024 * DM * 2, LW_BYTES = LW_DN + (size_t)NEXP * DM * FF * 2;
static_assert(LW_BYTES == 156 * MiB, "weights per layer");
constexpr size_t WS_HB = WS_W + 2 * LW_BYTES;
constexpr size_t WS_OA = WS_HB + 64 * MiB;
constexpr size_t WS_OB = WS_OA + 16 * MiB;
constexpr size_t WS_PO = WS_OB + 32 * MiB;
constexpr size_t WS_GATES = WS_PO + 48 * MiB;
constexpr size_t WS_QKV = WS_GATES + 128 * MiB;
constexpr size_t WS_P1 = WS_QKV;
constexpr size_t WS_Z = WS_P1;
constexpr size_t WS_MRG = WS_QKV + 64 * MiB;
constexpr size_t WS_HID = WS_QKV + 144 * MiB;
constexpr size_t WS_YP = WS_QKV;
constexpr size_t WS_H8 = WS_QKV + 240 * MiB;
constexpr size_t WS_END = WS_H8 + 32 * MiB;
static_assert(WS_HID >= WS_YP + (size_t)36864 * DM * 2 || WS_YP >= WS_HID + (size_t)36864 * FF * 2, "YP / HID overlap");
static_assert(WS_END <= 1024 * MiB, "workspace");
constexpr int CW_TMO = 0, CW_CODE = 1, CW_BAR = 4096, CW_ECNT = 16384;
constexpr int CW_CMAX = 32768;
static_assert((CW_CMAX + DEPTH * NIN) * 4 <= (int)CTL_ZERO_BYTES, "ctl");
#define XB_TMO      128
#define XB_XCNT(j)  (256  + 64 * (j))
#define XB_XSUB(j)  (1280 + 64 * (j))
#define XB_XGEN(j)  (2304 + 64 * (j))
#define XB_TOP      3328
#define XB_TOPGEN   3392
#define XCD_BAR_WORDS 3456
#define XB_SPIN_CAP (1u << 18)
constexpr int RING_BYTES = 131072, LDSCTL_OFF = RING_BYTES, MISC_OFF = LDSCTL_OFF + 320, LT_OFF = LDSCTL_OFF + 1024  , WSCR_OFF = LDSCTL_OFF + 2048  ;
constexpr int LDS_BYTES = 147456;

__device__ __forceinline__ unsigned xb_ld(unsigned* p)              { return __hip_atomic_load(p, __ATOMIC_RELAXED, __HIP_MEMORY_SCOPE_AGENT); }
__device__ __forceinline__ unsigned xb_add(unsigned* p, unsigned v) { return __hip_atomic_fetch_add(p, v, __ATOMIC_RELAXED, __HIP_MEMORY_SCOPE_AGENT); }
__device__ __forceinline__ unsigned xb_xcc_id() { return (unsigned)__builtin_amdgcn_s_getreg((3 << 11) | 20) & 0xFu; }
#define XB_SPIN(cond, bar) do { unsigned _sp = 0; while (cond) { __builtin_amdgcn_s_sleep(1); \
    if ((++_sp & 255u) == 0u) { if (xb_ld(&(bar)[XB_TMO])) break; if (_sp > XB_SPIN_CAP) { atomicAdd(&(bar)[XB_TMO], 1u); break; } } } } while (0)
struct XcdBarrier { unsigned* bar; unsigned x; volatile LAS unsigned* st; };
__device__ __forceinline__ XcdBarrier xcd_barrier_post(unsigned* bar, volatile LAS unsigned* st) {
    XcdBarrier b; b.bar = bar; b.x = xb_xcc_id(); b.st = st;
    if (threadIdx.x == 0) (void)xb_add(&bar[XB_XCNT(b.x)], 1u);
    return b;
}
__device__ __forceinline__ void xcd_barrier_complete(unsigned* bar, unsigned x, unsigned& nloc, unsigned& nx) {
    const unsigned G = gridDim.x * gridDim.y * gridDim.z;
    unsigned sum, cnt, mine, sp = 0u;
    for (;;) {
        sum = 0u; cnt = 0u; mine = 0u;
#pragma unroll
        for (unsigned j = 0; j < 16; ++j) { const unsigned c = xb_ld(&bar[XB_XCNT(j)]); sum += c; cnt += (c > 0u) ? 1u : 0u; mine = (j == x) ? c : mine; }
        if (sum == G) break;
        __builtin_amdgcn_s_sleep(1);
        if ((++sp & 255u) == 0u) { if (xb_ld(&bar[XB_TMO])) break; if (sp > XB_SPIN_CAP) { atomicAdd(&bar[XB_TMO], 1u); break; } }
    }
    nloc = mine > 0u ? mine : 1u; nx = cnt > 0u ? cnt : 1u;
}
__device__ __forceinline__ void xcd_barrier(const XcdBarrier& b) {
    asm volatile("s_waitcnt vmcnt(0)" ::: "memory");
    __syncthreads();
    if (threadIdx.x == 0) {
        unsigned* bar = b.bar;
        __builtin_amdgcn_s_waitcnt(0);
        unsigned nloc = b.st[0], nx = b.st[1];
        if (nloc == 0u) { xcd_barrier_complete(bar, b.x, nloc, nx); b.st[0] = nloc; b.st[1] = nx; }
        const unsigned old = xb_add(&bar[XB_XSUB(b.x)], 1u);
        const unsigned gen = old / nloc;
        if (old + 1u == (gen + 1u) * nloc) {
            __builtin_amdgcn_fence(__ATOMIC_RELEASE, "agent");
            asm volatile("s_waitcnt vmcnt(0)" ::: "memory");
            const unsigned og = xb_add(&bar[XB_TOP], 1u);
            const unsigned tg = og / nx;
            if (og + 1u == (tg + 1u) * nx) xb_add(&bar[XB_TOPGEN], 1u);
            else XB_SPIN(xb_ld(&bar[XB_TOPGEN]) == tg, bar);
            __builtin_amdgcn_fence(__ATOMIC_ACQUIRE, "agent");
            xb_add(&bar[XB_XGEN(b.x)], 1u);
            asm volatile("s_waitcnt vmcnt(0)" ::: "memory");
        } else {
            XB_SPIN(xb_ld(&bar[XB_XGEN(b.x)]) == gen, bar);
            __builtin_amdgcn_fence(__ATOMIC_ACQUIRE, "agent");
            asm volatile("s_waitcnt vmcnt(0)" ::: "memory");
        }
    }
    __syncthreads();
}

struct Args { const float* in[14]; float* out; unsigned char* ws; int ph_lo, ph_hi; };
static_assert(sizeof(Args) == 14 * 8 + 8 + 8 + 8, "Args has no padding");

__device__ __forceinline__ float wave_sum(float v) {
#pragma unroll
    for (int o = 1; o < 64; o <<= 1) v += __shfl_xor(v, o);
    return v;
}
__device__ __forceinline__ unsigned f2bf(float f) { unsigned u = __builtin_bit_cast(unsigned, f); return (u + 0x7fffu + ((u >> 16) & 1u)) >> 16; }
__device__ __forceinline__ unsigned pk2(float lo, float hi) { return f2bf(lo) | (f2bf(hi) << 16); }

template <int MAP> __device__ __forceinline__ int wmap(int n) {
    if (MAP == 1) {
        if (n < 2 * WA) { const int d = n & 127; if (d < 32) { const int dd = (d < 16) ? (((d >> 2) << 3) + (d & 3)) : ((((d - 16) >> 2) << 3) + 4 + (d & 3)); return (n & ~127) + dd; } }
        return n;
    } else if (MAP == 2) {
        if (n < FF) return ((n >> 7) << 8) + (n & 127);
        const int j = n - FF; return ((j >> 7) << 8) + 128 + (j & 127);
    }
    return n;
}
template <int MAP>
__device__ __forceinline__ void xpose_item(const float* W, int K, int N, bf16_t* WT, LAS float* scr, int item, int lane) {
    const int nblk = N / 32, kb = item / nblk, nb = item % nblk, k0 = 64 * kb, n0 = 32 * nb;
#pragma unroll 8
    for (int i = 0; i < 32; ++i) { const int kk = 2 * i + (lane >> 5); scr[kk * 33 + (lane & 31)] = W[(size_t)(k0 + kk) * N + n0 + (lane & 31)]; }
    asm volatile("s_waitcnt lgkmcnt(0)" ::: "memory");
    const int c = lane & 7;
#pragma unroll
    for (int j = 0; j < 4; ++j) { const int n = (lane >> 3) + 8 * j; const LAS float* s = scr + (8 * c) * 33 + n;
        u32x4 o; o.x = pk2(s[0 * 33], s[1 * 33]); o.y = pk2(s[2 * 33], s[3 * 33]); o.z = pk2(s[4 * 33], s[5 * 33]); o.w = pk2(s[6 * 33], s[7 * 33]);
        *(u32x4*)(WT + (size_t)wmap<MAP>(n0 + n) * K + k0 + 8 * c) = o; }
    asm volatile("s_waitcnt lgkmcnt(0)" ::: "memory");
}
__device__ __forceinline__ int opq(int x) { asm volatile("" : "+v"(x)); return x; }
struct Frame {
    LAS unsigned char* lds; volatile LAS unsigned* MISC; unsigned* ctl; unsigned char* ws;
    int tid, lane, wave, vcu, G;
    const Args* A; float* out;
};
constexpr int I_IN = (DM / 64) * (NIN / 32), I_PA = (512 / 64) * (DM / 32), I_PB = (1024 / 64) * (DM / 32), I_WO = (DM / 64) * (DM / 32),
              I_UP1 = (DM / 64) * (1024 / 32), I_UP = NEXP * I_UP1, I_DN1 = (FF / 64) * (DM / 32), I_DN = NEXP * I_DN1;

__device__ __forceinline__ float wave_max(float v) {
#pragma unroll
    for (int o = 1; o < 64; o <<= 1) v = fmaxf(v, __shfl_xor(v, o));
    return v;
}
__device__ __forceinline__ unsigned q8(float v, float inv) { const int q = (int)__builtin_rintf(v * inv); return (unsigned)(q < -127 ? -127 : (q > 127 ? 127 : q)) & 0xffu; }
__device__ __forceinline__ unsigned q8x4(float a, float b, float c, float d, float inv) { return q8(a, inv) | (q8(b, inv) << 8) | (q8(c, inv) << 16) | (q8(d, inv) << 24); }

struct XItem { const float* src; unsigned char* dst; float* sb; unsigned* cmax; int N, K, k0, n0, kind; };
__device__ __forceinline__ int wmap_rt(int kind, int n) { return kind == 1 ? wmap<1>(n) : kind == 2 ? wmap<2>(n) : n; }
__device__ __forceinline__ void tile_load(f32x4 (&t)[8], const XItem& x, int lane) {
    const float* p = x.src + (size_t)(x.k0 + (lane >> 3)) * x.N + x.n0 + 4 * (lane & 7);
#pragma unroll
    for (int i = 0; i < 8; ++i) t[i] = *(const f32x4*)(p + (size_t)(8 * i) * x.N);
}
__device__ __forceinline__ void tile_to_lds(const f32x4 (&t)[8], LAS float* scr, int lane) {
#pragma unroll
    for (int i = 0; i < 8; ++i) { LAS float* d = scr + ((lane >> 3) + 8 * i) * 33 + 4 * (lane & 7); d[0] = t[i].x; d[1] = t[i].y; d[2] = t[i].z; d[3] = t[i].w; }
}
__device__ __forceinline__ void tile_colmax(const f32x4 (&t)[8], const XItem& x, int lane) {
    f32x4 m = (f32x4){0.f, 0.f, 0.f, 0.f};
#pragma unroll
    for (int i = 0; i < 8; ++i) { m.x = fmaxf(m.x, fabsf(t[i].x)); m.y = fmaxf(m.y, fabsf(t[i].y)); m.z = fmaxf(m.z, fabsf(t[i].z)); m.w = fmaxf(m.w, fabsf(t[i].w)); }
#pragma unroll
    for (int o = 8; o < 64; o <<= 1) { m.x = fmaxf(m.x, __shfl_xor(m.x, o)); m.y = fmaxf(m.y, __shfl_xor(m.y, o)); m.z = fmaxf(m.z, __shfl_xor(m.z, o)); m.w = fmaxf(m.w, __shfl_xor(m.w, o)); }
    const float v0 = __shfl(m.x, lane >> 2), v1 = __shfl(m.y, lane >> 2), v2 = __shfl(m.z, lane >> 2), v3 = __shfl(m.w, lane >> 2);
    const int e = lane & 3; const float v = e == 0 ? v0 : e == 1 ? v1 : e == 2 ? v2 : v3;
    if (lane < 32) __hip_atomic_fetch_max(x.cmax + x.n0 + lane, __float_as_uint(v), __ATOMIC_RELAXED, __HIP_MEMORY_SCOPE_AGENT);
}
__device__ __forceinline__ void tile_store_bf16(const XItem& x, const LAS float* scr, int lane) {
    const int c = lane & 7;
#pragma unroll
    for (int j = 0; j < 4; ++j) { const int n = (lane >> 3) + 8 * j; const LAS float* s = scr + (8 * c) * 33 + n;
        u32x4 o; o.x = cvt_pk_bf16(s[0 * 33], s[1 * 33]); o.y = cvt_pk_bf16(s[2 * 33], s[3 * 33]); o.z = cvt_pk_bf16(s[4 * 33], s[5 * 33]); o.w = cvt_pk_bf16(s[6 * 33], s[7 * 33]);
        *(u32x4*)((bf16_t*)x.dst + (size_t)wmap_rt(x.kind, x.n0 + n) * x.K + x.k0 + 8 * c) = o; }
}
__device__ __forceinline__ void tile_store_i8(const XItem& x, const LAS float* scr, int lane) {
    const int c = lane & 3;
#pragma unroll
    for (int j = 0; j < 2; ++j) { const int n = (lane >> 2) + 16 * j; const LAS float* s = scr + (16 * c) * 33 + n;
        const float am = __uint_as_float(x.cmax[x.n0 + n]); const float inv = am > 0.f ? 127.0f / am : 0.f;
        u32x4 o; o.x = q8x4(s[0 * 33], s[1 * 33], s[2 * 33], s[3 * 33], inv); o.y = q8x4(s[4 * 33], s[5 * 33], s[6 * 33], s[7 * 33], inv);
        o.z = q8x4(s[8 * 33], s[9 * 33], s[10 * 33], s[11 * 33], inv); o.w = q8x4(s[12 * 33], s[13 * 33], s[14 * 33], s[15 * 33], inv);
        const int dr = wmap<1>(x.n0 + n);
        *(u32x4*)(x.dst + (size_t)dr * x.K + x.k0 + 16 * c) = o;
        if (x.k0 == 0 && c == 0) x.sb[dr] = am * (1.0f / 127.0f); }
}
__device__ __forceinline__ void tile_process(const f32x4 (&t)[8], const XItem& x, LAS float* scr, int lane, bool& need_lds) {
    need_lds = x.kind != 4;
    if (x.kind == 4) tile_colmax(t, x, lane); else tile_to_lds(t, scr, lane);
}
constexpr int I_CMX0 = I_IN;
constexpr int I_LAYER0 = I_CMX0 + I_PA + I_PB + I_WO + I_UP + I_DN;
__device__ __forceinline__ XItem decode_p0(const Frame& F, int it) {
    const int l = it / I_LAYER0; int r = it % I_LAYER0;
    unsigned char* LW = F.ws + WS_W + (size_t)l * LW_BYTES;
    XItem x; x.sb = nullptr; x.cmax = F.ctl + CW_CMAX + l * NIN; int nblk;
    if (r < I_CMX0) { x.src = F.A->in[2] + (size_t)l * DM * NIN; x.dst = nullptr; x.N = NIN; x.K = DM; x.kind = 4; }
    else { r -= I_CMX0;
    if (r < I_PA) { x.src = F.A->in[3] + (size_t)l * 512 * DM; x.dst = LW + LW_PA; x.N = DM; x.K = 512; x.kind = 0; }
    else { r -= I_PA;
    if (r < I_PB) { x.src = F.A->in[4] + (size_t)l * 1024 * DM; x.dst = LW + LW_PB; x.N = DM; x.K = 1024; x.kind = 0; }
    else { r -= I_PB;
    if (r < I_WO) { x.src = F.A->in[5] + (size_t)l * DM * DM; x.dst = LW + LW_WO; x.N = DM; x.K = DM; x.kind = 0; }
    else { r -= I_WO;
    if (r < I_UP) { const int e = r / I_UP1; r %= I_UP1; x.src = F.A->in[12] + ((size_t)l * NEXP + e) * DM * 1024; x.dst = LW + LW_UP + (size_t)e * 1024 * DM * 2; x.N = 1024; x.K = DM; x.kind = 2; }
    else { r -= I_UP; const int e = r / I_DN1; r %= I_DN1; x.src = F.A->in[13] + ((size_t)l * NEXP + e) * FF * DM; x.dst = LW + LW_DN + (size_t)e * DM * FF * 2; x.N = DM; x.K = FF; x.kind = 0; } } } } }
    nblk = x.N / 32; x.k0 = 64 * (r / nblk); x.n0 = 32 * (r % nblk);
    return x;
}
__device__ __forceinline__ XItem decode_p1(const Frame& F, int it) {
    const int l = it / I_IN, r = it % I_IN; XItem x;
    x.src = F.A->in[2] + (size_t)l * DM * NIN; x.dst = F.ws + WS_W + (size_t)l * LW_BYTES + LW_IN; x.sb = (float*)(F.ws + WS_SB) + l * NIN; x.cmax = F.ctl + CW_CMAX + l * NIN;
    x.N = NIN; x.K = DM; x.kind = 3; x.k0 = 64 * (r / (NIN / 32)); x.n0 = 32 * (r % (NIN / 32));
    return x;
}
template <int WHICH>
__device__ __forceinline__ void item_loop(Frame& F, int total) {
    LAS float* scr = (LAS float*)(F.lds + F.wave * 16384);
    const int gw = F.vcu * NWAVES + F.wave, NGW = F.G * NWAVES;
    int it = gw; if (it >= total) return;
    XItem cur = WHICH == 0 ? decode_p0(F, it) : decode_p1(F, it);
    f32x4 t[8]; tile_load(t, cur, F.lane);
    for (;;) {
        const bool lds = cur.kind != 4;
        if (lds) tile_to_lds(t, scr, F.lane); else tile_colmax(t, cur, F.lane);
        const int nit = it + NGW; const bool more = nit < total; XItem nx = cur;
        if (more) { nx = WHICH == 0 ? decode_p0(F, nit) : decode_p1(F, nit); tile_load(t, nx, F.lane); }
        if (lds) { asm volatile("s_waitcnt lgkmcnt(0)" ::: "memory");
            if (cur.kind == 3) tile_store_i8(cur, scr, F.lane); else tile_store_bf16(cur, scr, F.lane);
            asm volatile("s_waitcnt lgkmcnt(0)" ::: "memory"); }
        if (!more) break;
        cur = nx; it = nit;
    }
}

__device__ __forceinline__ void p0_prologue(Frame& F) {
    const int gw = F.vcu * NWAVES + F.wave, NGW = F.G * NWAVES;
    item_loop<0>(F, DEPTH * I_LAYER0);
    bf16_t* HB = (bf16_t*)(F.ws + WS_HB); unsigned char* H8 = F.ws + WS_H8; float* SA = (float*)(F.ws + WS_SA);
    for (int m = gw; m < MTOK; m += NGW) {
        const f32x4* xr = (const f32x4*)(F.A->in[0] + (size_t)m * DM) + F.lane; unsigned long long* o8 = (unsigned long long*)(HB + (size_t)m * DM) + F.lane;
        f32x4 v[8]; float am = 0.f;
#pragma unroll
        for (int j = 0; j < 8; ++j) { v[j] = xr[64 * j]; am = fmaxf(fmaxf(am, fmaxf(fabsf(v[j].x), fabsf(v[j].y))), fmaxf(fabsf(v[j].z), fabsf(v[j].w))); }
        am = wave_max(am); const float inv = am > 0.f ? 127.0f / am : 0.f;
        unsigned* o4 = (unsigned*)(H8 + (size_t)m * DM) + F.lane;
#pragma unroll
        for (int j = 0; j < 8; ++j) { o8[64 * j] = (unsigned long long)cvt_pk_bf16(v[j].x, v[j].y) | ((unsigned long long)cvt_pk_bf16(v[j].z, v[j].w) << 32); o4[64 * j] = q8x4(v[j].x, v[j].y, v[j].z, v[j].w, inv); }
        if (F.lane == 0) SA[m] = am * (1.0f / 127.0f);
    }
    {
        float* rope = (float*)(F.ws + WS_ROPE); const int* pos = (const int*)F.A->in[1];
        const int f = F.tid & 15;
        const float IF[16] = {1.0f, 0.44036659598350525f, 0.1939227432012558f, 0.08539710193872452f, 0.03760603070259094f, 0.016560440883040428f, 0.007292664609849453f, 0.0032114461064338684f,
                              0.0014142135623842478f, 0.0006227724370546639f, 0.00027424818836152554f, 0.00012076973507646471f, 5.3182957344688475e-05f, 2.34199997066753e-05f, 1.0313385246263351e-05f, 4.541670477919979e-06f};
        float inv = 0.f;
#pragma unroll
        for (int k = 0; k < 16; ++k) inv = (f == k) ? IF[k] : inv;
        for (int i = F.vcu * 512 + F.tid; i < MTOK * 16; i += F.G * 512) {
            const int row = i >> 4; const float ang = (float)pos[row] * inv;
            double rev = (double)ang * 0.15915494309189535; rev -= __builtin_rint(rev); const float rv = (float)rev;
            rope[(size_t)row * 32 + f] = __builtin_amdgcn_cosf(rv); rope[(size_t)row * 32 + 16 + f] = __builtin_amdgcn_sinf(rv);
        }
    }
    {
        bf16_t* WR = (bf16_t*)(F.ws + WS_WRT);
        for (int i = F.vcu * 512 + F.tid; i < DEPTH * 32 * DM; i += F.G * 512) {
            const int l = i / (32 * DM), o = (i / DM) % 32, k = i % DM;
            const float w = (o < 4) ? F.A->in[8][((size_t)l * DM + k) * 4 + o] : (o < 20) ? F.A->in[10][((size_t)l * DM + k) * 16 + (o - 4)] : 0.f;
            const unsigned hi = f2bf(w); const float rest = w - __uint_as_float(hi << 16);
            WR[((size_t)l * 2 * 32 + o) * DM + k] = (bf16_t)hi; WR[((size_t)l * 2 * 32 + 32 + o) * DM + k] = (bf16_t)f2bf(rest);
        }
    }
}
__device__ __forceinline__ void p1_quant(Frame& F) { item_loop<1>(F, DEPTH * I_IN); }

__device__ __forceinline__ void unpack8(const u32x4 w, float* f) { f[0] = bf_lo(w.x); f[1] = bf_hi(w.x); f[2] = bf_lo(w.y); f[3] = bf_hi(w.y); f[4] = bf_lo(w.z); f[5] = bf_hi(w.z); f[6] = bf_lo(w.w); f[7] = bf_hi(w.w); }
__device__ __forceinline__ u32x4 pack8f(const float* f) { u32x4 w; w.x = cvt_pk_bf16(f[0], f[1]); w.y = cvt_pk_bf16(f[2], f[3]); w.z = cvt_pk_bf16(f[4], f[5]); w.w = cvt_pk_bf16(f[6], f[7]); return w; }

__device__ __forceinline__ void ln1_router(Frame& F0, int l, bool do_route) {
    struct { LAS unsigned char* lds; unsigned* ctl; unsigned char* ws; int tid, lane, wave, vcu; const Args* A; } F;
    F.lds = F0.lds; F.ctl = F0.ctl; F.ws = F0.ws; F.tid = opq(F0.tid); F.lane = F.tid & 63; F.wave = __builtin_amdgcn_readfirstlane(F.tid >> 6); F.vcu = F0.vcu; F.A = F0.A;
    LAS float* Pt = (LAS float*)F.lds;
    const float* gam = F.A->in[6] + (size_t)(l * 2) * DM; const float* bet = F.A->in[7] + (size_t)(l * 2) * DM;
    bf16_t* HB = (bf16_t*)(F.ws + WS_HB); const bf16_t* Z = (const bf16_t*)(F.ws + WS_Z);
    const int row0 = F.vcu * 64;
    for (int i = 0; i < 8; i += 2) {
        const int row = row0 + F.wave * 8 + i;
        const u32x4* zr = (const u32x4*)(Z + (size_t)row * DM) + F.lane;
        u32x4 zw[2][4];
#pragma unroll
        for (int r = 0; r < 2; ++r)
#pragma unroll
            for (int j = 0; j < 4; ++j) zw[r][j] = zr[r * (DM / 8) + 64 * j];
#pragma unroll
        for (int r = 0; r < 2; ++r) {
            float v[4][8]; float s = 0.f;
#pragma unroll
            for (int j = 0; j < 4; ++j) { unpack8(zw[r][j], v[j]);
#pragma unroll
                for (int e = 0; e < 8; ++e) s += v[j][e]; }
            const float mean = wave_sum(s) * (1.f / DM); float s2 = 0.f;
#pragma unroll
            for (int j = 0; j < 4; ++j)
#pragma unroll
                for (int e = 0; e < 8; ++e) { v[j][e] -= mean; s2 += v[j][e] * v[j][e]; }
            const float rstd = 1.f / sqrtf(wave_sum(s2) * (1.f / DM) + LN_EPS);
            u32x4* hr = (u32x4*)(HB + (size_t)(row + r) * DM) + F.lane;
#pragma unroll
            for (int j = 0; j < 4; ++j) { const f32x4 g0 = ((const f32x4*)gam)[2 * F.lane + 128 * j], g1 = ((const f32x4*)gam)[2 * F.lane + 128 * j + 1], b0 = ((const f32x4*)bet)[2 * F.lane + 128 * j], b1 = ((const f32x4*)bet)[2 * F.lane + 128 * j + 1];
#pragma unroll
                for (int e = 0; e < 4; ++e) { v[j][e] = v[j][e] * rstd * g0[e] + b0[e]; v[j][4 + e] = v[j][4 + e] * rstd * g1[e] + b1[e]; }
                hr[64 * j] = pack8f(v[j]); }
        }
    }
    asm volatile("s_waitcnt vmcnt(0)" ::: "memory");
    __syncthreads();
    {
        const int tile = F.wave & 3, kh = F.wave >> 2, fr = F.lane & 15, fq = F.lane >> 4;
        const bf16_t* ap = HB + (size_t)(row0 + 16 * tile + fr) * DM + kh * 1024 + 8 * fq;
        const bf16_t* WH = (const bf16_t*)(F.ws + WS_WRT) + (size_t)l * 2 * 32 * DM; const bf16_t* WL = WH + 32 * DM;
        const bf16_t* bh = WH + (size_t)fr * DM + kh * 1024 + 8 * fq; const bf16_t* bl = WL + (size_t)fr * DM + kh * 1024 + 8 * fq;
        f32x4 c0 = (f32x4){0.f, 0.f, 0.f, 0.f}, c1 = c0;
#pragma unroll 4
        for (int ks = 0; ks < 32; ++ks) {
            const bf16x8 a = *(const bf16x8*)(ap + 32 * ks);
            const bf16x8 h0 = *(const bf16x8*)(bh + 32 * ks), h1 = *(const bf16x8*)(bh + 16 * DM + 32 * ks), l0 = *(const bf16x8*)(bl + 32 * ks), l1 = *(const bf16x8*)(bl + 16 * DM + 32 * ks);
            c0 = __builtin_amdgcn_mfma_f32_16x16x32_bf16(a, h0, c0, 0, 0, 0); c0 = __builtin_amdgcn_mfma_f32_16x16x32_bf16(a, l0, c0, 0, 0, 0);
            c1 = __builtin_amdgcn_mfma_f32_16x16x32_bf16(a, h1, c1, 0, 0, 0); c1 = __builtin_amdgcn_mfma_f32_16x16x32_bf16(a, l1, c1, 0, 0, 0);
        }
        LAS float* pp = Pt + (kh * 64 + 16 * tile + 4 * fq) * 32 + fr;
#pragma unroll
        for (int r = 0; r < 4; ++r) { pp[r * 32] = c0[r]; pp[r * 32 + 16] = c1[r]; }
    }
    __syncthreads();
    if (F.wave == 0 && do_route) {
        const int rl = F.lane, row = row0 + rl;
        const float* cb = F.A->in[9] + l * 4; const float* fb = F.A->in[11] + l * 16;
        float c[4], f[16];
#pragma unroll
        for (int j = 0; j < 4; ++j) c[j] = (Pt[rl * 32 + j] + Pt[(64 + rl) * 32 + j]) + cb[j];
#pragma unroll
        for (int j = 0; j < 16; ++j) f[j] = (Pt[rl * 32 + 4 + j] + Pt[(64 + rl) * 32 + 4 + j]) + fb[j];
        float cmax = c[0]; int g = 0;
#pragma unroll
        for (int j = 1; j < 4; ++j) if (c[j] > cmax) { cmax = c[j]; g = j; }
        float se = 0.f;
#pragma unroll
        for (int j = 0; j < 4; ++j) se += __expf(c[j] - cmax);
        const float pgrp = 1.0f / se;
        float sel[4];
#pragma unroll
        for (int i = 0; i < 4; ++i) sel[i] = (g == 0) ? f[i] : (g == 1) ? f[4 + i] : (g == 2) ? f[8 + i] : f[12 + i];
        float v1 = sel[0]; int i1 = 0;
#pragma unroll
        for (int i = 1; i < 4; ++i) if (sel[i] > v1) { v1 = sel[i]; i1 = i; }
        float v2 = -__builtin_inff(); int i2 = 0;
#pragma unroll
        for (int i = 0; i < 4; ++i) if (i != i1 && sel[i] > v2) { v2 = sel[i]; i2 = i; }
        const float w1 = 1.0f / (1.0f + __expf(v2 - v1)), w2 = 1.0f - w1;
        const int e1 = 4 * g + i1, e2 = 4 * g + i2;
        const unsigned long long lt = (1ull << F.lane) - 1ull;
        int r1 = 0, r2 = 0, mycnt = 0;
#pragma unroll
        for (int e = 0; e < NEXP; ++e) { const unsigned long long m1 = __ballot(e1 == e), m2 = __ballot(e2 == e); const int c1 = __popcll(m1);
            if (e1 == e) r1 = __popcll(m1 & lt); if (e2 == e) r2 = c1 + __popcll(m2 & lt); if (F.lane == e) mycnt = c1 + __popcll(m2); }
        int base = 0;
        if (F.lane < NEXP && mycnt > 0) base = (int)__hip_atomic_fetch_add(F.ctl + CW_ECNT + 64 * l + F.lane, (unsigned)mycnt, __ATOMIC_RELAXED, __HIP_MEMORY_SCOPE_AGENT);
        const int pos1 = __shfl(base, e1) + r1, pos2 = __shfl(base, e2) + r2;
        int* list = (int*)(F.ws + WS_LIST);
        list[e1 * ECAP + pos1] = row; list[e2 * ECAP + pos2] = row;
        ((u32x4*)(F.ws + WS_TOK))[row] = (u32x4){(unsigned)(e1 << 16 | pos1), __float_as_uint(pgrp * w1), (unsigned)(e2 << 16 | pos2), __float_as_uint(pgrp * w2)};
    }
    __syncthreads();
}
__device__ __forceinline__ void moe_tables(Frame& F, int l) {
    LAS int* LT = (LAS int*)(F.lds + LT_OFF);
    if (F.tid == 0) { int t = 0;
        for (int e = 0; e < NEXP; ++e) { const int c = (int)__hip_atomic_load(F.ctl + CW_ECNT + 64 * l + e, __ATOMIC_RELAXED, __HIP_MEMORY_SCOPE_AGENT); LT[e] = t; LT[32 + e] = c; t += (c + 255) >> 8; }
        LT[16] = t; }
    __syncthreads();
    if (F.tid < 160) { const int rt = F.tid; int e = 0;
#pragma unroll
        for (int j = 1; j < NEXP; ++j) e += (LT[j] <= rt) ? 1 : 0;
        LT[64 + rt] = e; }
    __syncthreads();
}
__device__ __forceinline__ void ln2_phase(Frame& F0, int l) {
    struct { LAS unsigned char* lds; unsigned char* ws; int lane, wave, vcu, G; const Args* A; float* out; } F;
    F.lds = F0.lds; F.ws = F0.ws; { const int t = opq(F0.tid); F.lane = t & 63; F.wave = __builtin_amdgcn_readfirstlane(t >> 6); } F.vcu = F0.vcu; F.G = F0.G; F.A = F0.A; F.out = F0.out;
    const LAS int* LT = (const LAS int*)(F.lds + LT_OFF);
    const float* gam = F.A->in[6] + (size_t)(l * 2 + 1) * DM; const float* bet = F.A->in[7] + (size_t)(l * 2 + 1) * DM;
    bf16_t* HB = (bf16_t*)(F.ws + WS_HB); const bf16_t* YP = (const bf16_t*)(F.ws + WS_YP); unsigned char* H8 = F.ws + WS_H8; float* SA = (float*)(F.ws + WS_SA);
    const int gw = F.vcu * NWAVES + F.wave, NGW = F.G * NWAVES;
    for (int row = gw; row < MTOK; row += NGW) {
        const u32x4 ti = ((const u32x4*)(F.ws + WS_TOK))[row];
        const int e1 = ti.x >> 16, p1 = ti.x & 0xffff, e2 = ti.z >> 16, p2 = ti.z & 0xffff; const float g1 = __uint_as_float(ti.y), g2 = __uint_as_float(ti.w);
        const size_t s1 = (size_t)LT[e1] * 256 + p1, s2 = (size_t)LT[e2] * 256 + p2;
        u32x4* hr = (u32x4*)(HB + (size_t)row * DM) + F.lane;
        const u32x4* y1 = (const u32x4*)(YP + s1 * DM) + F.lane; const u32x4* y2 = (const u32x4*)(YP + s2 * DM) + F.lane;
        float v[4][8]; float s = 0.f;
#pragma unroll
        for (int j = 0; j < 4; ++j) { float h[8], a[8], b[8]; unpack8(hr[64 * j], h); unpack8(y1[64 * j], a); unpack8(y2[64 * j], b);
#pragma unroll
            for (int e = 0; e < 8; ++e) { v[j][e] = ALPHA * h[e] + g1 * a[e] + g2 * b[e]; s += v[j][e]; } }
        const float mean = wave_sum(s) * (1.f / DM); float s2v = 0.f;
#pragma unroll
        for (int j = 0; j < 4; ++j)
#pragma unroll
            for (int e = 0; e < 8; ++e) { v[j][e] -= mean; s2v += v[j][e] * v[j][e]; }
        const float rstd = 1.f / sqrtf(wave_sum(s2v) * (1.f / DM) + LN_EPS);
        float am = 0.f;
#pragma unroll
        for (int j = 0; j < 4; ++j) { const f32x4 g0 = ((const f32x4*)gam)[2 * F.lane + 128 * j], g1v = ((const f32x4*)gam)[2 * F.lane + 128 * j + 1], b0 = ((const f32x4*)bet)[2 * F.lane + 128 * j], b1 = ((const f32x4*)bet)[2 * F.lane + 128 * j + 1];
#pragma unroll
            for (int e = 0; e < 4; ++e) { v[j][e] = v[j][e] * rstd * g0[e] + b0[e]; v[j][4 + e] = v[j][4 + e] * rstd * g1v[e] + b1[e]; am = fmaxf(am, fmaxf(fabsf(v[j][e]), fabsf(v[j][4 + e]))); } }
        if (l + 1 < DEPTH) {
            am = wave_max(am); const float inv = am > 0.f ? 127.0f / am : 0.f;
            u32x2* q = (u32x2*)(H8 + (size_t)row * DM) + F.lane;
#pragma unroll
            for (int j = 0; j < 4; ++j) { hr[64 * j] = pack8f(v[j]); q[64 * j] = (u32x2){q8x4(v[j][0], v[j][1], v[j][2], v[j][3], inv), q8x4(v[j][4], v[j][5], v[j][6], v[j][7], inv)}; }
            if (F.lane == 0) SA[row] = am * (1.0f / 127.0f);
        } else {
            f32x4* o = (f32x4*)(F.out + (size_t)row * DM) + 2 * F.lane;
#pragma unroll
            for (int j = 0; j < 4; ++j) { o[128 * j] = (f32x4){v[j][0], v[j][1], v[j][2], v[j][3]}; o[128 * j + 1] = (f32x4){v[j][4], v[j][5], v[j][6], v[j][7]}; }
        }
    }
}

constexpr int N_PHASES = 2 + 8 * DEPTH;
#ifndef PHMASK
#define PHMASK 0x3ff
#endif
#ifndef DUPMASK
#define DUPMASK 0
#endif
__global__ void __launch_bounds__(NWAVES * 64, 2) mk_fwd(Args args) {
    extern __shared__ __attribute__((aligned(16))) unsigned char lds_raw[];
    Frame F;
    F.lds = (LAS unsigned char*)lds_raw; F.MISC = (volatile LAS unsigned*)(F.lds + MISC_OFF);
    F.tid = threadIdx.x; F.lane = F.tid & 63; F.wave = __builtin_amdgcn_readfirstlane(F.tid >> 6);
    F.G = gridDim.x; { const int bx = blockIdx.x; F.vcu = (F.G % 8 == 0) ? (bx % 8) * (F.G / 8) + bx / 8 : bx; }
    F.ws = args.ws; F.ctl = (unsigned*)(args.ws + WS_CTL); F.out = args.out;
    F.A = &args;
    for (int u = F.tid; u < (LDS_BYTES - LDSCTL_OFF) / 4; u += NWAVES * 64) ((LAS unsigned*)(F.lds + LDSCTL_OFF))[u] = 0u;
    __syncthreads();
    const int lo = args.ph_lo, hi = args.ph_hi;
    XcdBarrier bar; bar.bar = F.ctl + CW_BAR; bar.x = 0; bar.st = nullptr;
    if (hi - lo > 1) bar = xcd_barrier_post(F.ctl + CW_BAR, F.MISC + 8);
#define IN(k) (lo <= (k) && (k) < hi)
#define PH(s) ((PHMASK >> (s)) & 1)
#define REP(s) for (int rep_ = 0; rep_ < (((DUPMASK >> (s)) & 1) ? 2 : 1); ++rep_)
#define SEAM(k) do { if (IN(k) && IN((k) + 1)) xcd_barrier(bar); } while (0)
    if (PH(0) && IN(0)) { REP(0) p0_prologue(F); SEAM(0); }
    if (PH(0) && IN(1)) { REP(0) p1_quant(F); SEAM(1); }
    bf16_t* HB = (bf16_t*)(F.ws + WS_HB);
    bf16_t* QKV = (bf16_t*)(F.ws + WS_QKV); bf16_t* GATES = (bf16_t*)(F.ws + WS_GATES);
    bf16_t* OA = (bf16_t*)(F.ws + WS_OA); bf16_t* OB = (bf16_t*)(F.ws + WS_OB);
    for (int l = 0; l < DEPTH; ++l) {
        const int pb = 2 + 8 * l;
        const bf16_t* LW = (const bf16_t*)(F.ws + WS_W + (size_t)l * LW_BYTES);
        if (PH(1) && IN(pb + 0)) {
            pg8::Gemm g{(const bf16_t*)(F.ws + WS_H8), LW + LW_IN / 2, DM / 2}; pg8::StaticOrder S; S.init(MTOK, NIN, F.G, (int)blockIdx.x);
            pg8::EpiProj E{QKV, GATES, (const float*)(F.ws + WS_ROPE), (const float*)(F.ws + WS_SA), (const float*)(F.ws + WS_SB) + l * NIN};
            REP(1) pg8::gemm_phase<pg8::EpiProj, pg8::StaticOrder, true, false, true>(F.lds, g, S, E);
            SEAM(pb + 0);
        }
        if (PH(2) && IN(pb + 1)) {
            att::SbTensors TB{QKV + (size_t)3 * MTOK * WA, QKV + (size_t)3 * MTOK * WA + (size_t)MTOK * WB, QKV + (size_t)3 * MTOK * WA + (size_t)2 * MTOK * WB, OB};
            att::DaTensors TA{QKV, QKV + (size_t)MTOK * WA, QKV + (size_t)2 * MTOK * WA, (bf16_t*)(F.ws + WS_PO), (float*)(F.ws + WS_PL)};
            for (int c = F.vcu; c < 256; c += F.G) { const int x = c >> 5, j = c & 31, bh = 8 * x + (j >> 2), role = j & 3;
                const int qbA = role == 0 ? 3 : role == 1 ? 2 : role == 2 ? 7 : 6, qbB = role == 0 ? 0 : role == 1 ? 1 : role == 2 ? 4 : 5;
                REP(2) { att::sb_unit(TB, bh >> 3, bh & 7, qbA, F.lds); att::sb_unit(TB, bh >> 3, bh & 7, qbB, F.lds); }
                if (role < 2) { const int a = x * 16 + (j >> 2) * 2 + role; REP(3) att::da_unit(TA, OA, a >> 4, (a >> 2) & 3, a & 3, F.lds, (LAS float*)(F.lds + WSCR_OFF)); } }
            SEAM(pb + 1);
        }
        if (PH(3) && IN(pb + 2)) {
            bf16_t* P1 = (bf16_t*)(F.ws + WS_P1); bf16_t* MRG = (bf16_t*)(F.ws + WS_MRG);
            pg8::StaticOrder S; S.init(MTOK, DM, F.G, (int)blockIdx.x);
            REP(4) {
            { pg8::Gemm g{OA, LW + LW_PA / 2, 512}; pg8::EpiGate<false> E{GATES, P1, MRG}; pg8::gemm_phase<pg8::EpiGate<false>, pg8::StaticOrder, true, false>(F.lds, g, S, E); }
            { pg8::Gemm g{OB, LW + LW_PB / 2, 1024}; pg8::EpiGate<true> E{GATES + (size_t)MTOK * DM, P1, MRG}; pg8::gemm_phase<pg8::EpiGate<true>, pg8::StaticOrder, true, false>(F.lds, g, S, E); }
            }
            SEAM(pb + 2);
        }
        if (PH(4) && IN(pb + 3)) {
            pg8::Gemm g{(const bf16_t*)(F.ws + WS_MRG), LW + LW_WO / 2, DM}; pg8::StaticOrder S; S.init(MTOK, DM, F.G, (int)blockIdx.x);
            pg8::EpiResid E{HB, (bf16_t*)(F.ws + WS_Z)};
            REP(5) pg8::gemm_phase<pg8::EpiResid, pg8::StaticOrder, true, false>(F.lds, g, S, E);
            SEAM(pb + 3);
        }
        if (PH(5) && IN(pb + 4)) { REP(8) ln1_router(F, l, rep_ == (((DUPMASK >> 8) & 1) ? 1 : 0)); SEAM(pb + 4); }
        if (PH(6) && IN(pb + 5)) {
            moe_tables(F, l);
            const LAS int* LT = (const LAS int*)(F.lds + LT_OFF);
            pg8::MoeOrder S{4, F.G, F.vcu, LT[16] * 4, LT, LT + 32, (const int*)(F.ws + WS_LIST)};
            pg8::Gemm g{HB, LW + LW_UP / 2, DM}; pg8::EpiSwiglu E{(bf16_t*)(F.ws + WS_HID)};
            REP(6) pg8::gemm_phase<pg8::EpiSwiglu, pg8::MoeOrder, true, true>(F.lds, g, S, E);
            SEAM(pb + 5);
        }
        if (PH(7) && IN(pb + 6)) {
            moe_tables(F, l);
            const LAS int* LT = (const LAS int*)(F.lds + LT_OFF);
            pg8::MoeOrder S{8, F.G, F.vcu, LT[16] * 8, LT, LT + 32, (const int*)(F.ws + WS_LIST)};
            pg8::Gemm g{(const bf16_t*)(F.ws + WS_HID), LW + LW_DN / 2, FF}; pg8::EpiBf16 E{(bf16_t*)(F.ws + WS_YP), DM};
            REP(7) pg8::gemm_phase<pg8::EpiBf16, pg8::MoeOrder, true, false>(F.lds, g, S, E);
            SEAM(pb + 6);
        }
        if (PH(8) && IN(pb + 7)) { moe_tables(F, l); ln2_phase(F, l); if (((DUPMASK >> 9) & 1) && l + 1 == DEPTH) ln2_phase(F, l); SEAM(pb + 7); }
    }
#undef IN
#undef SEAM
}

extern "C" void kernel_launch(void* const* d_in, const int* in_sizes, int n_in, void* d_out, int out_size, void* d_ws, size_t ws_size, hipStream_t stream) {
    static int grid = 0;
    if (grid == 0) {
        if (n_in != 14 || in_sizes[0] != MTOK * DM || out_size != MTOK * DM || ws_size < WS_END) { fprintf(stderr, "kernel_launch: unexpected shapes (n_in %d, in0 %d, out %d, ws %zu)\n", n_in, n_in > 0 ? in_sizes[0] : -1, out_size, ws_size); grid = -1; return; }
        int dev = 0, cus = 0;
        if (hipGetDevice(&dev) != hipSuccess || hipDeviceGetAttribute(&cus, hipDeviceAttributeMultiprocessorCount, dev) != hipSuccess) { grid = -1; return; }
        if (hipFuncSetAttribute((const void*)mk_fwd, hipFuncAttributeMaxDynamicSharedMemorySize, LDS_BYTES) != hipSuccess) { fprintf(stderr, "kernel_launch: hipFuncSetAttribute failed\n"); grid = -1; return; }
        int per_cu = 0;
        if (hipOccupancyMaxActiveBlocksPerMultiprocessor(&per_cu, (const void*)mk_fwd, NWAVES * 64, LDS_BYTES) != hipSuccess || per_cu < 1) fprintf(stderr, "kernel_launch: occupancy query reports %d\n", per_cu);
        (void)hipGetLastError();
        if (cus < 256) { fprintf(stderr, "kernel_launch: needs 256 CUs, device has %d\n", cus); grid = -1; return; }
        grid = 256;
    }
    if (grid < 0) return;
    if (hipMemsetAsync((char*)d_ws + WS_CTL, 0, CTL_ZERO_BYTES, stream) != hipSuccess) return;
    Args a{};
    for (int i = 0; i < 14; ++i) a.in[i] = (const float*)d_in[i];
    a.out = (float*)d_out; a.ws = (unsigned char*)d_ws;
#if MK_ONE_LAUNCH
    a.ph_lo = 0; a.ph_hi = N_PHASES;
    hipLaunchKernelGGL(mk_fwd, dim3(grid), dim3(NWAVES * 64), LDS_BYTES, stream, a);
#else
    for (int p = 0; p < N_PHASES; ++p) { a.ph_lo = p; a.ph_hi = p + 1; hipLaunchKernelGGL(mk_fwd, dim3(grid), dim3(NWAVES * 64), LDS_BYTES, stream, a); }
#endif
}
```

```cpp
#include <hip/hip_runtime.h>
#include <cstdio>
#include <cstdint>

#define LAS __attribute__((address_space(3)))
#define GAS __attribute__((address_space(1)))
typedef unsigned short bf16_t;
typedef short bf16x8 __attribute__((ext_vector_type(8)));
typedef short s16x4 __attribute__((ext_vector_type(4)));
typedef float f32x4 __attribute__((ext_vector_type(4)));
typedef float f32x2 __attribute__((ext_vector_type(2)));
typedef float f32x16 __attribute__((ext_vector_type(16)));
typedef unsigned u32x4 __attribute__((ext_vector_type(4)));
typedef unsigned u32x2 __attribute__((ext_vector_type(2)));
typedef int i32x4 __attribute__((ext_vector_type(4)));

constexpr int BATCH = 8, SEQ = 2048, DM = 2048, DEPTH = 2, MTOK = BATCH * SEQ;
constexpr int HD = 128, WA = 1536, WB = 1024, NIN = 11776;
constexpr int NEXP = 16, FF = 512, ECAP = 16384;
constexpr float LN_EPS = 1e-5f;
constexpr float ALPHA = 1.4142135623730951f;
constexpr float LOG2E = 1.4426950408889634f;
constexpr float QK_C2 = 0.08838834764831845f * LOG2E;

__device__ __forceinline__ unsigned cvt_pk_bf16(float lo, float hi) { unsigned r; asm volatile("v_cvt_pk_bf16_f32 %0, %1, %2" : "=v"(r) : "v"(lo), "v"(hi)); return r; }
__device__ __forceinline__ float bf_lo(unsigned w) { return __uint_as_float(w << 16); }
__device__ __forceinline__ float bf_hi(unsigned w) { return __uint_as_float(w & 0xffff0000u); }
__device__ __forceinline__ float sigmoidf_fast(float x) { return __builtin_amdgcn_rcpf(1.0f + __builtin_amdgcn_exp2f(-x * LOG2E)); }

namespace pg8 {
constexpr int BM = 256, BK = 64, HALF = 128, HTB = HALF * BK * 2, STAGE_BYTES = 8 * HTB, NXCD = 8, WGM = 8;
__host__ __device__ __forceinline__ int lds_byte(int r, int c) { const int st = (r >> 4) * 2 + (c >> 5), rr = r & 15, cc = c & 31, ob = rr * 64 + cc * 2; return st * 1024 + (ob ^ (((ob >> 9) & 1) << 5)); }
__host__ __device__ __forceinline__ void stage_rc(int b, int& R, int& C) { const int st = b / 1024, sb = b % 1024, swz = sb ^ (((sb >> 9) & 1) << 5); R = (st >> 1) * 16 + swz / 64; C = (st & 1) * 32 + (swz % 64) / 2; }
__host__ __device__ __forceinline__ int perm32(int rho) { const int n = rho >> 4, i = rho & 15; return 8 * (i >> 2) + 4 * n + (i & 3); }

struct Unit { int pm, pn, pb, e, r0; };
struct Gemm { const bf16_t* A; const bf16_t* Bt; int K; };

struct StaticOrder {
    int nM, nN, nwg, G, c;
    __device__ void init(int M, int N, int G_, int c_) { nM = M / BM; nN = N / BM; nwg = nM * nN; G = G_; c = c_; }
    __device__ bool next(int i, Unit& u) const {
        const long L = (long)i * G + c; if (L >= nwg) return false;
        int wgid = (int)L; { const int q = nwg / NXCD, r = nwg % NXCD, xcd = wgid % NXCD, off = wgid / NXCD; wgid = (xcd < r ? xcd * (q + 1) : r * (q + 1) + (xcd - r) * q) + off; }
        const int nig = WGM * nN, gid = wgid / nig, fm = gid * WGM, gsz = (nM - fm) < WGM ? (nM - fm) : WGM;
        u.pm = fm + ((wgid % nig) % gsz); u.pn = (wgid % nig) / gsz; u.pb = u.pn; u.e = 0; u.r0 = 0; return true;
    }
    __device__ __forceinline__ int tok(const Unit&, int) const { return 0; }
};
struct MoeOrder {
    int nct, G, c, total; const LAS int* tb; const LAS int* cnt; const int* list;
    __device__ bool next(int i, Unit& u) const {
        const long L = (long)i * G + c; if (L >= total) return false;
        const int rt = (int)L / nct, ct = (int)L % nct; const int e = __builtin_amdgcn_readfirstlane(tb[64 + rt]);
        u.pm = rt; u.pn = ct; u.pb = e * nct + ct; u.e = e; u.r0 = (rt - __builtin_amdgcn_readfirstlane(tb[e])) * BM; return true;
    }
    __device__ __forceinline__ int tok(const Unit& u, int row) const { const int cn = cnt[u.e]; int pos = u.r0 + row; pos = pos < cn ? pos : cn - 1; return list[u.e * ECAP + pos]; }
};

template <class Epi, class Sched, bool ALIGN_EPI, bool GATHER, bool I8 = false>
__device__ __forceinline__ void gemm_phase(LAS unsigned char* lds, const Gemm g, const Sched& S, const Epi& E) {
    int tid = threadIdx.x; asm volatile("" : "+v"(tid));
    const int wid = __builtin_amdgcn_readfirstlane(tid >> 6), lane = tid & 63, wr = wid >> 2, wc = wid & 3, fr = lane & 15, fq = lane >> 4;
    const int K = g.K, nt = K / BK;
    const size_t kstep = (size_t)(BK * 2);
    const size_t hstep = (size_t)HALF * K * 2;
    const size_t tstep = 2 * hstep;
    int RA[2], CA[2]; unsigned voffB[2];
#pragma unroll
    for (int i = 0; i < 2; ++i) { int R, C; stage_rc(tid * 16 + i * 8192, R, C); const int Rb = Epi::PERM ? ((R & ~31) + perm32(R & 31)) : R; RA[i] = R; CA[i] = C; voffB[i] = (unsigned)(Rb * K + C) * 2u; }
    const unsigned ldsw = (unsigned)wid * 1024u;
    const int aoff = lds_byte(wr * 64 + fr, fq * 8), boff = lds_byte(wc * 32 + fr, fq * 8);
#define PG8_SA(b, h) (((b) * 2 + (h)) * HTB)
#define PG8_SB(b, h) ((4 + (b) * 2 + (h)) * HTB)
#define PG8_STAGE(bufoff, gbase, v0, v1) do { \
        __builtin_amdgcn_global_load_lds((const unsigned*)((const char*)(gbase) + (v0)), (LAS unsigned*)(lds + (bufoff) + ldsw), 16, 0, 0); \
        __builtin_amdgcn_global_load_lds((const unsigned*)((const char*)(gbase) + (v1)), (LAS unsigned*)(lds + (bufoff) + ldsw + 8192), 16, 0, 0); } while (0)
#define PG8_LDA(dst, b, h) do { _Pragma("unroll") for (int m = 0; m < 4; ++m) _Pragma("unroll") for (int k = 0; k < 2; ++k) dst[m][k] = *(const LAS bf16x8*)(lds + PG8_SA(b, h) + aoff + m * 2048 + k * 1024); } while (0)
#define PG8_LDB(dst, b, h) do { _Pragma("unroll") for (int n = 0; n < 2; ++n) _Pragma("unroll") for (int k = 0; k < 2; ++k) dst[n][k] = *(const LAS bf16x8*)(lds + PG8_SB(b, h) + boff + n * 2048 + k * 1024); } while (0)
#define PG8_MMA(ai, bj, At, Bt) do { __builtin_amdgcn_s_setprio(1); _Pragma("unroll") for (int m = 0; m < 4; ++m) _Pragma("unroll") for (int n = 0; n < 2; ++n) _Pragma("unroll") for (int k = 0; k < 2; ++k) { \
        if constexpr (I8) acc[ai][bj][m][n] = __builtin_bit_cast(AccT, __builtin_amdgcn_mfma_i32_16x16x64_i8(__builtin_bit_cast(i32x4, Bt[n][k]), __builtin_bit_cast(i32x4, At[m][k]), __builtin_bit_cast(i32x4, acc[ai][bj][m][n]), 0, 0, 0)); \
        else acc[ai][bj][m][n] = __builtin_bit_cast(AccT, __builtin_amdgcn_mfma_f32_16x16x32_bf16(Bt[n][k], At[m][k], __builtin_bit_cast(f32x4, acc[ai][bj][m][n]), 0, 0, 0)); } __builtin_amdgcn_s_setprio(0); } while (0)
#define PG8_WAIT_V(n) asm volatile("s_waitcnt vmcnt(" #n ")" ::: "memory")
#define PG8_WAIT_L(n) asm volatile("s_waitcnt lgkmcnt(" #n ")" ::: "memory")
#define PG8_BAR __builtin_amdgcn_s_barrier()
#define PG8_SCHED __builtin_amdgcn_sched_barrier(0)
    Unit cur, nxt; int ui = 0;
    if (!S.next(0, cur)) return;
    typedef typename Epi::AccT AccT;
    AccT acc[2][2][4][2];
#pragma unroll
    for (int a = 0; a < 2; ++a)
#pragma unroll
        for (int b = 0; b < 2; ++b)
#pragma unroll
            for (int m = 0; m < 4; ++m)
#pragma unroll
                for (int n = 0; n < 2; ++n) acc[a][b][m][n] = AccT{};
    bf16x8 At[4][2], B0[2][2], B1[2][2];
    unsigned c00, c01, c10, c11, n00, n01, n10, n11;
    if constexpr (GATHER) {
        c00 = (unsigned)(S.tok(cur, RA[0]) * K + CA[0]) * 2u; c01 = (unsigned)(S.tok(cur, RA[1]) * K + CA[1]) * 2u;
        c10 = (unsigned)(S.tok(cur, HALF + RA[0]) * K + CA[0]) * 2u; c11 = (unsigned)(S.tok(cur, HALF + RA[1]) * K + CA[1]) * 2u;
    } else {
        c00 = (unsigned)(RA[0] * K + CA[0]) * 2u; c01 = (unsigned)(RA[1] * K + CA[1]) * 2u; c10 = c00 + (unsigned)hstep; c11 = c01 + (unsigned)hstep;
    }
    n00 = c00; n01 = c01; n10 = c10; n11 = c11;
    const char* cA = GATHER ? (const char*)g.A : (const char*)g.A + (size_t)cur.pm * tstep; const char* cB = (const char*)g.Bt + (size_t)cur.pb * tstep;
    PG8_STAGE(PG8_SB(0, 0), cB, voffB[0], voffB[1]); PG8_STAGE(PG8_SB(0, 1), cB + hstep, voffB[0], voffB[1]); PG8_STAGE(PG8_SA(0, 0), cA, c00, c01); PG8_STAGE(PG8_SA(0, 1), cA, c10, c11);
    if (wr == 1) PG8_BAR;
    PG8_WAIT_V(2); PG8_BAR;
    PG8_STAGE(PG8_SB(1, 0), cB + kstep, voffB[0], voffB[1]); PG8_STAGE(PG8_SA(1, 0), cA + kstep, c00, c01); PG8_STAGE(PG8_SB(1, 1), cB + hstep + kstep, voffB[0], voffB[1]);
    PG8_WAIT_V(6); PG8_BAR;
    for (;;) {
        const bool has_next = S.next(ui + 1, nxt);
        const char* nA = has_next ? (GATHER ? (const char*)g.A : (const char*)g.A + (size_t)nxt.pm * tstep) : cA; const char* nB = has_next ? (const char*)g.Bt + (size_t)nxt.pb * tstep : cB;
        if constexpr (GATHER) {
            if (has_next) {
                n00 = (unsigned)(S.tok(nxt, RA[0]) * K + CA[0]) * 2u; n01 = (unsigned)(S.tok(nxt, RA[1]) * K + CA[1]) * 2u;
                n10 = (unsigned)(S.tok(nxt, HALF + RA[0]) * K + CA[0]) * 2u; n11 = (unsigned)(S.tok(nxt, HALF + RA[1]) * K + CA[1]) * 2u;
            } else { n00 = c00; n01 = c01; n10 = c10; n11 = c11; }
        }
        for (int t = 0; t < nt; t += 2) {
            const bool last = (t == nt - 2);
            const char* a1 = cA + (size_t)(t + 1) * kstep;
            const char* a2 = last ? nA : cA + (size_t)(t + 2) * kstep; const char* b2 = last ? nB : cB + (size_t)(t + 2) * kstep;
            const char* a3 = a2 + kstep; const char* b3 = b2 + kstep;
            const unsigned o00 = last ? n00 : c00, o01 = last ? n01 : c01, o10 = last ? n10 : c10, o11 = last ? n11 : c11;
            PG8_LDB(B0, 0, 0); PG8_LDB(B1, 0, 1); PG8_SCHED; PG8_LDA(At, 0, 0); PG8_STAGE(PG8_SA(1, 1), a1, c10, c11);
            PG8_WAIT_V(8); PG8_WAIT_L(0); PG8_BAR; PG8_MMA(0, 0, At, B0); PG8_MMA(0, 1, At, B1); PG8_BAR; PG8_SCHED;
            PG8_LDA(At, 0, 1); PG8_STAGE(PG8_SB(0, 0), b2, voffB[0], voffB[1]); PG8_STAGE(PG8_SB(0, 1), b2 + hstep, voffB[0], voffB[1]); PG8_STAGE(PG8_SA(0, 0), a2, o00, o01);
            PG8_WAIT_V(8); PG8_WAIT_L(0); PG8_BAR; PG8_MMA(1, 0, At, B0); PG8_MMA(1, 1, At, B1); PG8_BAR; PG8_SCHED;
            PG8_LDB(B0, 1, 0); PG8_LDB(B1, 1, 1); PG8_SCHED; PG8_LDA(At, 1, 0); PG8_STAGE(PG8_SA(0, 1), a2, o10, o11);
            PG8_WAIT_V(8); PG8_WAIT_L(0); PG8_BAR; PG8_MMA(0, 0, At, B0); PG8_MMA(0, 1, At, B1); PG8_BAR; PG8_SCHED;
            PG8_LDA(At, 1, 1); PG8_STAGE(PG8_SB(1, 0), b3, voffB[0], voffB[1]); PG8_STAGE(PG8_SB(1, 1), b3 + hstep, voffB[0], voffB[1]); PG8_STAGE(PG8_SA(1, 0), a3, o00, o01);
            PG8_WAIT_V(8); PG8_WAIT_L(0); PG8_BAR; PG8_MMA(1, 0, At, B0); PG8_MMA(1, 1, At, B1); PG8_BAR; PG8_SCHED;
        }
        if constexpr (ALIGN_EPI) { if (wr == 0) PG8_BAR; }
        E(acc, cur, wr, wc, fr, fq);
        if (!has_next) break;
#pragma unroll
        for (int a = 0; a < 2; ++a)
#pragma unroll
            for (int b = 0; b < 2; ++b)
#pragma unroll
                for (int m = 0; m < 4; ++m)
#pragma unroll
                    for (int n = 0; n < 2; ++n) acc[a][b][m][n] = AccT{};
        cur = nxt; cA = nA; cB = nB; ++ui; c00 = n00; c01 = n01; c10 = n10; c11 = n11;
        if constexpr (ALIGN_EPI) { if (wr == 1) PG8_BAR; }
    }
    PG8_WAIT_V(0);
    if constexpr (!ALIGN_EPI) { if (wr == 0) PG8_BAR; }
    PG8_BAR;
#undef PG8_SA
#undef PG8_SB
#undef PG8_STAGE
#undef PG8_LDA
#undef PG8_LDB
#undef PG8_MMA
#undef PG8_WAIT_V
#undef PG8_WAIT_L
#undef PG8_BAR
#undef PG8_SCHED
}
}
namespace pg8 {
struct EpiProj {
    static constexpr bool PERM = true; typedef i32x4 AccT;
    bf16_t* qkv;
    bf16_t* gates;
    const float* rope;
    const float* sa;
    const float* sb;
    __device__ __forceinline__ void operator()(const i32x4 (&acc)[2][2][4][2], const Unit& u, int wr, int wc, int fr, int fq) const {
        const int pn = u.pn; bf16_t* base; int ldc, ct0;
        if (pn < 18) { const int t = pn / 6; base = qkv + (size_t)t * MTOK * WA; ldc = WA; ct0 = t * 6; }
        else if (pn < 30) { const int t = (pn - 18) / 4; base = qkv + (size_t)3 * MTOK * WA + (size_t)t * MTOK * WB; ldc = WB; ct0 = 18 + t * 4; }
        else { const int t = (pn - 30) / 8; base = gates + (size_t)t * MTOK * DM; ldc = DM; ct0 = 30 + t * 8; }
        const int row0 = u.pm * BM + wr * 64 + fr, col0 = (pn - ct0) * BM + wc * 32 + 8 * fq, bcol0 = pn * BM + wc * 32 + 8 * fq;
        const bool do_rope = (pn < 12) && (wc == 0);
        f32x4 sbv[2][2];
#pragma unroll
        for (int bj = 0; bj < 2; ++bj)
#pragma unroll
            for (int n = 0; n < 2; ++n) sbv[bj][n] = *(const f32x4*)(sb + bcol0 + bj * HALF + 4 * n);
#pragma unroll
        for (int ai = 0; ai < 2; ++ai)
#pragma unroll
            for (int m = 0; m < 4; ++m) { const int row = row0 + ai * HALF + m * 16; bf16_t* rowp = base + (size_t)row * ldc + col0;
                const float sar = sa[row];
                f32x4 cs = (f32x4){1.f, 1.f, 1.f, 1.f}, sn = (f32x4){0.f, 0.f, 0.f, 0.f};
                if (do_rope) { cs = *(const f32x4*)(rope + (size_t)row * 32 + 4 * fq); sn = *(const f32x4*)(rope + (size_t)row * 32 + 16 + 4 * fq); }
#pragma unroll
                for (int bj = 0; bj < 2; ++bj) { f32x4 v0 = __builtin_convertvector(acc[ai][bj][m][0], f32x4) * (sbv[bj][0] * sar), v1 = __builtin_convertvector(acc[ai][bj][m][1], f32x4) * (sbv[bj][1] * sar);
                    if (do_rope) { const f32x4 y0 = v0 * cs - v1 * sn, y1 = v1 * cs + v0 * sn; v0 = y0; v1 = y1; }
                    u32x4 w; w.x = cvt_pk_bf16(v0[0], v0[1]); w.y = cvt_pk_bf16(v0[2], v0[3]); w.z = cvt_pk_bf16(v1[0], v1[1]); w.w = cvt_pk_bf16(v1[2], v1[3]);
                    *(u32x4*)(rowp + bj * HALF) = w; }
                asm volatile("" ::: "memory"); }
    }
};
struct EpiBf16 {
    static constexpr bool PERM = true; typedef f32x4 AccT;
    bf16_t* O; int ldc;
    __device__ __forceinline__ void operator()(const f32x4 (&acc)[2][2][4][2], const Unit& u, int wr, int wc, int fr, int fq) const {
        const int row0 = u.pm * BM + wr * 64 + fr, col0 = u.pn * BM + wc * 32 + 8 * fq;
#pragma unroll
        for (int ai = 0; ai < 2; ++ai)
#pragma unroll
            for (int m = 0; m < 4; ++m) { bf16_t* rowp = O + (size_t)(row0 + ai * HALF + m * 16) * ldc + col0;
#pragma unroll
                for (int bj = 0; bj < 2; ++bj) { const f32x4 v0 = acc[ai][bj][m][0], v1 = acc[ai][bj][m][1];
                    u32x4 w; w.x = cvt_pk_bf16(v0[0], v0[1]); w.y = cvt_pk_bf16(v0[2], v0[3]); w.z = cvt_pk_bf16(v1[0], v1[1]); w.w = cvt_pk_bf16(v1[2], v1[3]);
                    *(u32x4*)(rowp + bj * HALF) = w; } }
    }
};
template <bool SECOND> struct EpiGate {
    static constexpr bool PERM = true; typedef f32x4 AccT;
    const bf16_t* gate; bf16_t* P1; bf16_t* out;
    __device__ __forceinline__ void operator()(const f32x4 (&acc)[2][2][4][2], const Unit& u, int wr, int wc, int fr, int fq) const {
        const int row0 = u.pm * BM + wr * 64 + fr, col0 = u.pn * BM + wc * 32 + 8 * fq;
#pragma unroll
        for (int ai = 0; ai < 2; ++ai)
#pragma unroll
            for (int m = 0; m < 4; ++m) { const size_t off = (size_t)(row0 + ai * HALF + m * 16) * DM + col0;
#pragma unroll
                for (int bj = 0; bj < 2; ++bj) { const f32x4 v0 = acc[ai][bj][m][0], v1 = acc[ai][bj][m][1];
                    const u32x4 gw = *(const u32x4*)(gate + off + bj * HALF);
                    float r[8];
                    r[0] = sigmoidf_fast(bf_lo(gw.x)) * v0[0]; r[1] = sigmoidf_fast(bf_hi(gw.x)) * v0[1]; r[2] = sigmoidf_fast(bf_lo(gw.y)) * v0[2]; r[3] = sigmoidf_fast(bf_hi(gw.y)) * v0[3];
                    r[4] = sigmoidf_fast(bf_lo(gw.z)) * v1[0]; r[5] = sigmoidf_fast(bf_hi(gw.z)) * v1[1]; r[6] = sigmoidf_fast(bf_lo(gw.w)) * v1[2]; r[7] = sigmoidf_fast(bf_hi(gw.w)) * v1[3];
                    if (SECOND) { const u32x4 pw = *(const u32x4*)(P1 + off + bj * HALF);
                        r[0] += bf_lo(pw.x); r[1] += bf_hi(pw.x); r[2] += bf_lo(pw.y); r[3] += bf_hi(pw.y); r[4] += bf_lo(pw.z); r[5] += bf_hi(pw.z); r[6] += bf_lo(pw.w); r[7] += bf_hi(pw.w); }
                    u32x4 w; w.x = cvt_pk_bf16(r[0], r[1]); w.y = cvt_pk_bf16(r[2], r[3]); w.z = cvt_pk_bf16(r[4], r[5]); w.w = cvt_pk_bf16(r[6], r[7]);
                    *(u32x4*)((SECOND ? out : P1) + off + bj * HALF) = w; }
                asm volatile("" ::: "memory"); }
    }
};
struct EpiResid {
    static constexpr bool PERM = true; typedef f32x4 AccT;
    const bf16_t* h; bf16_t* z;
    __device__ __forceinline__ void operator()(const f32x4 (&acc)[2][2][4][2], const Unit& u, int wr, int wc, int fr, int fq) const {
        const int row0 = u.pm * BM + wr * 64 + fr, col0 = u.pn * BM + wc * 32 + 8 * fq;
#pragma unroll
        for (int ai = 0; ai < 2; ++ai)
#pragma unroll
            for (int m = 0; m < 4; ++m) { const size_t off = (size_t)(row0 + ai * HALF + m * 16) * DM + col0;
#pragma unroll
                for (int bj = 0; bj < 2; ++bj) { const f32x4 v0 = acc[ai][bj][m][0], v1 = acc[ai][bj][m][1];
                    const u32x4 hw = *(const u32x4*)(h + off + bj * HALF);
                    u32x4 w; w.x = cvt_pk_bf16(ALPHA * bf_lo(hw.x) + v0[0], ALPHA * bf_hi(hw.x) + v0[1]); w.y = cvt_pk_bf16(ALPHA * bf_lo(hw.y) + v0[2], ALPHA * bf_hi(hw.y) + v0[3]);
                    w.z = cvt_pk_bf16(ALPHA * bf_lo(hw.z) + v1[0], ALPHA * bf_hi(hw.z) + v1[1]); w.w = cvt_pk_bf16(ALPHA * bf_lo(hw.w) + v1[2], ALPHA * bf_hi(hw.w) + v1[3]);
                    *(u32x4*)(z + off + bj * HALF) = w; }
                asm volatile("" ::: "memory"); }
    }
};
struct EpiSwiglu {
    static constexpr bool PERM = true; typedef f32x4 AccT;
    bf16_t* Hd;
    __device__ __forceinline__ void operator()(const f32x4 (&acc)[2][2][4][2], const Unit& u, int wr, int wc, int fr, int fq) const {
        const int row0 = u.pm * BM + wr * 64 + fr, col0 = u.pn * HALF + wc * 32 + 8 * fq;
#pragma unroll
        for (int ai = 0; ai < 2; ++ai)
#pragma unroll
            for (int m = 0; m < 4; ++m) { bf16_t* rowp = Hd + (size_t)(row0 + ai * HALF + m * 16) * FF + col0;
                float r[8];
#pragma unroll
                for (int n = 0; n < 2; ++n)
#pragma unroll
                    for (int j = 0; j < 4; ++j) { const float a = acc[ai][0][m][n][j], b = acc[ai][1][m][n][j]; r[4 * n + j] = a * sigmoidf_fast(a) * b; }
                u32x4 w; w.x = cvt_pk_bf16(r[0], r[1]); w.y = cvt_pk_bf16(r[2], r[3]); w.z = cvt_pk_bf16(r[4], r[5]); w.w = cvt_pk_bf16(r[6], r[7]);
                *(u32x4*)rowp = w; }
    }
};
}
namespace att {
#define SBAR() __builtin_amdgcn_sched_barrier(0)
#define KSWZ(row, colB) ((row) * 256 + ((colB) ^ (((row) & 7) << 4)))
__device__ __forceinline__ int v_st(int k, int c) { const int kk = (k & ~0xC) | ((k & 4) << 1) | ((k & 8) >> 1); return ((kk >> 3) * 4 + (c >> 5)) * 512 + ((kk & 7) * 32 + (c & 31)) * 2; }
__device__ __forceinline__ int v_rd_base(int lane) { return ((lane & 3) << 3) | (((lane >> 2) & 3) << 6) | (((lane >> 4) & 1) << 5) | (((lane >> 5) & 1) << 8); }
__device__ __forceinline__ int crow(int r, int hi) { return (r & 3) + 8 * (r >> 2) + 4 * hi; }
__device__ __forceinline__ float partner_f(float x, int hi) { auto rr = __builtin_amdgcn_permlane32_swap(__float_as_uint(x), __float_as_uint(x), false, false); return __uint_as_float(hi ? rr[0] : rr[1]); }
#define PK4(P, B_, OUT) do { unsigned a0 = cvt_pk_bf16(P[B_+0], P[B_+1]), a1 = cvt_pk_bf16(P[B_+2], P[B_+3]);                          \
        unsigned b0 = cvt_pk_bf16(P[B_+4], P[B_+5]), b1 = cvt_pk_bf16(P[B_+6], P[B_+7]);                                             \
        auto r0 = __builtin_amdgcn_permlane32_swap(a0, b0, false, false); auto r1 = __builtin_amdgcn_permlane32_swap(a1, b1, false, false); \
        u32x4 w = {r0[0], r1[0], r0[1], r1[1]}; OUT = *reinterpret_cast<bf16x8*>(&w); } while (0)
#define TRRD(dst, addr, off) asm volatile("ds_read_b64_tr_b16 %0, %1 offset:%2" : "=&v"(dst) : "v"(addr), "i"(off) : "memory")

__device__ __forceinline__ void qkt32(f32x16& p, unsigned kaddr, int r32, int hi, const bf16x8* qr) {
    p = f32x16{};
    unsigned kb[4];
#pragma unroll
    for (int dd = 0; dd < 4; ++dd) kb[dd] = kaddr + KSWZ(r32, (dd * 16 + hi * 8) * 2);
#pragma unroll
    for (int d0 = 0; d0 < 8; ++d0) { const bf16x8 b0 = *(const LAS bf16x8*)(uintptr_t)(kb[d0 & 3] + (d0 >> 2) * 128);
        p = __builtin_amdgcn_mfma_f32_32x32x16_bf16(b0, qr[d0], p, 0, 0, 0); }
}
__device__ __forceinline__ void pv32(f32x16* o, unsigned vaddr, bf16x8 pa0, bf16x8 pa1) {
#define PV_D2(d0) do { s16x4 l0, l1, h0, h1, m0, m1, n0, n1; constexpr int b_ = (d0) * 512; \
        TRRD(l0, vaddr, b_); TRRD(h0, vaddr, b_ + 2048); TRRD(l1, vaddr, b_ + 4096); TRRD(h1, vaddr, b_ + 6144); \
        TRRD(m0, vaddr, b_ + 512); TRRD(n0, vaddr, b_ + 512 + 2048); TRRD(m1, vaddr, b_ + 512 + 4096); TRRD(n1, vaddr, b_ + 512 + 6144); \
        asm volatile("s_waitcnt lgkmcnt(0)" ::: "memory"); SBAR(); \
        o[d0] = __builtin_amdgcn_mfma_f32_32x32x16_bf16(pa0, (bf16x8){l0[0], l0[1], l0[2], l0[3], h0[0], h0[1], h0[2], h0[3]}, o[d0], 0, 0, 0); \
        o[d0 + 1] = __builtin_amdgcn_mfma_f32_32x32x16_bf16(pa0, (bf16x8){m0[0], m0[1], m0[2], m0[3], n0[0], n0[1], n0[2], n0[3]}, o[d0 + 1], 0, 0, 0); \
        o[d0] = __builtin_amdgcn_mfma_f32_32x32x16_bf16(pa1, (bf16x8){l1[0], l1[1], l1[2], l1[3], h1[0], h1[1], h1[2], h1[3]}, o[d0], 0, 0, 0); \
        o[d0 + 1] = __builtin_amdgcn_mfma_f32_32x32x16_bf16(pa1, (bf16x8){m1[0], m1[1], m1[2], m1[3], n1[0], n1[1], n1[2], n1[3]}, o[d0 + 1], 0, 0, 0); } while (0)
    PV_D2(0); PV_D2(2);
#undef PV_D2
}
template <class RowPtr>
__device__ __forceinline__ void store_o_bf16(const f32x16* o, const float* rscale, int lane, LAS unsigned char* stage, const RowPtr& rowp) {
    const int r32 = lane & 31, hi = lane >> 5;
#pragma unroll
    for (int r = 0; r < 16; ++r) { LAS unsigned short* sp = (LAS unsigned short*)(stage + crow(r, hi) * 256) + r32;
#pragma unroll
        for (int d0 = 0; d0 < 4; ++d0) { const float v = o[d0][r] * rscale[r]; sp[d0 * 32] = (unsigned short)cvt_pk_bf16(v, v); } }
    asm volatile("s_waitcnt lgkmcnt(0)" ::: "memory");
#pragma unroll
    for (int i = 0; i < 8; ++i) { const int row = (lane >> 4) + 4 * i; const u32x4 w = *(const LAS u32x4*)(stage + row * 256 + (lane & 15) * 16); *(u32x4*)(rowp(row) + (lane & 15) * 8) = w; }
    asm volatile("s_waitcnt lgkmcnt(0)" ::: "memory");
}

template <bool MASK>
__device__ __forceinline__ void sb_half(f32x16& p, float& C, int dq, int hi) {
    float om[16];
#pragma unroll
    for (int r = 0; r < 16; ++r) {
        const float e = __builtin_amdgcn_exp2f(p[r] * -QK_C2); float b = __builtin_amdgcn_rcpf(1.0f + e); float o = 1.0f - b;
        if (MASK) { const bool v = ((r & 3) + 8 * (r >> 2)) < dq; b = v ? b : 0.f; o = v ? o : 1.f; }
        p[r] = b; om[r] = o; }
    float g[4], pg[4], eh[4];
#pragma unroll
    for (int c = 0; c < 4; ++c) { g[c] = (om[4 * c] * om[4 * c + 1]) * (om[4 * c + 2] * om[4 * c + 3]); pg[c] = partner_f(g[c], hi); }
    eh[3] = C; eh[2] = eh[3] * (g[3] * pg[3]); eh[1] = eh[2] * (g[2] * pg[2]); eh[0] = eh[1] * (g[1] * pg[1]); C = eh[0] * (g[0] * pg[0]);
#pragma unroll
    for (int c = 3; c >= 0; --c) { float E = hi ? eh[c] : eh[c] * pg[c];
#pragma unroll
        for (int r = 4 * c + 3; r >= 4 * c; --r) { p[r] *= E; E *= om[r]; } }
}

struct SbTensors { const bf16_t* Q; const bf16_t* K; const bf16_t* V; bf16_t* O; };
__device__ __forceinline__ void sb_unit(const SbTensors& T, int b, int head, int qb, LAS unsigned char* lds, volatile LAS unsigned* flags  ) {
    int tid = threadIdx.x; asm volatile("" : "+v"(tid));
    const int wid = __builtin_amdgcn_readfirstlane(tid >> 6), lane = tid & 63, r32 = lane & 31, hi = lane >> 5;
    const size_t rowbase = (size_t)b * SEQ;
    const int q0 = qb * 256 + wid * 32;
    const int tq = q0 + r32;
    bf16x8 qr[8];
    { const bf16_t* qp = T.Q + (rowbase + tq) * WB + head * HD + hi * 8;
#pragma unroll
      for (int d0 = 0; d0 < 8; ++d0) qr[d0] = *(const bf16x8*)(qp + d0 * 16); }
    const bf16_t* Kh = T.K + rowbase * WB + head * HD; const bf16_t* Vh = T.V + rowbase * WB + head * HD;
    const int sr = tid >> 4, sc = (tid & 15) * 8;
    const int kws = KSWZ(sr, sc * 2), vst0 = v_st(sr, sc), vst1 = v_st(32 + sr, sc);
    const unsigned Kl = (unsigned)(uintptr_t)lds, Vl = Kl + 49152u, vrb = (unsigned)v_rd_base(lane);
    f32x16 o[4] = {}; float C = 1.0f;
    const int NT = 4 * qb + 4;
    bf16x8 ka0, ka1, va0, va1, kb0, kb1, vb0, vb1;
#define SB_LOADK(S, jt) do { const bf16_t* kp = Kh + (size_t)((jt) * 64 + sr) * WB + sc; k##S##0 = *(const bf16x8*)kp; k##S##1 = *(const bf16x8*)(kp + 32 * WB); } while (0)
#define SB_LOADV(S, jt) do { const bf16_t* vp = Vh + (size_t)((jt) * 64 + sr) * WB + sc; v##S##0 = *(const bf16x8*)vp; v##S##1 = *(const bf16x8*)(vp + 32 * WB); } while (0)
#define SB_WRITEK(S, slot) do { *(LAS bf16x8*)(lds + (slot) * 16384 + kws) = k##S##0; *(LAS bf16x8*)(lds + (slot) * 16384 + kws + 32 * 256) = k##S##1; } while (0)
#define SB_WRITEV(S, slot) do { *(LAS bf16x8*)(lds + 49152 + (slot) * 16384 + vst0) = v##S##0; *(LAS bf16x8*)(lds + 49152 + (slot) * 16384 + vst1) = v##S##1; } while (0)
#define SB_ACT(it_) (!wdone && ((NT - 1 - (it_)) * 64) <= q0 + 30)
#define SB_QKT(P, it_, h_) do { if (SB_ACT(it_)) qkt32(P, Kl + (unsigned)((it_) % 3) * 16384u + (h_) * (32 * 256), r32, hi, qr); } while (0)
#define SB_REST(P, it_, h_) do { if (SB_ACT(it_)) { const int kb_ = (NT - 1 - (it_)) * 64; \
        if (kb_ + 63 >= q0) sb_half<true>(P, C, tq - kb_ - 32 * (h_) - 4 * hi, hi); else sb_half<false>(P, C, 0, hi); \
        bf16x8 pa0, pa1; PK4(P, 0, pa0); PK4(P, 8, pa1); \
        pv32(o, Vl + (unsigned)((it_) & 1) * 16384u + vrb + (h_) * 8192, pa0, pa1); } } while (0)
    bool wdone = false;
    if (tid < 16) flags[tid] = 0u;
    SB_LOADK(a, NT - 1); SB_LOADV(a, NT - 1); SB_WRITEK(a, 0); SB_WRITEV(a, 0);
    SB_LOADK(a, NT - 2); SB_WRITEK(a, 1);
    SB_LOADK(b, NT - 3); SB_LOADV(b, NT - 2);
    __syncthreads();
    f32x16 pA, pB;
    SB_QKT(pA, 0, 1);
    bool stop = false;
#define SB_ITER(it_, L, W) do { \
        if ((it_) + 3 < NT) SB_LOADK(L, NT - 4 - (it_)); if ((it_) + 2 < NT) SB_LOADV(L, NT - 3 - (it_)); \
        SB_QKT(pB, it_, 0); \
        SB_REST(pA, it_, 1); \
        if ((it_) + 1 < NT) SB_QKT(pA, (it_) + 1, 1); \
        SB_REST(pB, it_, 0); \
        if ((it_) + 2 < NT) SB_WRITEK(W, ((it_) + 2) % 3); if ((it_) + 1 < NT) SB_WRITEV(W, ((it_) + 1) & 1); \
        if (!wdone && __all(C < 1e-18f)) wdone = true; \
        if (lane == 0) flags[((it_) & 1) * 8 + wid] = wdone ? 1u : 0u; \
        __syncthreads(); \
        unsigned nd = 0; \
        _Pragma("unroll") for (int w = 0; w < 8; ++w) nd += flags[((it_) & 1) * 8 + w]; \
        stop = nd == 8u; } while (0)
    for (int it = 0; it < NT; it += 2) {
        SB_ITER(it, a, b); if (stop) break;
        SB_ITER(it + 1, b, a); if (stop) break;
    }
#undef SB_ITER
    __syncthreads();
#undef SB_STEP
#undef SB_REST
#undef SB_QKT
#undef SB_ACT
#undef SB_LOADK
#undef SB_LOADV
#undef SB_WRITEK
#undef SB_WRITEV
    float ones[16];
#pragma unroll
    for (int r = 0; r < 16; ++r) ones[r] = 1.0f;
    bf16_t* Ob = T.O + (rowbase + q0) * WB + head * HD;
    store_o_bf16(o, ones, lane, lds + wid * 8192, [&](int row) { return Ob + (size_t)row * WB; });
    __syncthreads();
}

struct DaTensors { const bf16_t* Q; const bf16_t* K; const bf16_t* V; bf16_t* PO; float* PL; };
__device__ __forceinline__ void da_softmax_pv(f32x16& p, bool edge, int dq, float& m_reg, float& l_reg, f32x16* o, LAS float* al_l, int r32, int hi, unsigned vaddr) {
    if (edge) { const float NEG = -__builtin_inff();
#pragma unroll
        for (int r = 0; r < 16; ++r) { const int c = (r & 3) + 8 * (r >> 2); if ((unsigned)(dq - c) >= 129u) p[r] = NEG; } }
    float pmax = p[0];
#pragma unroll
    for (int r = 1; r < 16; ++r) pmax = fmaxf(pmax, p[r]);
    pmax = fmaxf(pmax, partner_f(pmax, hi));
    float alpha = 1.f;
    if (!__all((pmax - m_reg) * QK_C2 <= 8.0f * LOG2E)) {
        const float mn = fmaxf(m_reg, pmax); alpha = __builtin_amdgcn_exp2f((m_reg - mn) * QK_C2); m_reg = mn;
        if (hi == 0) al_l[r32] = alpha; asm volatile("s_waitcnt lgkmcnt(0)" ::: "memory");
#pragma unroll
        for (int r = 0; r < 16; ++r) { const float a = al_l[crow(r, hi)];
#pragma unroll
            for (int d0 = 0; d0 < 4; ++d0) o[d0][r] *= a; }
    }
    const float mnL = -m_reg * QK_C2; float ps = 0.f;
#pragma unroll
    for (int r = 0; r < 16; ++r) { p[r] = __builtin_amdgcn_exp2f(fmaf(p[r], QK_C2, mnL)); ps += p[r]; }
    ps += partner_f(ps, hi);
    l_reg = l_reg * alpha + ps;
    bf16x8 pa0, pa1; PK4(p, 0, pa0); PK4(p, 8, pa1);
    pv32(o, vaddr, pa0, pa1);
}
__device__ __forceinline__ void da_finish(const DaTensors& T, const f32x16* o, float m_reg, float l_reg, LAS float* li_l, LAS unsigned char* stage, int b, int h, int g, int rho, int u0, int lane) {
    const int r32 = lane & 31, hi = lane >> 5;
    const int dsh = 2 * g; const size_t rowbase = (size_t)b * SEQ;
    if (hi == 0) li_l[r32] = l_reg; asm volatile("s_waitcnt lgkmcnt(0)" ::: "memory");
    float rli[16];
#pragma unroll
    for (int r = 0; r < 16; ++r) rli[r] = __builtin_amdgcn_rcpf(li_l[crow(r, hi)]);
    bf16_t* Pg = T.PO + (size_t)g * MTOK * 512 + h * HD;
    store_o_bf16(o, rli, lane, stage, [&](int row) { return Pg + (rowbase + (size_t)(((u0 + row) << dsh) + rho)) * 512; });
    if (hi == 0) T.PL[((size_t)g * MTOK + rowbase + (size_t)(((u0 + r32) << dsh) + rho)) * 4 + h] = m_reg * QK_C2 + __builtin_amdgcn_logf(l_reg);
}
__device__ __forceinline__ void da_job(const DaTensors& T, int b, int h, int g, int rho, int u0, LAS unsigned char* wl, LAS float* ws) {
    int lane = threadIdx.x & 63; asm volatile("" : "+v"(lane));
    const int r32 = lane & 31, hi = lane >> 5;
    const int dsh = 2 * g;
    const size_t rowbase = (size_t)b * SEQ; const int colh = g * 512 + h * HD;
    bf16x8 qr[8];
    { const bf16_t* qp = T.Q + (rowbase + (size_t)(((u0 + r32) << dsh) + rho)) * WA + colh + hi * 8;
#pragma unroll
      for (int d0 = 0; d0 < 8; ++d0) qr[d0] = *(const bf16x8*)(qp + d0 * 16); }
    const unsigned Kl = (unsigned)(uintptr_t)wl, Vl = Kl + 8192u + (unsigned)v_rd_base(lane);
    f32x16 o[4] = {}; float m_reg = -1e30f, l_reg = 0.f;
    const int srow = lane >> 4, sc = (lane & 15) * 8;
    int tau0 = (128 - u0 + 31) >> 5; if (tau0 < 0) tau0 = 0;
    bf16x8 kk[8], vv[8];
#define DA_LOAD(tau_) do { const int ub_ = u0 - 128 + 32 * (tau_); _Pragma("unroll") for (int c = 0; c < 8; ++c) { const int ki = srow + 4 * c; \
        const size_t ro = (rowbase + (size_t)(((ub_ + ki) << dsh) + rho)) * WA + colh + sc; kk[c] = *(const bf16x8*)(T.K + ro); vv[c] = *(const bf16x8*)(T.V + ro); } } while (0)
    DA_LOAD(tau0);
    for (int tau = tau0; tau < 5; ++tau) {
        const int ub = u0 - 128 + 32 * tau;
#pragma unroll
        for (int c = 0; c < 8; ++c) { const int ki = srow + 4 * c; *(LAS bf16x8*)(wl + KSWZ(ki, sc * 2)) = kk[c]; *(LAS bf16x8*)(wl + 8192 + v_st(ki, sc)) = vv[c]; }
        if (tau + 1 < 5) DA_LOAD(tau + 1);
        asm volatile("s_waitcnt lgkmcnt(0)" ::: "memory"); SBAR();
        f32x16 p; qkt32(p, Kl, r32, hi, qr);
        da_softmax_pv(p, tau == 0 || tau == 4, u0 + r32 - ub - 4 * hi, m_reg, l_reg, o, ws, r32, hi, Vl);
    }
#undef DA_LOAD
    da_finish(T, o, m_reg, l_reg, ws + 32, wl, b, h, g, rho, u0, lane);
}
__device__ __forceinline__ void da_span(const DaTensors& T, int b, int h, int g, int rho, int U0, LAS unsigned char* hl, LAS float* ws) {
    int tid = threadIdx.x; asm volatile("" : "+v"(tid));
    const int wq = __builtin_amdgcn_readfirstlane((tid >> 6) & 3), lane = tid & 63, r32 = lane & 31, hi = lane >> 5, t256 = tid & 255;
    const int dsh = 2 * g; const size_t rowbase = (size_t)b * SEQ; const int colh = g * 512 + h * HD;
    const int u0 = U0 + 32 * wq;
    bf16x8 qr[8];
    { const bf16_t* qp = T.Q + (rowbase + (size_t)(((u0 + r32) << dsh) + rho)) * WA + colh + hi * 8;
#pragma unroll
      for (int d0 = 0; d0 < 8; ++d0) qr[d0] = *(const bf16x8*)(qp + d0 * 16); }
    const unsigned Kl = (unsigned)(uintptr_t)hl, Vl = Kl + 24576u + (unsigned)v_rd_base(lane);
    f32x16 o[4] = {}; float m_reg = -1e30f, l_reg = 0.f;
    const int skey = t256 >> 3, sc = (t256 & 7) * 16;
    const int kw0 = KSWZ(skey, sc * 2), kw1 = KSWZ(skey, sc * 2 + 16), vw0 = v_st(skey, sc), vw1 = v_st(skey, sc + 8);
    const int tv0 = U0 >= 128 ? 0 : (128 - U0) >> 5;
    bf16x8 k0, k1, v0, v1;
#define SP_LOAD(tau_) do { const size_t ro = (rowbase + (size_t)(((U0 - 128 + 32 * (tau_) + skey) << dsh) + rho)) * WA + colh + sc; \
        k0 = *(const bf16x8*)(T.K + ro); k1 = *(const bf16x8*)(T.K + ro + 8); v0 = *(const bf16x8*)(T.V + ro); v1 = *(const bf16x8*)(T.V + ro + 8); } while (0)
#define SP_WRITE(tau_) do { LAS unsigned char* ks_ = hl + ((tau_) % 3) * 8192; LAS unsigned char* vs_ = hl + 24576 + ((tau_) % 3) * 8192; \
        *(LAS bf16x8*)(ks_ + kw0) = k0; *(LAS bf16x8*)(ks_ + kw1) = k1; *(LAS bf16x8*)(vs_ + vw0) = v0; *(LAS bf16x8*)(vs_ + vw1) = v1; } while (0)
    if (tv0 <= 0) { SP_LOAD(0); SP_WRITE(0); }
    if (tv0 <= 1) { SP_LOAD(1); SP_WRITE(1); }
    __syncthreads();
    for (int tau = 0; tau < 8; ++tau) {
        const bool more = tau + 2 < 8 && tau + 2 >= tv0;
        if (more) SP_LOAD(tau + 2);
        if (tau >= tv0 && tau >= wq && tau <= wq + 4) {
            const int slot = tau % 3;
            f32x16 p; qkt32(p, Kl + slot * 8192, r32, hi, qr);
            const int trel = tau - wq;
            da_softmax_pv(p, trel == 0 || trel == 4, u0 + r32 - (U0 - 128 + 32 * tau) - 4 * hi, m_reg, l_reg, o, ws, r32, hi, Vl + slot * 8192);
        }
        if (more) SP_WRITE(tau + 2);
        __syncthreads();
    }
#undef SP_LOAD
#undef SP_WRITE
    da_finish(T, o, m_reg, l_reg, ws + 32, hl + wq * 8192, b, h, g, rho, u0, lane);
    __syncthreads();
}
__device__ __forceinline__ void da_round(const DaTensors& T, int b, int h, int chunk, int r, LAS unsigned char* lds, LAS float* wscr) {
    int tid = threadIdx.x; asm volatile("" : "+v"(tid)); const int wid = __builtin_amdgcn_readfirstlane(tid >> 6), half = wid >> 2;
    da_span(T, b, h, half, half ? r : 0, half ? chunk * 128 : chunk * 512 + 128 * r, lds + half * 49152, wscr + wid * 64);
}
__device__ __forceinline__ void da_g2set(const DaTensors& T, int b, int h, int chunk, int jj, LAS unsigned char* lds, LAS float* wscr) {
    int tid = threadIdx.x; asm volatile("" : "+v"(tid)); const int wid = __builtin_amdgcn_readfirstlane(tid >> 6);
    da_job(T, b, h, 2, wid + 8 * jj, chunk * 32, lds + wid * 16384, wscr + wid * 64);
    __syncthreads();
}
__device__ __forceinline__ void merge_groups(const DaTensors& T, bf16_t* OA, int gtid, int gthreads) {
    for (int it0 = gtid; it0 < MTOK * 64; it0 += 4 * gthreads) {
        float l0[4], l1[4], l2[4]; u32x4 pa[4], pb[4], pc[4]; size_t off[4];
#pragma unroll
        for (int u = 0; u < 4; ++u) { const int it = it0 + u * gthreads; const size_t row = (size_t)(it >> 6); const int h = (it >> 4) & 3, ch = it & 15;
            l0[u] = T.PL[(0 * (size_t)MTOK + row) * 4 + h]; l1[u] = T.PL[(1 * (size_t)MTOK + row) * 4 + h]; l2[u] = T.PL[(2 * (size_t)MTOK + row) * 4 + h];
            off[u] = row * 512 + h * HD + ch * 8;
            pa[u] = *(const u32x4*)(T.PO + off[u]); pb[u] = *(const u32x4*)(T.PO + (size_t)MTOK * 512 + off[u]); pc[u] = *(const u32x4*)(T.PO + (size_t)2 * MTOK * 512 + off[u]); }
#pragma unroll
        for (int u = 0; u < 4; ++u) {
            const float mx = fmaxf(l0[u], fmaxf(l1[u], l2[u]));
            float w0 = __builtin_amdgcn_exp2f(l0[u] - mx), w1 = __builtin_amdgcn_exp2f(l1[u] - mx), w2 = __builtin_amdgcn_exp2f(l2[u] - mx);
            const float inv = 1.0f / (w0 + w1 + w2); w0 *= inv; w1 *= inv; w2 *= inv;
            const u32x4 a = pa[u], bq = pb[u], c = pc[u];
            u32x4 w;
            w.x = cvt_pk_bf16(w0 * bf_lo(a.x) + w1 * bf_lo(bq.x) + w2 * bf_lo(c.x), w0 * bf_hi(a.x) + w1 * bf_hi(bq.x) + w2 * bf_hi(c.x));
            w.y = cvt_pk_bf16(w0 * bf_lo(a.y) + w1 * bf_lo(bq.y) + w2 * bf_lo(c.y), w0 * bf_hi(a.y) + w1 * bf_hi(bq.y) + w2 * bf_hi(c.y));
            w.z = cvt_pk_bf16(w0 * bf_lo(a.z) + w1 * bf_lo(bq.z) + w2 * bf_lo(c.z), w0 * bf_hi(a.z) + w1 * bf_hi(bq.z) + w2 * bf_hi(c.z));
            w.w = cvt_pk_bf16(w0 * bf_lo(a.w) + w1 * bf_lo(bq.w) + w2 * bf_lo(c.w), w0 * bf_hi(a.w) + w1 * bf_hi(bq.w) + w2 * bf_hi(c.w));
            *(u32x4*)(OA + off[u]) = w;
        }
    }
}
#undef SBAR
}
#define MK_ONE_LAUNCH 1
constexpr int NWAVES = 8;
#ifndef MK_ONE_LAUNCH
#define MK_ONE_LAUNCH 1
#endif
constexpr size_t MiB = 1u << 20;
constexpr size_t WS_CTL = 0, CTL_ZERO_BYTES = 1 * MiB;
constexpr size_t WS_ROPE = 2 * MiB;
constexpr size_t WS_WRT = 4 * MiB;
constexpr size_t WS_SA = 4 * MiB + 512 * 1024;
constexpr size_t WS_SB = 4 * MiB + 768 * 1024;
constexpr size_t WS_TOK = 5 * MiB;
constexpr size_t WS_LIST = 6 * MiB;
constexpr size_t WS_PL = 7 * MiB;
constexpr size_t WS_W = 8 * MiB;
constexpr size_t LW_IN = 0, LW_PA = LW_IN + (size_t)NIN * DM * 2, LW_PB = LW_PA + (size_t)DM * 512 * 2, LW_WO = LW_PB + (size_t)DM * 1024 * 2,
                 LW_UP = LW_WO + (size_t)DM * DM * 2, LW_DN = LW_UP + (size_t)NEXP * 1024 * DM * 2, LW_BYTES = LW_DN + (size_t)NEXP * DM * FF * 2;
static_assert(LW_BYTES == 156 * MiB, "weights per layer");
constexpr size_t WS_HB = WS_W + 2 * LW_BYTES;
constexpr size_t WS_OA = WS_HB + 64 * MiB;
constexpr size_t WS_OB = WS_OA + 16 * MiB;
constexpr size_t WS_PO = WS_OB + 32 * MiB;
constexpr size_t WS_GATES = WS_PO + 48 * MiB;
constexpr size_t WS_QKV = WS_GATES + 128 * MiB;
constexpr size_t WS_P1 = WS_QKV;
constexpr size_t WS_Z = WS_P1;
constexpr size_t WS_MRG = WS_QKV + 64 * MiB;
constexpr size_t WS_HID = WS_QKV + 144 * MiB;
constexpr size_t WS_YP = WS_QKV;
constexpr size_t WS_H8 = WS_QKV + 240 * MiB;
constexpr size_t WS_END = WS_H8 + 32 * MiB;
static_assert(WS_HID >= WS_YP + (size_t)36864 * DM * 2 || WS_YP >= WS_HID + (size_t)36864 * FF * 2, "YP / HID overlap");
static_assert(WS_END <= 1024 * MiB, "workspace");
constexpr int CW_TMO = 0, CW_CODE = 1, CW_BAR = 4096, CW_ECNT = 16384;
constexpr int CW_CMAX = 32768;
static_assert((CW_CMAX + DEPTH * NIN) * 4 <= (int)CTL_ZERO_BYTES, "ctl");
#define XB_TMO      128
#define XB_XCNT(j)  (256  + 64 * (j))
#define XB_XSUB(j)  (1280 + 64 * (j))
#define XB_XGEN(j)  (2304 + 64 * (j))
#define XB_TOP      3328
#define XB_TOPGEN   3392
#define XCD_BAR_WORDS 3456
#define XB_SPIN_CAP (1u << 18)
constexpr int RING_BYTES = 131072, LDSCTL_OFF = RING_BYTES, MISC_OFF = LDSCTL_OFF + 320, LT_OFF = LDSCTL_OFF + 1024  , WSCR_OFF = LDSCTL_OFF + 2048  ;
constexpr int LDS_BYTES = 147456;

__device__ __forceinline__ unsigned xb_ld(unsigned* p)              { return __hip_atomic_load(p, __ATOMIC_RELAXED, __HIP_MEMORY_SCOPE_AGENT); }
__device__ __forceinline__ unsigned xb_add(unsigned* p, unsigned v) { return __hip_atomic_fetch_add(p, v, __ATOMIC_RELAXED, __HIP_MEMORY_SCOPE_AGENT); }
__device__ __forceinline__ unsigned xb_xcc_id() { return (unsigned)__builtin_amdgcn_s_getreg((3 << 11) | 20) & 0xFu; }
#define XB_SPIN(cond, bar) do { unsigned _sp = 0; while (cond) { __builtin_amdgcn_s_sleep(1); \
    if ((++_sp & 255u) == 0u) { if (xb_ld(&(bar)[XB_TMO])) break; if (_sp > XB_SPIN_CAP) { atomicAdd(&(bar)[XB_TMO], 1u); break; } } } } while (0)
struct XcdBarrier { unsigned* bar; unsigned x; volatile LAS unsigned* st; };
__device__ __forceinline__ XcdBarrier xcd_barrier_post(unsigned* bar, volatile LAS unsigned* st) {
    XcdBarrier b; b.bar = bar; b.x = xb_xcc_id(); b.st = st;
    if (threadIdx.x == 0) (void)xb_add(&bar[XB_XCNT(b.x)], 1u);
    return b;
}
__device__ __forceinline__ void xcd_barrier_complete(unsigned* bar, unsigned x, unsigned& nloc, unsigned& nx) {
    const unsigned G = gridDim.x * gridDim.y * gridDim.z;
    unsigned sum, cnt, mine, sp = 0u;
    for (;;) {
        sum = 0u; cnt = 0u; mine = 0u;
#pragma unroll
        for (unsigned j = 0; j < 16; ++j) { const unsigned c = xb_ld(&bar[XB_XCNT(j)]); sum += c; cnt += (c > 0u) ? 1u : 0u; mine = (j == x) ? c : mine; }
        if (sum == G) break;
        __builtin_amdgcn_s_sleep(1);
        if ((++sp & 255u) == 0u) { if (xb_ld(&bar[XB_TMO])) break; if (sp > XB_SPIN_CAP) { atomicAdd(&bar[XB_TMO], 1u); break; } }
    }
    nloc = mine > 0u ? mine : 1u; nx = cnt > 0u ? cnt : 1u;
}
__device__ __forceinline__ void xcd_barrier(const XcdBarrier& b) {
    asm volatile("s_waitcnt vmcnt(0)" ::: "memory");
    __syncthreads();
    if (threadIdx.x == 0) {
        unsigned* bar = b.bar;
        __builtin_amdgcn_s_waitcnt(0);
        unsigned nloc = b.st[0], nx = b.st[1];
        if (nloc == 0u) { xcd_barrier_complete(bar, b.x, nloc, nx); b.st[0] = nloc; b.st[1] = nx; }
        const unsigned old = xb_add(&bar[XB_XSUB(b.x)], 1u);
        const unsigned gen = old / nloc;
        if (old + 1u == (gen + 1u) * nloc) {
            __builtin_amdgcn_fence(__ATOMIC_RELEASE, "agent");
            asm volatile("s_waitcnt vmcnt(0)" ::: "memory");
            const unsigned og = xb_add(&bar[XB_TOP], 1u);
            const unsigned tg = og / nx;
            if (og + 1u == (tg + 1u) * nx) xb_add(&bar[XB_TOPGEN], 1u);
            else XB_SPIN(xb_ld(&bar[XB_TOPGEN]) == tg, bar);
            __builtin_amdgcn_fence(__ATOMIC_ACQUIRE, "agent");
            xb_add(&bar[XB_XGEN(b.x)], 1u);
            asm volatile("s_waitcnt vmcnt(0)" ::: "memory");
        } else {
            XB_SPIN(xb_ld(&bar[XB_XGEN(b.x)]) == gen, bar);
            __builtin_amdgcn_fence(__ATOMIC_ACQUIRE, "agent");
            asm volatile("s_waitcnt vmcnt(0)" ::: "memory");
        }
    }
    __syncthreads();
}

struct Args { const float* in[14]; float* out; unsigned char* ws; int ph_lo, ph_hi; };
static_assert(sizeof(Args) == 14 * 8 + 8 + 8 + 8, "Args has no padding");

template <int CTRL> __device__ __forceinline__ float dppf(float v) { return __uint_as_float((unsigned)__builtin_amdgcn_update_dpp(0, (int)__float_as_uint(v), CTRL, 0xF, 0xF, true)); }
__device__ __forceinline__ float wave_sum(float v) {
    v += dppf<0xB1>(v); v += dppf<0x4E>(v); v += dppf<0x141>(v); v += dppf<0x140>(v);
    { auto r = __builtin_amdgcn_permlane16_swap(__float_as_uint(v), __float_as_uint(v), false, false); v = __uint_as_float(r[0]) + __uint_as_float(r[1]); }
    { auto r = __builtin_amdgcn_permlane32_swap(__float_as_uint(v), __float_as_uint(v), false, false); v = __uint_as_float(r[0]) + __uint_as_float(r[1]); }
    return v;
}
__device__ __forceinline__ float wave_max(float v) {
    v = fmaxf(v, dppf<0xB1>(v)); v = fmaxf(v, dppf<0x4E>(v)); v = fmaxf(v, dppf<0x141>(v)); v = fmaxf(v, dppf<0x140>(v));
    { auto r = __builtin_amdgcn_permlane16_swap(__float_as_uint(v), __float_as_uint(v), false, false); v = fmaxf(__uint_as_float(r[0]), __uint_as_float(r[1])); }
    { auto r = __builtin_amdgcn_permlane32_swap(__float_as_uint(v), __float_as_uint(v), false, false); v = fmaxf(__uint_as_float(r[0]), __uint_as_float(r[1])); }
    return v;
}
__device__ __forceinline__ float max_over_8s(float v) {
    v = fmaxf(v, dppf<0x128>(v));
    { auto r = __builtin_amdgcn_permlane16_swap(__float_as_uint(v), __float_as_uint(v), false, false); v = fmaxf(__uint_as_float(r[0]), __uint_as_float(r[1])); }
    { auto r = __builtin_amdgcn_permlane32_swap(__float_as_uint(v), __float_as_uint(v), false, false); v = fmaxf(__uint_as_float(r[0]), __uint_as_float(r[1])); }
    return v;
}
__device__ __forceinline__ float lane_read(float v, int src_lane) { return __uint_as_float((unsigned)__builtin_amdgcn_ds_bpermute(src_lane << 2, (int)__float_as_uint(v))); }
__device__ __forceinline__ int lane_read_i(int v, int src_lane) { return __builtin_amdgcn_ds_bpermute(src_lane << 2, v); }
__device__ __forceinline__ unsigned f2bf(float f) { unsigned u = __builtin_bit_cast(unsigned, f); return (u + 0x7fffu + ((u >> 16) & 1u)) >> 16; }
__device__ __forceinline__ unsigned pk2(float lo, float hi) { return f2bf(lo) | (f2bf(hi) << 16); }

template <int MAP> __device__ __forceinline__ int wmap(int n) {
    if (MAP == 1) {
        if (n < 2 * WA) { const int d = n & 127; if (d < 32) { const int dd = (d < 16) ? (((d >> 2) << 3) + (d & 3)) : ((((d - 16) >> 2) << 3) + 4 + (d & 3)); return (n & ~127) + dd; } }
        return n;
    } else if (MAP == 2) {
        if (n < FF) return ((n >> 7) << 8) + (n & 127);
        const int j = n - FF; return ((j >> 7) << 8) + 128 + (j & 127);
    }
    return n;
}
template <int MAP>
__device__ __forceinline__ void xpose_item(const float* W, int K, int N, bf16_t* WT, LAS float* scr, int item, int lane) {
    const int nblk = N / 32, kb = item / nblk, nb = item % nblk, k0 = 64 * kb, n0 = 32 * nb;
#pragma unroll 8
    for (int i = 0; i < 32; ++i) { const int kk = 2 * i + (lane >> 5); scr[kk * 33 + (lane & 31)] = W[(size_t)(k0 + kk) * N + n0 + (lane & 31)]; }
    asm volatile("s_waitcnt lgkmcnt(0)" ::: "memory");
    const int c = lane & 7;
#pragma unroll
    for (int j = 0; j < 4; ++j) { const int n = (lane >> 3) + 8 * j; const LAS float* s = scr + (8 * c) * 33 + n;
        u32x4 o; o.x = pk2(s[0 * 33], s[1 * 33]); o.y = pk2(s[2 * 33], s[3 * 33]); o.z = pk2(s[4 * 33], s[5 * 33]); o.w = pk2(s[6 * 33], s[7 * 33]);
        *(u32x4*)(WT + (size_t)wmap<MAP>(n0 + n) * K + k0 + 8 * c) = o; }
    asm volatile("s_waitcnt lgkmcnt(0)" ::: "memory");
}
__device__ __forceinline__ int opq(int x) { asm volatile("" : "+v"(x)); return x; }
__device__ __forceinline__ int tid_() { return opq((int)threadIdx.x); }
struct Frame {
    LAS unsigned char* lds; volatile LAS unsigned* MISC; unsigned* ctl; unsigned char* ws;
    int wave, vcu, G;
    const Args* A; float* out;
};
constexpr int I_IN = (DM / 64) * (NIN / 32), I_PA = (512 / 64) * (DM / 32), I_PB = (1024 / 64) * (DM / 32), I_WO = (DM / 64) * (DM / 32),
              I_UP1 = (DM / 64) * (1024 / 32), I_UP = NEXP * I_UP1, I_DN1 = (FF / 64) * (DM / 32), I_DN = NEXP * I_DN1;

__device__ __forceinline__ unsigned q8(float v, float inv) { const int q = (int)__builtin_rintf(v * inv); return (unsigned)(q < -127 ? -127 : (q > 127 ? 127 : q)) & 0xffu; }
__device__ __forceinline__ unsigned q8x4(float a, float b, float c, float d, float inv) { return q8(a, inv) | (q8(b, inv) << 8) | (q8(c, inv) << 16) | (q8(d, inv) << 24); }

struct XItem { const float* src; unsigned char* dst; float* sb; unsigned* cmax; int N, K, k0, n0, kind; };
__device__ __forceinline__ int wmap_rt(int kind, int n) { return kind == 1 ? wmap<1>(n) : kind == 2 ? wmap<2>(n) : n; }
__device__ __forceinline__ void tile_load(f32x4 (&t)[8], const XItem& x, int lane) {
    const float* p = x.src + (size_t)(x.k0 + (lane >> 3)) * x.N + x.n0 + 4 * (lane & 7);
#pragma unroll
    for (int i = 0; i < 8; ++i) t[i] = *(const f32x4*)(p + (size_t)(8 * i) * x.N);
}
__device__ __forceinline__ void tile_to_lds(const f32x4 (&t)[8], LAS float* scr, int lane) {
#pragma unroll
    for (int i = 0; i < 8; ++i) { LAS float* d = scr + ((lane >> 3) + 8 * i) * 33 + 4 * (lane & 7); d[0] = t[i].x; d[1] = t[i].y; d[2] = t[i].z; d[3] = t[i].w; }
}
__device__ __forceinline__ void tile_colmax(const f32x4 (&t)[8], const XItem& x, int lane) {
    f32x4 m = (f32x4){0.f, 0.f, 0.f, 0.f};
#pragma unroll
    for (int i = 0; i < 8; ++i) { m.x = fmaxf(m.x, fabsf(t[i].x)); m.y = fmaxf(m.y, fabsf(t[i].y)); m.z = fmaxf(m.z, fabsf(t[i].z)); m.w = fmaxf(m.w, fabsf(t[i].w)); }
    m.x = max_over_8s(m.x); m.y = max_over_8s(m.y); m.z = max_over_8s(m.z); m.w = max_over_8s(m.w);
    const float v0 = lane_read(m.x, lane >> 2), v1 = lane_read(m.y, lane >> 2), v2 = lane_read(m.z, lane >> 2), v3 = lane_read(m.w, lane >> 2);
    const int e = lane & 3; const float v = e == 0 ? v0 : e == 1 ? v1 : e == 2 ? v2 : v3;
    if (lane < 32) __hip_atomic_fetch_max(x.cmax + x.n0 + lane, __float_as_uint(v), __ATOMIC_RELAXED, __HIP_MEMORY_SCOPE_AGENT);
}
__device__ __forceinline__ void tile_store_bf16(const XItem& x, const LAS float* scr, int lane) {
    const int c = lane & 7;
#pragma unroll
    for (int j = 0; j < 4; ++j) { const int n = (lane >> 3) + 8 * j; const LAS float* s = scr + (8 * c) * 33 + n;
        u32x4 o; o.x = cvt_pk_bf16(s[0 * 33], s[1 * 33]); o.y = cvt_pk_bf16(s[2 * 33], s[3 * 33]); o.z = cvt_pk_bf16(s[4 * 33], s[5 * 33]); o.w = cvt_pk_bf16(s[6 * 33], s[7 * 33]);
        *(u32x4*)((bf16_t*)x.dst + (size_t)wmap_rt(x.kind, x.n0 + n) * x.K + x.k0 + 8 * c) = o; }
}
__device__ __forceinline__ void tile_store_i8(const XItem& x, const LAS float* scr, int lane) {
    const int c = lane & 3;
#pragma unroll
    for (int j = 0; j < 2; ++j) { const int n = (lane >> 2) + 16 * j; const LAS float* s = scr + (16 * c) * 33 + n;
        const float am = __uint_as_float(x.cmax[x.n0 + n]); const float inv = am > 0.f ? 127.0f / am : 0.f;
        u32x4 o; o.x = q8x4(s[0 * 33], s[1 * 33], s[2 * 33], s[3 * 33], inv); o.y = q8x4(s[4 * 33], s[5 * 33], s[6 * 33], s[7 * 33], inv);
        o.z = q8x4(s[8 * 33], s[9 * 33], s[10 * 33], s[11 * 33], inv); o.w = q8x4(s[12 * 33], s[13 * 33], s[14 * 33], s[15 * 33], inv);
        const int dr = wmap<1>(x.n0 + n);
        *(u32x4*)(x.dst + (size_t)dr * x.K + x.k0 + 16 * c) = o;
        if (x.k0 == 0 && c == 0) x.sb[dr] = am * (1.0f / 127.0f); }
}
__device__ __forceinline__ void tile_process(const f32x4 (&t)[8], const XItem& x, LAS float* scr, int lane, bool& need_lds) {
    need_lds = x.kind != 4;
    if (x.kind == 4) tile_colmax(t, x, lane); else tile_to_lds(t, scr, lane);
}
constexpr int I_CMX0 = I_IN;
constexpr int I_LAYER0 = I_CMX0 + I_PA + I_PB + I_WO + I_UP + I_DN;
__device__ __forceinline__ XItem decode_p0(const Frame& F, int it) {
    const int l = it / I_LAYER0; int r = it % I_LAYER0;
    unsigned char* LW = F.ws + WS_W + (size_t)l * LW_BYTES;
    XItem x; x.sb = nullptr; x.cmax = F.ctl + CW_CMAX + l * NIN; int nblk;
    if (r < I_CMX0) { x.src = F.A->in[2] + (size_t)l * DM * NIN; x.dst = nullptr; x.N = NIN; x.K = DM; x.kind = 4; }
    else { r -= I_CMX0;
    if (r < I_PA) { x.src = F.A->in[3] + (size_t)l * 512 * DM; x.dst = LW + LW_PA; x.N = DM; x.K = 512; x.kind = 0; }
    else { r -= I_PA;
    if (r < I_PB) { x.src = F.A->in[4] + (size_t)l * 1024 * DM; x.dst = LW + LW_PB; x.N = DM; x.K = 1024; x.kind = 0; }
    else { r -= I_PB;
    if (r < I_WO) { x.src = F.A->in[5] + (size_t)l * DM * DM; x.dst = LW + LW_WO; x.N = DM; x.K = DM; x.kind = 0; }
    else { r -= I_WO;
    if (r < I_UP) { const int e = r / I_UP1; r %= I_UP1; x.src = F.A->in[12] + ((size_t)l * NEXP + e) * DM * 1024; x.dst = LW + LW_UP + (size_t)e * 1024 * DM * 2; x.N = 1024; x.K = DM; x.kind = 2; }
    else { r -= I_UP; const int e = r / I_DN1; r %= I_DN1; x.src = F.A->in[13] + ((size_t)l * NEXP + e) * FF * DM; x.dst = LW + LW_DN + (size_t)e * DM * FF * 2; x.N = DM; x.K = FF; x.kind = 0; } } } } }
    nblk = x.N / 32; x.k0 = 64 * (r / nblk); x.n0 = 32 * (r % nblk);
    return x;
}
__device__ __forceinline__ XItem decode_p1(const Frame& F, int it) {
    const int l = it / I_IN, r = it % I_IN; XItem x;
    x.src = F.A->in[2] + (size_t)l * DM * NIN; x.dst = F.ws + WS_W + (size_t)l * LW_BYTES + LW_IN; x.sb = (float*)(F.ws + WS_SB) + l * NIN; x.cmax = F.ctl + CW_CMAX + l * NIN;
    x.N = NIN; x.K = DM; x.kind = 3; x.k0 = 64 * (r / (NIN / 32)); x.n0 = 32 * (r % (NIN / 32));
    return x;
}
template <int WHICH>
__device__ __forceinline__ void item_loop(Frame& F, int total) {
    LAS float* scr = (LAS float*)(F.lds + F.wave * 16384);
    const int gw = F.vcu * NWAVES + F.wave, NGW = F.G * NWAVES;
    const int lane_l = tid_() & 63;
    int it = gw; if (it >= total) return;
    XItem cur = WHICH == 0 ? decode_p0(F, it) : decode_p1(F, it);
    f32x4 t[8]; tile_load(t, cur, lane_l);
    for (;;) {
        const bool lds = cur.kind != 4;
        if (lds) tile_to_lds(t, scr, lane_l); else tile_colmax(t, cur, lane_l);
        const int nit = it + NGW; const bool more = nit < total; XItem nx = cur;
        if (more) { nx = WHICH == 0 ? decode_p0(F, nit) : decode_p1(F, nit); tile_load(t, nx, lane_l); }
        if (lds) { asm volatile("s_waitcnt lgkmcnt(0)" ::: "memory");
            if (cur.kind == 3) tile_store_i8(cur, scr, lane_l); else tile_store_bf16(cur, scr, lane_l);
            asm volatile("s_waitcnt lgkmcnt(0)" ::: "memory"); }
        if (!more) break;
        cur = nx; it = nit;
    }
}

__device__ __forceinline__ void p0_prologue(Frame& F) {
    const int gw = F.vcu * NWAVES + F.wave, NGW = F.G * NWAVES; const int tid_l = tid_(), lane_l = tid_l & 63;
    item_loop<0>(F, DEPTH * I_LAYER0);
    bf16_t* HB = (bf16_t*)(F.ws + WS_HB); unsigned char* H8 = F.ws + WS_H8; float* SA = (float*)(F.ws + WS_SA);
    for (int m = gw; m < MTOK; m += NGW) {
        const f32x4* xr = (const f32x4*)(F.A->in[0] + (size_t)m * DM) + lane_l; unsigned long long* o8 = (unsigned long long*)(HB + (size_t)m * DM) + lane_l;
        f32x4 v[8]; float am = 0.f;
#pragma unroll
        for (int j = 0; j < 8; ++j) { v[j] = xr[64 * j]; am = fmaxf(fmaxf(am, fmaxf(fabsf(v[j].x), fabsf(v[j].y))), fmaxf(fabsf(v[j].z), fabsf(v[j].w))); }
        am = wave_max(am); const float inv = am > 0.f ? 127.0f / am : 0.f;
        unsigned* o4 = (unsigned*)(H8 + (size_t)m * DM) + lane_l;
#pragma unroll
        for (int j = 0; j < 8; ++j) { o8[64 * j] = (unsigned long long)cvt_pk_bf16(v[j].x, v[j].y) | ((unsigned long long)cvt_pk_bf16(v[j].z, v[j].w) << 32); o4[64 * j] = q8x4(v[j].x, v[j].y, v[j].z, v[j].w, inv); }
        if (lane_l == 0) SA[m] = am * (1.0f / 127.0f);
    }
    {
        float* rope = (float*)(F.ws + WS_ROPE); const int* pos = (const int*)F.A->in[1];
        const int f = tid_l & 15;
        const float IF[16] = {1.0f, 0.44036659598350525f, 0.1939227432012558f, 0.08539710193872452f, 0.03760603070259094f, 0.016560440883040428f, 0.007292664609849453f, 0.0032114461064338684f,
                              0.0014142135623842478f, 0.0006227724370546639f, 0.00027424818836152554f, 0.00012076973507646471f, 5.3182957344688475e-05f, 2.34199997066753e-05f, 1.0313385246263351e-05f, 4.541670477919979e-06f};
        float inv = 0.f;
#pragma unroll
        for (int k = 0; k < 16; ++k) inv = (f == k) ? IF[k] : inv;
        for (int i = F.vcu * 512 + tid_l; i < MTOK * 16; i += F.G * 512) {
            const int row = i >> 4; const float ang = (float)pos[row] * inv;
            double rev = (double)ang * 0.15915494309189535; rev -= __builtin_rint(rev); const float rv = (float)rev;
            rope[(size_t)row * 32 + f] = __builtin_amdgcn_cosf(rv); rope[(size_t)row * 32 + 16 + f] = __builtin_amdgcn_sinf(rv);
        }
    }
    {
        bf16_t* WR = (bf16_t*)(F.ws + WS_WRT);
        for (int i = F.vcu * 512 + tid_l; i < DEPTH * 32 * DM; i += F.G * 512) {
            const int l = i / (32 * DM), o = (i / DM) % 32, k = i % DM;
            const float w = (o < 4) ? F.A->in[8][((size_t)l * DM + k) * 4 + o] : (o < 20) ? F.A->in[10][((size_t)l * DM + k) * 16 + (o - 4)] : 0.f;
            const unsigned hi = f2bf(w); const float rest = w - __uint_as_float(hi << 16);
            WR[((size_t)l * 2 * 32 + o) * DM + k] = (bf16_t)hi; WR[((size_t)l * 2 * 32 + 32 + o) * DM + k] = (bf16_t)f2bf(rest);
        }
    }
}
__device__ __forceinline__ void p1_quant(Frame& F) { item_loop<1>(F, DEPTH * I_IN); }

__device__ __forceinline__ void unpack8(const u32x4 w, float* f) { f[0] = bf_lo(w.x); f[1] = bf_hi(w.x); f[2] = bf_lo(w.y); f[3] = bf_hi(w.y); f[4] = bf_lo(w.z); f[5] = bf_hi(w.z); f[6] = bf_lo(w.w); f[7] = bf_hi(w.w); }
__device__ __forceinline__ u32x4 pack8f(const float* f) { u32x4 w; w.x = cvt_pk_bf16(f[0], f[1]); w.y = cvt_pk_bf16(f[2], f[3]); w.z = cvt_pk_bf16(f[4], f[5]); w.w = cvt_pk_bf16(f[6], f[7]); return w; }

__device__ __forceinline__ void ln1_router(Frame& F0, int l, bool do_route) {
    struct { LAS unsigned char* lds; unsigned* ctl; unsigned char* ws; int tid, lane, wave, vcu; const Args* A; } F;
    F.lds = F0.lds; F.ctl = F0.ctl; F.ws = F0.ws; F.tid = tid_(); F.lane = F.tid & 63; F.wave = __builtin_amdgcn_readfirstlane(F.tid >> 6); F.vcu = F0.vcu; F.A = F0.A;
    LAS float* Pt = (LAS float*)F.lds;
    const float* gam = F.A->in[6] + (size_t)(l * 2) * DM; const float* bet = F.A->in[7] + (size_t)(l * 2) * DM;
    bf16_t* HB = (bf16_t*)(F.ws + WS_HB); const bf16_t* Z = (const bf16_t*)(F.ws + WS_Z);
    const int row0 = F.vcu * 64;
    for (int i = 0; i < 8; i += 2) {
        const int row = row0 + F.wave * 8 + i;
        const u32x4* zr = (const u32x4*)(Z + (size_t)row * DM) + F.lane;
        u32x4 zw[2][4];
#pragma unroll
        for (int r = 0; r < 2; ++r)
#pragma unroll
            for (int j = 0; j < 4; ++j) zw[r][j] = zr[r * (DM / 8) + 64 * j];
#pragma unroll
        for (int r = 0; r < 2; ++r) {
            float v[4][8]; float s = 0.f;
#pragma unroll
            for (int j = 0; j < 4; ++j) { unpack8(zw[r][j], v[j]);
#pragma unroll
                for (int e = 0; e < 8; ++e) s += v[j][e]; }
            const float mean = wave_sum(s) * (1.f / DM); float s2 = 0.f;
#pragma unroll
            for (int j = 0; j < 4; ++j)
#pragma unroll
                for (int e = 0; e < 8; ++e) { v[j][e] -= mean; s2 += v[j][e] * v[j][e]; }
            const float rstd = 1.f / sqrtf(wave_sum(s2) * (1.f / DM) + LN_EPS);
            u32x4* hr = (u32x4*)(HB + (size_t)(row + r) * DM) + F.lane;
#pragma unroll
            for (int j = 0; j < 4; ++j) { const f32x4 g0 = ((const f32x4*)gam)[2 * F.lane + 128 * j], g1 = ((const f32x4*)gam)[2 * F.lane + 128 * j + 1], b0 = ((const f32x4*)bet)[2 * F.lane + 128 * j], b1 = ((const f32x4*)bet)[2 * F.lane + 128 * j + 1];
#pragma unroll
                for (int e = 0; e < 4; ++e) { v[j][e] = v[j][e] * rstd * g0[e] + b0[e]; v[j][4 + e] = v[j][4 + e] * rstd * g1[e] + b1[e]; }
                hr[64 * j] = pack8f(v[j]); }
        }
    }
    asm volatile("s_waitcnt vmcnt(0)" ::: "memory");
    __syncthreads();
    {
        const int tile = F.wave & 3, kh = F.wave >> 2, fr = F.lane & 15, fq = F.lane >> 4;
        const bf16_t* ap = HB + (size_t)(row0 + 16 * tile + fr) * DM + kh * 1024 + 8 * fq;
        const bf16_t* WH = (const bf16_t*)(F.ws + WS_WRT) + (size_t)l * 2 * 32 * DM; const bf16_t* WL = WH + 32 * DM;
        const bf16_t* bh = WH + (size_t)fr * DM + kh * 1024 + 8 * fq; const bf16_t* bl = WL + (size_t)fr * DM + kh * 1024 + 8 * fq;
        f32x4 c0 = (f32x4){0.f, 0.f, 0.f, 0.f}, c1 = c0;
#pragma unroll 4
        for (int ks = 0; ks < 32; ++ks) {
            const bf16x8 a = *(const bf16x8*)(ap + 32 * ks);
            const bf16x8 h0 = *(const bf16x8*)(bh + 32 * ks), h1 = *(const bf16x8*)(bh + 16 * DM + 32 * ks), l0 = *(const bf16x8*)(bl + 32 * ks), l1 = *(const bf16x8*)(bl + 16 * DM + 32 * ks);
            c0 = __builtin_amdgcn_mfma_f32_16x16x32_bf16(a, h0, c0, 0, 0, 0); c0 = __builtin_amdgcn_mfma_f32_16x16x32_bf16(a, l0, c0, 0, 0, 0);
            c1 = __builtin_amdgcn_mfma_f32_16x16x32_bf16(a, h1, c1, 0, 0, 0); c1 = __builtin_amdgcn_mfma_f32_16x16x32_bf16(a, l1, c1, 0, 0, 0);
        }
        LAS float* pp = Pt + (kh * 64 + 16 * tile + 4 * fq) * 32 + fr;
#pragma unroll
        for (int r = 0; r < 4; ++r) { pp[r * 32] = c0[r]; pp[r * 32 + 16] = c1[r]; }
    }
    __syncthreads();
    if (F.wave == 0 && do_route) {
        const int rl = F.lane, row = row0 + rl;
        const float* cb = F.A->in[9] + l * 4; const float* fb = F.A->in[11] + l * 16;
        float c[4], f[16];
#pragma unroll
        for (int j = 0; j < 4; ++j) c[j] = (Pt[rl * 32 + j] + Pt[(64 + rl) * 32 + j]) + cb[j];
#pragma unroll
        for (int j = 0; j < 16; ++j) f[j] = (Pt[rl * 32 + 4 + j] + Pt[(64 + rl) * 32 + 4 + j]) + fb[j];
        float cmax = c[0]; int g = 0;
#pragma unroll
        for (int j = 1; j < 4; ++j) if (c[j] > cmax) { cmax = c[j]; g = j; }
        float se = 0.f;
#pragma unroll
        for (int j = 0; j < 4; ++j) se += __expf(c[j] - cmax);
        const float pgrp = 1.0f / se;
        float sel[4];
#pragma unroll
        for (int i = 0; i < 4; ++i) sel[i] = (g == 0) ? f[i] : (g == 1) ? f[4 + i] : (g == 2) ? f[8 + i] : f[12 + i];
        float v1 = sel[0]; int i1 = 0;
#pragma unroll
        for (int i = 1; i < 4; ++i) if (sel[i] > v1) { v1 = sel[i]; i1 = i; }
        float v2 = -__builtin_inff(); int i2 = 0;
#pragma unroll
        for (int i = 0; i < 4; ++i) if (i != i1 && sel[i] > v2) { v2 = sel[i]; i2 = i; }
        const float w1 = 1.0f / (1.0f + __expf(v2 - v1)), w2 = 1.0f - w1;
        const int e1 = 4 * g + i1, e2 = 4 * g + i2;
        const unsigned long long lt = (1ull << F.lane) - 1ull;
        int r1 = 0, r2 = 0, mycnt = 0;
#pragma unroll
        for (int e = 0; e < NEXP; ++e) { const unsigned long long m1 = __ballot(e1 == e), m2 = __ballot(e2 == e); const int c1 = __popcll(m1);
            if (e1 == e) r1 = __popcll(m1 & lt); if (e2 == e) r2 = c1 + __popcll(m2 & lt); if (F.lane == e) mycnt = c1 + __popcll(m2); }
        int base = 0;
        if (F.lane < NEXP && mycnt > 0) base = (int)__hip_atomic_fetch_add(F.ctl + CW_ECNT + 64 * l + F.lane, (unsigned)mycnt, __ATOMIC_RELAXED, __HIP_MEMORY_SCOPE_AGENT);
        const int pos1 = lane_read_i(base, e1) + r1, pos2 = lane_read_i(base, e2) + r2;
        int* list = (int*)(F.ws + WS_LIST);
        list[e1 * ECAP + pos1] = row; list[e2 * ECAP + pos2] = row;
        ((u32x4*)(F.ws + WS_TOK))[row] = (u32x4){(unsigned)(e1 << 16 | pos1), __float_as_uint(pgrp * w1), (unsigned)(e2 << 16 | pos2), __float_as_uint(pgrp * w2)};
    }
    __syncthreads();
}
__device__ __forceinline__ void moe_tables(Frame& F, int l) {
    LAS int* LT = (LAS int*)(F.lds + LT_OFF);
    const int tid_l = tid_();
    if (tid_l == 0) { int t = 0;
        for (int e = 0; e < NEXP; ++e) { const int c = (int)__hip_atomic_load(F.ctl + CW_ECNT + 64 * l + e, __ATOMIC_RELAXED, __HIP_MEMORY_SCOPE_AGENT); LT[e] = t; LT[32 + e] = c; t += (c + 255) >> 8; }
        LT[16] = t; }
    __syncthreads();
    if (tid_l < 160) { const int rt = tid_l; int e = 0;
#pragma unroll
        for (int j = 1; j < NEXP; ++j) e += (LT[j] <= rt) ? 1 : 0;
        LT[64 + rt] = e; }
    __syncthreads();
}
__device__ __forceinline__ void ln2_phase(Frame& F0, int l) {
    struct { LAS unsigned char* lds; unsigned char* ws; int lane, wave, vcu, G; const Args* A; float* out; } F;
    F.lds = F0.lds; F.ws = F0.ws; { const int t = tid_(); F.lane = t & 63; F.wave = __builtin_amdgcn_readfirstlane(t >> 6); } F.vcu = F0.vcu; F.G = F0.G; F.A = F0.A; F.out = F0.out;
    const LAS int* LT = (const LAS int*)(F.lds + LT_OFF);
    const float* gam = F.A->in[6] + (size_t)(l * 2 + 1) * DM; const float* bet = F.A->in[7] + (size_t)(l * 2 + 1) * DM;
    bf16_t* HB = (bf16_t*)(F.ws + WS_HB); const bf16_t* YP = (const bf16_t*)(F.ws + WS_YP); unsigned char* H8 = F.ws + WS_H8; float* SA = (float*)(F.ws + WS_SA);
    const int gw = F.vcu * NWAVES + F.wave, NGW = F.G * NWAVES;
    for (int row = gw; row < MTOK; row += NGW) {
        const u32x4 ti = ((const u32x4*)(F.ws + WS_TOK))[row];
        const int e1 = ti.x >> 16, p1 = ti.x & 0xffff, e2 = ti.z >> 16, p2 = ti.z & 0xffff; const float g1 = __uint_as_float(ti.y), g2 = __uint_as_float(ti.w);
        const size_t s1 = (size_t)LT[e1] * 256 + p1, s2 = (size_t)LT[e2] * 256 + p2;
        u32x4* hr = (u32x4*)(HB + (size_t)row * DM) + F.lane;
        const u32x4* y1 = (const u32x4*)(YP + s1 * DM) + F.lane; const u32x4* y2 = (const u32x4*)(YP + s2 * DM) + F.lane;
        float v[4][8]; float s = 0.f;
#pragma unroll
        for (int j = 0; j < 4; ++j) { float h[8], a[8], b[8]; unpack8(hr[64 * j], h); unpack8(y1[64 * j], a); unpack8(y2[64 * j], b);
#pragma unroll
            for (int e = 0; e < 8; ++e) { v[j][e] = ALPHA * h[e] + g1 * a[e] + g2 * b[e]; s += v[j][e]; } }
        const float mean = wave_sum(s) * (1.f / DM); float s2v = 0.f;
#pragma unroll
        for (int j = 0; j < 4; ++j)
#pragma unroll
            for (int e = 0; e < 8; ++e) { v[j][e] -= mean; s2v += v[j][e] * v[j][e]; }
        const float rstd = 1.f / sqrtf(wave_sum(s2v) * (1.f / DM) + LN_EPS);
        float am = 0.f;
#pragma unroll
        for (int j = 0; j < 4; ++j) { const f32x4 g0 = ((const f32x4*)gam)[2 * F.lane + 128 * j], g1v = ((const f32x4*)gam)[2 * F.lane + 128 * j + 1], b0 = ((const f32x4*)bet)[2 * F.lane + 128 * j], b1 = ((const f32x4*)bet)[2 * F.lane + 128 * j + 1];
#pragma unroll
            for (int e = 0; e < 4; ++e) { v[j][e] = v[j][e] * rstd * g0[e] + b0[e]; v[j][4 + e] = v[j][4 + e] * rstd * g1v[e] + b1[e]; am = fmaxf(am, fmaxf(fabsf(v[j][e]), fabsf(v[j][4 + e]))); } }
        if (l + 1 < DEPTH) {
            am = wave_max(am); const float inv = am > 0.f ? 127.0f / am : 0.f;
            u32x2* q = (u32x2*)(H8 + (size_t)row * DM) + F.lane;
#pragma unroll
            for (int j = 0; j < 4; ++j) { hr[64 * j] = pack8f(v[j]); q[64 * j] = (u32x2){q8x4(v[j][0], v[j][1], v[j][2], v[j][3], inv), q8x4(v[j][4], v[j][5], v[j][6], v[j][7], inv)}; }
            if (F.lane == 0) SA[row] = am * (1.0f / 127.0f);
        } else {
            f32x4* o = (f32x4*)(F.out + (size_t)row * DM) + 2 * F.lane;
#pragma unroll
            for (int j = 0; j < 4; ++j) { o[128 * j] = (f32x4){v[j][0], v[j][1], v[j][2], v[j][3]}; o[128 * j + 1] = (f32x4){v[j][4], v[j][5], v[j][6], v[j][7]}; }
        }
    }
}

constexpr int N_PHASES = 2 + 9 * DEPTH;
#ifdef TPROBE
#define TP_DECL unsigned long long tp0_ = 0;
#define TP_BEGIN(id, vc) if (TPROBE == (id) && F.vcu == (vc) && l == 0) tp0_ = __builtin_amdgcn_s_memrealtime();
#define TP_END(id, vc) if (TPROBE == (id) && F.vcu == (vc) && l == 0 && tid_() == 0) { const unsigned long long d_ = __builtin_amdgcn_s_memrealtime() - tp0_; __hip_atomic_store(F.ctl + 2, (unsigned)d_, __ATOMIC_RELAXED, __HIP_MEMORY_SCOPE_AGENT); }
#else
#define TP_DECL
#define TP_BEGIN(id, vc)
#define TP_END(id, vc)
#endif
#ifndef PHMASK
#define PHMASK 0x3ff
#endif
#ifndef DUPMASK
#define DUPMASK 0
#endif
__global__ void __launch_bounds__(NWAVES * 64, 2) mk_fwd(Args args) {
    extern __shared__ __attribute__((aligned(16))) unsigned char lds_raw[];
    Frame F;
    F.lds = (LAS unsigned char*)lds_raw; F.MISC = (volatile LAS unsigned*)(F.lds + MISC_OFF);
    F.wave = __builtin_amdgcn_readfirstlane(tid_() >> 6);
    F.G = gridDim.x; { const int bx = blockIdx.x; F.vcu = (F.G % 8 == 0) ? (bx % 8) * (F.G / 8) + bx / 8 : bx; }
    F.ws = args.ws; F.ctl = (unsigned*)(args.ws + WS_CTL); F.out = args.out;
    F.A = &args;
    for (int u = tid_(); u < (LDS_BYTES - LDSCTL_OFF) / 4; u += NWAVES * 64) ((LAS unsigned*)(F.lds + LDSCTL_OFF))[u] = 0u;
    __syncthreads();
    const int lo = args.ph_lo, hi = args.ph_hi;
    XcdBarrier bar; bar.bar = F.ctl + CW_BAR; bar.x = 0; bar.st = nullptr;
    if (hi - lo > 1) bar = xcd_barrier_post(F.ctl + CW_BAR, F.MISC + 8);
#define IN(k) (lo <= (k) && (k) < hi)
#define PH(s) ((PHMASK >> (s)) & 1)
#define REP(s) for (int rep_ = 0; rep_ < (((DUPMASK >> (s)) & 1) ? 2 : 1); ++rep_)
#define SEAM(k) do { if (IN(k) && IN((k) + 1)) xcd_barrier(bar); } while (0)
    if (PH(0) && IN(0)) { REP(0) p0_prologue(F); SEAM(0); }
    if (PH(0) && IN(1)) { REP(0) p1_quant(F); SEAM(1); }
    bf16_t* HB = (bf16_t*)(F.ws + WS_HB);
    bf16_t* QKV = (bf16_t*)(F.ws + WS_QKV); bf16_t* GATES = (bf16_t*)(F.ws + WS_GATES);
    bf16_t* OA = (bf16_t*)(F.ws + WS_OA); bf16_t* OB = (bf16_t*)(F.ws + WS_OB);
    for (int l = 0; l < DEPTH; ++l) {
        const int pb = 2 + 9 * l;
        const bf16_t* LW = (const bf16_t*)(F.ws + WS_W + (size_t)l * LW_BYTES);
        if (PH(1) && IN(pb + 0)) {
            pg8::Gemm g{(const bf16_t*)(F.ws + WS_H8), LW + LW_IN / 2, DM / 2}; pg8::StaticOrder S; S.init(MTOK, NIN, F.G, (int)blockIdx.x);
            pg8::EpiProj E{QKV, GATES, (const float*)(F.ws + WS_ROPE), (const float*)(F.ws + WS_SA), (const float*)(F.ws + WS_SB) + l * NIN};
            REP(1) pg8::gemm_phase<pg8::EpiProj, pg8::StaticOrder, true, false, true>(F.lds, g, S, E);
            SEAM(pb + 0);
        }
        if (PH(2) && IN(pb + 1)) {
            att::SbTensors TB{QKV + (size_t)3 * MTOK * WA, QKV + (size_t)3 * MTOK * WA + (size_t)MTOK * WB, QKV + (size_t)3 * MTOK * WA + (size_t)2 * MTOK * WB, OB};
            att::DaTensors TA{QKV, QKV + (size_t)MTOK * WA, QKV + (size_t)2 * MTOK * WA, (bf16_t*)(F.ws + WS_PO), (float*)(F.ws + WS_PL)};
            volatile LAS unsigned* sbf = (volatile LAS unsigned*)(F.lds + LDSCTL_OFF + 512);
            LAS float* wscr = (LAS float*)(F.lds + WSCR_OFF);
            for (int c = F.vcu; c < 256; c += F.G) {
                { TP_DECL TP_BEGIN(1, 0) REP(2) for (int q = 1; q >= 0; --q) { const int u = 2 * c + q; att::sb_unit(TB, u >> 6, (u >> 3) & 7, u & 7, F.lds, sbf); } TP_END(1, 0) }
                { TP_DECL TP_BEGIN(3, 0) REP(3) { for (int q = 0; q < 2; ++q) { const int sr = 2 * c + q, a = sr >> 2; att::da_round(TA, a >> 4, (a >> 2) & 3, a & 3, sr & 3, F.lds, wscr); }
                    { const int a = c >> 1; att::da_g2set(TA, a >> 4, (a >> 2) & 3, a & 3, c & 1, F.lds, wscr); } } TP_END(3, 0) } }
            { TP_DECL TP_BEGIN(4, 0)
            SEAM(pb + 1);
            TP_END(4, 0) }
        }
        if (PH(2) && IN(pb + 2)) {
            att::DaTensors TA{QKV, QKV + (size_t)MTOK * WA, QKV + (size_t)2 * MTOK * WA, (bf16_t*)(F.ws + WS_PO), (float*)(F.ws + WS_PL)};
            att::merge_groups(TA, OA, F.vcu * 512 + tid_(), F.G * 512);
            SEAM(pb + 2);
        }
        if (PH(3) && IN(pb + 3)) {
            bf16_t* P1 = (bf16_t*)(F.ws + WS_P1); bf16_t* MRG = (bf16_t*)(F.ws + WS_MRG);
            pg8::StaticOrder S; S.init(MTOK, DM, F.G, (int)blockIdx.x);
            REP(4) {
            { pg8::Gemm g{OA, LW + LW_PA / 2, 512}; pg8::EpiGate<false> E{GATES, P1, MRG}; pg8::gemm_phase<pg8::EpiGate<false>, pg8::StaticOrder, true, false>(F.lds, g, S, E); }
            { pg8::Gemm g{OB, LW + LW_PB / 2, 1024}; pg8::EpiGate<true> E{GATES + (size_t)MTOK * DM, P1, MRG}; pg8::gemm_phase<pg8::EpiGate<true>, pg8::StaticOrder, true, false>(F.lds, g, S, E); }
            }
            SEAM(pb + 3);
        }
        if (PH(4) && IN(pb + 4)) {
            pg8::Gemm g{(const bf16_t*)(F.ws + WS_MRG), LW + LW_WO / 2, DM}; pg8::StaticOrder S; S.init(MTOK, DM, F.G, (int)blockIdx.x);
            pg8::EpiResid E{HB, (bf16_t*)(F.ws + WS_Z)};
            REP(5) pg8::gemm_phase<pg8::EpiResid, pg8::StaticOrder, true, false>(F.lds, g, S, E);
            SEAM(pb + 4);
        }
        if (PH(5) && IN(pb + 5)) { REP(8) ln1_router(F, l, rep_ == (((DUPMASK >> 8) & 1) ? 1 : 0)); SEAM(pb + 5); }
        if (PH(6) && IN(pb + 6)) {
            moe_tables(F, l);
            const LAS int* LT = (const LAS int*)(F.lds + LT_OFF);
            pg8::MoeOrder S{4, F.G, F.vcu, LT[16] * 4, LT, LT + 32, (const int*)(F.ws + WS_LIST)};
            pg8::Gemm g{HB, LW + LW_UP / 2, DM}; pg8::EpiSwiglu E{(bf16_t*)(F.ws + WS_HID)};
            REP(6) pg8::gemm_phase<pg8::EpiSwiglu, pg8::MoeOrder, true, true>(F.lds, g, S, E);
            SEAM(pb + 6);
        }
        if (PH(7) && IN(pb + 7)) {
            moe_tables(F, l);
            const LAS int* LT = (const LAS int*)(F.lds + LT_OFF);
            pg8::MoeOrder S{8, F.G, F.vcu, LT[16] * 8, LT, LT + 32, (const int*)(F.ws + WS_LIST)};
            pg8::Gemm g{(const bf16_t*)(F.ws + WS_HID), LW + LW_DN / 2, FF}; pg8::EpiBf16 E{(bf16_t*)(F.ws + WS_YP), DM};
            REP(7) pg8::gemm_phase<pg8::EpiBf16, pg8::MoeOrder, true, false>(F.lds, g, S, E);
            SEAM(pb + 7);
        }
        if (PH(8) && IN(pb + 8)) { moe_tables(F, l); ln2_phase(F, l); if (((DUPMASK >> 9) & 1) && l + 1 == DEPTH) ln2_phase(F, l); SEAM(pb + 8); }
    }
#ifdef TPROBE
    if (IN(N_PHASES - 1) && F.vcu == 0) { asm volatile("s_waitcnt vmcnt(0)" ::: "memory"); __syncthreads();
        if (tid_() == 0) F.out[0] = (float)__hip_atomic_load(F.ctl + 2, __ATOMIC_RELAXED, __HIP_MEMORY_SCOPE_AGENT) * 0.01f - (float)TPROBE_OFF; }
#endif
#undef IN
#undef SEAM
}

extern "C" void kernel_launch(void* const* d_in, const int* in_sizes, int n_in, void* d_out, int out_size, void* d_ws, size_t ws_size, hipStream_t stream) {
    static int grid = 0;
    if (grid == 0) {
        if (n_in != 14 || in_sizes[0] != MTOK * DM || out_size != MTOK * DM || ws_size < WS_END) { fprintf(stderr, "kernel_launch: unexpected shapes (n_in %d, in0 %d, out %d, ws %zu)\n", n_in, n_in > 0 ? in_sizes[0] : -1, out_size, ws_size); grid = -1; return; }
        int dev = 0, cus = 0;
        if (hipGetDevice(&dev) != hipSuccess || hipDeviceGetAttribute(&cus, hipDeviceAttributeMultiprocessorCount, dev) != hipSuccess) { grid = -1; return; }
        if (hipFuncSetAttribute((const void*)mk_fwd, hipFuncAttributeMaxDynamicSharedMemorySize, LDS_BYTES) != hipSuccess) { fprintf(stderr, "kernel_launch: hipFuncSetAttribute failed\n"); grid = -1; return; }
        int per_cu = 0;
        if (hipOccupancyMaxActiveBlocksPerMultiprocessor(&per_cu, (const void*)mk_fwd, NWAVES * 64, LDS_BYTES) != hipSuccess || per_cu < 1) fprintf(stderr, "kernel_launch: occupancy query reports %d\n", per_cu);
        (void)hipGetLastError();
        if (cus < 256) { fprintf(stderr, "kernel_launch: needs 256 CUs, device has %d\n", cus); grid = -1; return; }
        grid = 256;
    }
    if (grid < 0) return;
    if (hipMemsetAsync((char*)d_ws + WS_CTL, 0, CTL_ZERO_BYTES, stream) != hipSuccess) return;
    Args a{};
    for (int i = 0; i < 14; ++i) a.in[i] = (const float*)d_in[i];
    a.out = (float*)d_out; a.ws = (unsigned char*)d_ws;
#if MK_ONE_LAUNCH
    a.ph_lo = 0; a.ph_hi = N_PHASES;
    hipLaunchKernelGGL(mk_fwd, dim3(grid), dim3(NWAVES * 64), LDS_BYTES, stream, a);
#else
    for (int p = 0; p < N_PHASES; ++p) { a.ph_lo = p; a.ph_hi = p + 1; hipLaunchKernelGGL(mk_fwd, dim3(grid), dim3(NWAVES * 64), LDS_BYTES, stream, a); }
#endif
}
```
